# Optimizing an MI355X kernel written in HIP

```python
import jax, jax.numpy as jnp
from jax import lax
import numpy as np

D_MODEL = 1024
BATCH = 8
SEQ = 4096
DEPTH = 2
DEC_BATCH = 32
DEC_SEQ = 16
PAST_LEN = 4096

CHUNK = 64
N_MIXERS = 2
N_ATT_LAYERS = (DEPTH + 1) // 2
N_MLP_LAYERS = DEPTH // 2
N_HEADS = 8
QK_NOPE_DIM = 128
QK_ROPE_DIM = 64
V_HEAD_DIM = 128
Q_LORA_RANK = 384
KV_LORA_RANK = 256
ROPE_THETA = 10000.0
Q_BLOCK = 128
SGU_CHUNK = 128
SGU_WIDTH = D_MODEL
SGU_GROUPS = 8
SGU_GROUP_DIM = SGU_WIDTH // SGU_GROUPS
D_FF = 4 * D_MODEL
EPS = 1e-6

kernel_name = 'hybrid_mla_chunkmlp_streaming_step'


def rmsnorm(x, g):
    xf = x.astype(jnp.float32)
    y = xf * lax.rsqrt(jnp.mean(xf * xf, axis=-1, keepdims=True) + EPS)
    return (y * g.astype(jnp.float32)).astype(x.dtype)


def rope(x, pos):
    half = QK_ROPE_DIM // 2
    inv = 1.0 / (ROPE_THETA ** (jnp.arange(half, dtype=jnp.float32) / half))
    ang = pos.astype(jnp.float32)[:, None] * inv[None, :]
    shape = (1, pos.shape[0]) + (1,) * (x.ndim - 3) + (half,)
    cos = jnp.cos(ang).reshape(shape)
    sin = jnp.sin(ang).reshape(shape)
    xf = x.astype(jnp.float32)
    x1, x2 = xf[..., :half], xf[..., half:]
    return jnp.concatenate([x1 * cos - x2 * sin, x2 * cos + x1 * sin], axis=-1).astype(x.dtype)


def ada_modulation(c, w, b):
    m = jax.nn.silu(c) @ w + b
    return jnp.split(m, 6, axis=-1)


def modulated_norm(x, g, shift, scale):
    return rmsnorm(x, g) * (1 + scale[:, None, :]) + shift[:, None, :]


def mla_project(h, pos, p):
    w_in, g_qa, g_kva, w_q_up, g_qn, g_qr, g_kr = p['w_in'], p['g_qa'], p['g_kva'], p['w_q_up'], p['g_qn'], p['g_qr'], p['g_kr']
    B, T, _ = h.shape
    a = h @ w_in
    cq, ckv, kr = jnp.split(a, [Q_LORA_RANK, Q_LORA_RANK + KV_LORA_RANK], axis=-1)
    cq = rmsnorm(cq, g_qa)
    ckv = rmsnorm(ckv, g_kva)
    q = (cq @ w_q_up).reshape(B, T, N_HEADS, QK_NOPE_DIM + QK_ROPE_DIM)
    qn = rmsnorm(q[..., :QK_NOPE_DIM], g_qn)
    qr = rope(rmsnorm(q[..., QK_NOPE_DIM:], g_qr), pos)
    kr = rope(rmsnorm(kr, g_kr), pos)
    return qn, qr, ckv, kr


def mla_keys(ckv, w_uk, g_kn):
    return rmsnorm(jnp.einsum('bkl,lhd->bkhd', ckv, w_uk), g_kn)


def mla_attend(qn, qr, kn, kr, ckv, q_pos, k_pos):
    scale = (QK_NOPE_DIM + QK_ROPE_DIM) ** -0.5
    s = jnp.einsum('bqhd,bkhd->bhqk', qn, kn) + jnp.einsum('bqhr,bkr->bhqk', qr, kr)
    s = s.astype(jnp.float32) * scale
    visible = (k_pos[None, :] // CHUNK) <= (q_pos[:, None] // CHUNK)
    s = jnp.where(visible[None, None], s, jnp.finfo(jnp.float32).min)
    pr = jax.nn.softmax(s, axis=-1).astype(ckv.dtype)
    return jnp.einsum('bhqk,bkl->bqhl', pr, ckv)


def mla_out(o_lat, w_uv, w_o):
    B, T = o_lat.shape[:2]
    o = jnp.einsum('bqhl,lhd->bqhd', o_lat, w_uv).reshape(B, T, N_HEADS * V_HEAD_DIM)
    return o @ w_o


def mla_prompt_mixer(h, pos, p):
    qn, qr, ckv, kr = mla_project(h, pos, p)
    kn = mla_keys(ckv, p['w_uk'], p['g_kn'])
    B, T = h.shape[:2]
    nb = T // Q_BLOCK
    qn_b = qn.reshape(B, nb, Q_BLOCK, N_HEADS, QK_NOPE_DIM).swapaxes(0, 1)
    qr_b = qr.reshape(B, nb, Q_BLOCK, N_HEADS, QK_ROPE_DIM).swapaxes(0, 1)
    pos_b = pos.reshape(nb, Q_BLOCK)
    o = lax.map(lambda a: mla_attend(a[0], a[1], kn, kr, ckv, a[2], pos), (qn_b, qr_b, pos_b))
    o = o.swapaxes(0, 1).reshape(B, T, N_HEADS, KV_LORA_RANK)
    return mla_out(o, p['w_uv'], p['w_o']), ckv, kr


def mla_sample_mixer(h, pos, past_ckv, past_kpe, p):
    qn, qr, ckv_new, kr_new = mla_project(h, pos, p)
    ckv_all = jnp.concatenate([past_ckv, ckv_new], axis=1)
    kr_all = jnp.concatenate([past_kpe, kr_new], axis=1)
    kn = mla_keys(ckv_all, p['w_uk'], p['g_kn'])
    k_pos = jnp.arange(ckv_all.shape[1])
    o = mla_attend(qn, qr, kn, kr_all, ckv_all, pos, k_pos)
    return mla_out(o, p['w_uv'], p['w_o']), ckv_new, kr_new


def sgu_mix(u, v, w_s, b_s, idx):
    ii = jnp.arange(SGU_CHUNK)
    mask = (ii[None, :] // CHUNK) <= (ii[:, None] // CHUNK)
    w = jnp.where(mask[None], w_s, 0)
    w = w[:, idx[:, None], idx[None, :]]
    bias = b_s[:, idx].T[None, None, :, :, None]
    mixed = jnp.einsum('gij,bnjgc->bnigc', w, v) + bias
    return u * mixed


def chunk_mlp_mixer(h, idx, p):
    B, T, _ = h.shape
    Tc = idx.shape[0]
    n = T // Tc
    z = jax.nn.gelu(h @ p['w_in'])
    u, v = jnp.split(z, 2, axis=-1)
    v = rmsnorm(v, p['g_v'])
    shp = (B, n, Tc, SGU_GROUPS, SGU_GROUP_DIM)
    g = sgu_mix(u.reshape(shp), v.reshape(shp), p['w_s'], p['b_s'], idx).reshape(B, T, SGU_WIDTH)
    return g @ p['w_o'], v


def sq_relu_ffn(h, w1, w2):
    return jnp.square(jax.nn.relu(h @ w1)) @ w2


def setup_inputs(seed: int = 0) -> dict:
    key = jax.random.key(seed)
    ks = iter(jax.random.split(key, 48))

    def nrm(shape, scale):
        return jax.random.normal(next(ks), shape, jnp.float32) * scale

    def gain(shape):
        return 1.0 + nrm(shape, 0.05)

    NA, NB = N_ATT_LAYERS, N_MLP_LAYERS
    return {
        'x_prompt': nrm((BATCH, SEQ, D_MODEL), 1.0),
        'x_sample': nrm((DEC_BATCH, DEC_SEQ, D_MODEL), 1.0),
        'cache_ckv': nrm((NA, DEC_BATCH, PAST_LEN, KV_LORA_RANK), 1.0),
        'cache_kpe': nrm((NA, DEC_BATCH, PAST_LEN, QK_ROPE_DIM), 1.0),
        'c_prompt': nrm((BATCH, D_MODEL), 1.0),
        'c_sample': nrm((DEC_BATCH, D_MODEL), 1.0),
        'ada_w': nrm((DEPTH, D_MODEL, 6 * D_MODEL), 0.5 * D_MODEL ** -0.5),
        'ada_b': nrm((DEPTH, 6 * D_MODEL), 0.02),
        'norm1_g': gain((DEPTH, D_MODEL)),
        'norm2_g': gain((DEPTH, D_MODEL)),
        'ffn_w1': nrm((DEPTH, D_MODEL, D_FF), D_MODEL ** -0.5),
        'ffn_w2': nrm((DEPTH, D_FF, D_MODEL), D_FF ** -0.5),
        'mla_w_in': nrm((NA, D_MODEL, Q_LORA_RANK + KV_LORA_RANK + QK_ROPE_DIM), D_MODEL ** -0.5),
        'mla_g_qa': gain((NA, Q_LORA_RANK)),
        'mla_g_kva': gain((NA, KV_LORA_RANK)),
        'mla_w_q_up': nrm((NA, Q_LORA_RANK, N_HEADS * (QK_NOPE_DIM + QK_ROPE_DIM)), Q_LORA_RANK ** -0.5),
        'mla_w_uk': nrm((NA, KV_LORA_RANK, N_HEADS, QK_NOPE_DIM), KV_LORA_RANK ** -0.5),
        'mla_w_uv': nrm((NA, KV_LORA_RANK, N_HEADS, V_HEAD_DIM), KV_LORA_RANK ** -0.5),
        'mla_g_qn': gain((NA, QK_NOPE_DIM)),
        'mla_g_qr': gain((NA, QK_ROPE_DIM)),
        'mla_g_kn': gain((NA, QK_NOPE_DIM)),
        'mla_g_kr': gain((NA, QK_ROPE_DIM)),
        'mla_w_o': nrm((NA, N_HEADS * V_HEAD_DIM, D_MODEL), (N_HEADS * V_HEAD_DIM) ** -0.5),
        'cm_w_in': nrm((NB, D_MODEL, 2 * SGU_WIDTH), D_MODEL ** -0.5),
        'cm_g_v': gain((NB, SGU_WIDTH)),
        'cm_w_s': nrm((NB, SGU_GROUPS, SGU_CHUNK, SGU_CHUNK), SGU_CHUNK ** -0.5),
        'cm_b_s': gain((NB, SGU_GROUPS, SGU_CHUNK)),
        'cm_w_o': nrm((NB, SGU_WIDTH, D_MODEL), SGU_WIDTH ** -0.5),
    }


def reference(x_prompt, x_sample, cache_ckv, cache_kpe, c_prompt, c_sample,
              ada_w, ada_b, norm1_g, norm2_g, ffn_w1, ffn_w2,
              mla_w_in, mla_g_qa, mla_g_kva, mla_w_q_up, mla_w_uk, mla_w_uv,
              mla_g_qn, mla_g_qr, mla_g_kn, mla_g_kr, mla_w_o,
              cm_w_in, cm_g_v, cm_w_s, cm_b_s, cm_w_o):
    seq_p = x_prompt.shape[1]
    seq_s = x_sample.shape[1]
    past = cache_ckv.shape[2]
    pos_p = jnp.arange(seq_p)
    pos_s = past + jnp.arange(seq_s)
    idx_p = jnp.arange(SGU_CHUNK)
    idx_s = (past + jnp.arange(seq_s)) % SGU_CHUNK

    x_p, x_s = x_prompt, x_sample
    ckv_p_l, kpe_p_l, ckv_s_l, kpe_s_l, v_s_l = [], [], [], [], []
    for i in range(DEPTH):
        sh1_p, sc1_p, gt1_p, sh2_p, sc2_p, gt2_p = ada_modulation(c_prompt, ada_w[i], ada_b[i])
        sh1_s, sc1_s, gt1_s, sh2_s, sc2_s, gt2_s = ada_modulation(c_sample, ada_w[i], ada_b[i])
        h_p = modulated_norm(x_p, norm1_g[i], sh1_p, sc1_p)
        h_s = modulated_norm(x_s, norm1_g[i], sh1_s, sc1_s)
        if i % N_MIXERS == 0:
            a = i // N_MIXERS
            p = {'w_in': mla_w_in[a], 'g_qa': mla_g_qa[a], 'g_kva': mla_g_kva[a], 'w_q_up': mla_w_q_up[a],
                 'w_uk': mla_w_uk[a], 'w_uv': mla_w_uv[a], 'g_qn': mla_g_qn[a], 'g_qr': mla_g_qr[a],
                 'g_kn': mla_g_kn[a], 'g_kr': mla_g_kr[a], 'w_o': mla_w_o[a]}
            m_p, ckv_p, kpe_p = mla_prompt_mixer(h_p, pos_p, p)
            m_s, ckv_s, kpe_s = mla_sample_mixer(h_s, pos_s, cache_ckv[a], cache_kpe[a], p)
            ckv_p_l.append(ckv_p)
            kpe_p_l.append(kpe_p)
            ckv_s_l.append(ckv_s)
            kpe_s_l.append(kpe_s)
        else:
            b = i // N_MIXERS
            p = {'w_in': cm_w_in[b], 'g_v': cm_g_v[b], 'w_s': cm_w_s[b], 'b_s': cm_b_s[b], 'w_o': cm_w_o[b]}
            m_p, _ = chunk_mlp_mixer(h_p, idx_p, p)
            m_s, v_s = chunk_mlp_mixer(h_s, idx_s, p)
            v_s_l.append(v_s)
        x_p = x_p + gt1_p[:, None, :] * m_p
        x_s = x_s + gt1_s[:, None, :] * m_s
        f_p = sq_relu_ffn(modulated_norm(x_p, norm2_g[i], sh2_p, sc2_p), ffn_w1[i], ffn_w2[i])
        f_s = sq_relu_ffn(modulated_norm(x_s, norm2_g[i], sh2_s, sc2_s), ffn_w1[i], ffn_w2[i])
        x_p = x_p + gt2_p[:, None, :] * f_p
        x_s = x_s + gt2_s[:, None, :] * f_s

    return (x_p, x_s, jnp.stack(ckv_p_l), jnp.stack(kpe_p_l), jnp.stack(ckv_s_l), jnp.stack(kpe_s_l), jnp.stack(v_s_l))
```

```cpp
#include <hip/hip_runtime.h>
#include <hip/hip_cooperative_groups.h>
#include <cstdio>
#include <cstdint>
namespace cg = cooperative_groups;

#define LAS __attribute__((address_space(3)))
typedef unsigned short bf16_t;
typedef short bf16x8 __attribute__((ext_vector_type(8)));
typedef short s16x4 __attribute__((ext_vector_type(4)));
typedef float f32x4 __attribute__((ext_vector_type(4)));
typedef float f32x2 __attribute__((ext_vector_type(2)));
typedef float f32x16 __attribute__((ext_vector_type(16)));
typedef unsigned u32x4 __attribute__((ext_vector_type(4)));
typedef unsigned u32x2 __attribute__((ext_vector_type(2)));

constexpr int DM = 1024, NB_P = 8, SEQ = 4096, NB_S = 32, DSEQ = 16, PAST = 4096;
constexpr int MP = NB_P * SEQ;
constexpr int MS = NB_S * DSEQ;
constexpr int MT = MP + MS;
constexpr int NSEQ = NB_P + NB_S;
constexpr int NH = 8, DNOPE = 128, DROPE = 64, DV = 128, QLORA = 384, KVLORA = 256, DFF = 4096;
constexpr int NCACHE = NB_S * PAST;
constexpr int MKN = MT + NCACHE;
constexpr int VTP = 33536;
constexpr float EPS = 1e-6f;
constexpr float SM_SCALE = 0.07216878364870322f;
constexpr int NSPLIT = 4;
constexpr size_t OUT_Y = 0, OUT_CKVP = (size_t)MT * DM, OUT_KPEP = OUT_CKVP + (size_t)MP * 256, OUT_CKVS = OUT_KPEP + (size_t)MP * 64,
                 OUT_KPES = OUT_CKVS + (size_t)MS * 256, OUT_VS = OUT_KPES + (size_t)MS * 64, OUT_END = OUT_VS + (size_t)MS * DM;
constexpr size_t MiB = 1u << 20;
constexpr size_t WS_CTL = 0, CTL_BYTES = 32768;
constexpr size_t WS_WIN = 1 * MiB;
constexpr size_t WS_WQ = WS_WIN + 768 * 1024 * 2;
constexpr size_t WS_WUK = WS_WQ + 1536 * 384 * 2;
constexpr size_t WS_WUV = WS_WUK + 1024 * 256 * 2;
constexpr size_t WS_WUKN = WS_WUV + 1024 * 256 * 2;
constexpr size_t WS_WO = WS_WUKN + 1024 * 256 * 2;
constexpr size_t WS_W1 = WS_WO + 1024 * 1024 * 2;
constexpr size_t WS_W2 = WS_W1 + 2ull * 4096 * 1024 * 2;
constexpr size_t WS_CWIN = WS_W2 + 2ull * 4096 * 1024 * 2;
constexpr size_t WS_CWO = WS_CWIN + 2048 * 1024 * 2;
constexpr size_t WS_WEND = WS_CWO + 1024 * 1024 * 2;
static_assert(WS_WEND <= 46 * MiB, "weights");
constexpr size_t WS_MODF = 46 * MiB;
constexpr size_t WS_SSV = 48 * MiB;
constexpr size_t WS_PBUF = 50 * MiB;
constexpr int KSPL = 8;
constexpr size_t WS_PART = 50 * MiB;
constexpr size_t WS_ML = 66 * MiB;
constexpr size_t WS_H = 67 * MiB;
constexpr size_t WS_A0 = 132 * MiB;
constexpr size_t WS_CQ = 230 * MiB;
constexpr size_t WS_CKV = 255 * MiB;
constexpr size_t WS_KR = 336 * MiB;
constexpr size_t WS_KPE = 341 * MiB;
constexpr size_t WS_RS = 357 * MiB;
constexpr size_t WS_KN = 363 * MiB;
constexpr size_t WS_V = 428 * MiB;
constexpr size_t WS_END = 493 * MiB;
constexpr size_t WS_HF = 132 * MiB;
constexpr size_t WS_U = 132 * MiB;
constexpr size_t WS_VT = 197 * MiB;
constexpr size_t WS_G = 263 * MiB;
static_assert(WS_CKV + (size_t)MKN * 256 * 2 <= WS_KR && WS_RS + (size_t)MKN * 32 <= WS_KN && WS_V + (size_t)MT * 2048 <= WS_END, "ws map");
static_assert(WS_VT + (size_t)1024 * VTP * 2 <= WS_G && WS_HF + (size_t)MT * 8192 <= WS_END, "ws map 2");
constexpr int LDS_BYTES = 147456;
constexpr int LDS_RED = 131072;
constexpr int LDS_MISC = 147392;

typedef __bf16 bf16x2_t __attribute__((ext_vector_type(2)));
__device__ __forceinline__ unsigned cvt_pk_bf16(float lo, float hi) { const f32x2 v = {lo, hi}; const bf16x2_t b = __builtin_convertvector(v, bf16x2_t); return __builtin_bit_cast(unsigned, b); }
__device__ __forceinline__ float bf2f(bf16_t b) { return __uint_as_float(((unsigned)b) << 16); }
__device__ __forceinline__ float bflo(unsigned w) { return __uint_as_float(w << 16); }
__device__ __forceinline__ float bfhi(unsigned w) { return __uint_as_float(w & 0xffff0000u); }
__device__ __forceinline__ bf16_t f2bf(float f) { return (bf16_t)(cvt_pk_bf16(f, 0.f) & 0xffffu); }
template <int X> __device__ __forceinline__ float swz_xor(float v) { return __int_as_float(__builtin_amdgcn_ds_swizzle(__float_as_int(v), (X << 10) | 0x1f)); }
__device__ __forceinline__ float sum_x32(float v) { auto rr = __builtin_amdgcn_permlane32_swap(__float_as_uint(v), __float_as_uint(v), false, false); return __uint_as_float(rr[0]) + __uint_as_float(rr[1]); }
__device__ __forceinline__ float wave_sum(float v) { v += swz_xor<1>(v); v += swz_xor<2>(v); v += swz_xor<4>(v); v += swz_xor<8>(v); v += swz_xor<16>(v); return sum_x32(v); }
__device__ __forceinline__ float gelu_tanh(float x) {
    const float u = 0.7978845608028654f * (x + 0.044715f * x * x * x);
    return x * __builtin_amdgcn_rcpf(1.f + __builtin_amdgcn_exp2f(-2.885390081777927f * u));
}
__device__ __forceinline__ void sincos_rev(float ang, float& s, float& c) {
    float rev = ang * 0.15915494309189535f; rev -= floorf(rev);
    s = __builtin_amdgcn_sinf(rev); c = __builtin_amdgcn_cosf(rev);
}
__device__ __forceinline__ float rope_inv(int i) { return __builtin_amdgcn_exp2f(-(float)i * (13.287712379549449f / 32.f)); }
__device__ __forceinline__ int row_pos(int r) { return r < MP ? (r & (SEQ - 1)) : PAST + ((r - MP) & (DSEQ - 1)); }
__device__ __forceinline__ int row_seq(int r) { return r < MP ? (r >> 12) : NB_P + ((r - MP) >> 4); }

namespace pg8 {
#define PG8_LAS __attribute__((address_space(3)))
constexpr int BM = 256, BK = 64, HALF = 128, HTB = HALF * BK * 2  , STAGE_BYTES = 8 * HTB, NXCD = 8, WGM = 8;
__host__ __device__ __forceinline__ int lds_byte(int r, int c) { const int st = (r >> 4) * 2 + (c >> 5), rr = r & 15, cc = c & 31, ob = rr * 64 + cc * 2; return st * 1024 + (ob ^ (((ob >> 9) & 1) << 5)); }
__host__ __device__ __forceinline__ void stage_rc(int b, int& R, int& C) { const int st = b / 1024, sb = b % 1024, swz = sb ^ (((sb >> 9) & 1) << 5); R = (st >> 1) * 16 + swz / 64; C = (st & 1) * 32 + (swz % 64) / 2; }
__host__ __device__ __forceinline__ int perm32(int rho) { const int n = rho >> 4, i = rho & 15; return 8 * (i >> 2) + 4 * n + (i & 3); }
struct Unit { int pm, pn, pk; };
struct Gemm { const bf16_t* A; const bf16_t* Bt; int M, N, K, ld; };
struct StaticOrder {
    int nM, nN, nwg, G, c;
    __host__ __device__ void init(int M, int N, int G_, int c_) { nM = M / BM; nN = N / BM; nwg = nM * nN; G = G_; c = c_; }
    __host__ __device__ bool next(int i, Unit& u) const {
        const long L = (long)i * G + c; if (L >= nwg) return false;
        int wgid = (int)L; { const int q = nwg / NXCD, r = nwg % NXCD, xcd = wgid % NXCD, off = wgid / NXCD; wgid = (xcd < r ? xcd * (q + 1) : r * (q + 1) + (xcd - r) * q) + off; }
        const int nig = WGM * nN, gid = wgid / nig, fm = gid * WGM, gsz = (nM - fm) < WGM ? (nM - fm) : WGM;
        u.pm = fm + ((wgid % nig) % gsz); u.pn = (wgid % nig) / gsz; u.pk = 0; return true;
    }
    __device__ __forceinline__ void a_ready(const Unit&) const {}
    __device__ __forceinline__ void done(const Unit&) const {}
};
struct TailOrder {
    int nM, nN, KS, G, c;
    __host__ __device__ void init(int M, int N, int KS_, int G_, int c_) { nM = M / BM; nN = N / BM; KS = KS_; G = G_; c = c_; }
    __host__ __device__ bool next(int i, Unit& u) const {
        const long L = (long)i * G + c; if (L >= (long)nM * nN * KS) return false;
        const int t = (int)L % (nM * nN); u.pk = (int)L / (nM * nN); u.pm = t % nM; u.pn = t / nM; return true;
    }
    __device__ __forceinline__ void a_ready(const Unit&) const {}
    __device__ __forceinline__ void done(const Unit&) const {}
};
template <class Epi, class Sched, bool ALIGN_EPI = false, bool SP2 = false>
__device__ __forceinline__ void gemm_phase(PG8_LAS unsigned char* lds, const Gemm g, const Sched& S, const Epi& E) {
    int tid_l = threadIdx.x; asm volatile("" : "+v"(tid_l));
    const int tid = tid_l, wid = __builtin_amdgcn_readfirstlane(tid >> 6), lane = tid & 63, wr = wid >> 2, wc = wid & 3, fr = lane & 15, fq = lane >> 4;
    const int K = g.K, nt = K / BK, ld = g.ld;
    unsigned voffA[2], voffB[2];
#pragma unroll
    for (int i = 0; i < 2; ++i) { int R, C; stage_rc(tid * 16 + i * 8192, R, C); const int Rb = Epi::PERM ? ((R & ~31) + perm32(R & 31)) : R;
        voffA[i] = (unsigned)(R * ld + C) * 2u; voffB[i] = (unsigned)(Rb * ld + C) * 2u; }
    const size_t kstep = (size_t)(BK * 2);
    const size_t hstep = (size_t)HALF * ld * 2;
    const size_t tstep = 2 * hstep;
    const unsigned ldsw = (unsigned)wid * 1024u;
    const int aoff = lds_byte(wr * 64 + fr, fq * 8), boff = lds_byte(wc * 32 + fr, fq * 8);
#define PG8_SA(b, h) (((b) * 2 + (h)) * HTB)
#define PG8_SB(b, h) ((4 + (b) * 2 + (h)) * HTB)
#define PG8_STAGE(bufoff, gbase, voff) do { _Pragma("unroll") for (int _i = 0; _i < 2; ++_i) \
        __builtin_amdgcn_global_load_lds((const unsigned*)((const char*)(gbase) + (voff)[_i]), (PG8_LAS unsigned*)(lds + (bufoff) + ldsw + _i * 8192), 16, 0, 0); } while (0)
#define PG8_LDA(dst, b, h) do { _Pragma("unroll") for (int m = 0; m < 4; ++m) _Pragma("unroll") for (int k = 0; k < 2; ++k) dst[m][k] = *(const PG8_LAS bf16x8*)(lds + PG8_SA(b, h) + aoff + m * 2048 + k * 1024); } while (0)
#define PG8_LDB(dst, b, h) do { _Pragma("unroll") for (int n = 0; n < 2; ++n) _Pragma("unroll") for (int k = 0; k < 2; ++k) dst[n][k] = *(const PG8_LAS bf16x8*)(lds + PG8_SB(b, h) + boff + n * 2048 + k * 1024); } while (0)
#define PG8_MMA(ai, bj, At, Bt) do { __builtin_amdgcn_s_setprio(1); _Pragma("unroll") for (int m = 0; m < 4; ++m) _Pragma("unroll") for (int n = 0; n < 2; ++n) _Pragma("unroll") for (int k = 0; k < 2; ++k) \
        acc[ai][bj][m][n] = __builtin_amdgcn_mfma_f32_16x16x32_bf16(Bt[n][k], At[m][k], acc[ai][bj][m][n], 0, 0, 0); __builtin_amdgcn_s_setprio(0); } while (0)
#define PG8_WAIT_V(n) asm volatile("s_waitcnt vmcnt(" #n ")" ::: "memory")
#define PG8_WAIT_L(n) asm volatile("s_waitcnt lgkmcnt(" #n ")" ::: "memory")
#define PG8_BAR __builtin_amdgcn_s_barrier()
#define PG8_SCHED __builtin_amdgcn_sched_barrier(0)
    Unit cur, nxt; int ui = 0;
    if (!S.next(0, cur)) return;
    f32x4 acc[2][2][4][2];
#pragma unroll
    for (int a = 0; a < 2; ++a)
#pragma unroll
        for (int b = 0; b < 2; ++b)
#pragma unroll
            for (int m = 0; m < 4; ++m)
#pragma unroll
                for (int n = 0; n < 2; ++n) acc[a][b][m][n] = (f32x4){0.f, 0.f, 0.f, 0.f};
    bf16x8 At[4][2], B0[2][2], B1[2][2];
    const char* cA = (const char*)g.A + (size_t)cur.pm * tstep + (size_t)cur.pk * K * 2; const char* cB = (const char*)g.Bt + (size_t)cur.pn * tstep + (size_t)cur.pk * K * 2;
    S.a_ready(cur);
    if constexpr (SP2) {
        PG8_STAGE(PG8_SB(0, 0), cB, voffB); PG8_STAGE(PG8_SB(0, 1), cB + hstep, voffB); PG8_STAGE(PG8_SA(0, 0), cA, voffA); PG8_STAGE(PG8_SA(0, 1), cA + hstep, voffA);
        if (wr == 1) PG8_BAR;
        PG8_WAIT_V(2); PG8_BAR;
        PG8_STAGE(PG8_SB(1, 0), cB + kstep, voffB); PG8_STAGE(PG8_SA(1, 0), cA + kstep, voffA); PG8_STAGE(PG8_SB(1, 1), cB + hstep + kstep, voffB);
        PG8_WAIT_V(6); PG8_BAR;
    } else {
        PG8_STAGE(PG8_SB(0, 0), cB, voffB); PG8_STAGE(PG8_SA(0, 0), cA, voffA); PG8_STAGE(PG8_SB(0, 1), cB + hstep, voffB); PG8_STAGE(PG8_SA(0, 1), cA + hstep, voffA);
        if (wr == 1) PG8_BAR;
        PG8_WAIT_V(4); PG8_BAR;
        PG8_STAGE(PG8_SB(1, 0), cB + kstep, voffB); PG8_STAGE(PG8_SA(1, 0), cA + kstep, voffA); PG8_STAGE(PG8_SB(1, 1), cB + hstep + kstep, voffB);
        PG8_WAIT_V(6); PG8_BAR;
    }
    for (;;) {
        const bool has_next = S.next(ui + 1, nxt);
        const char* nA = has_next ? (const char*)g.A + (size_t)nxt.pm * tstep + (size_t)nxt.pk * K * 2 : cA; const char* nB = has_next ? (const char*)g.Bt + (size_t)nxt.pn * tstep + (size_t)nxt.pk * K * 2 : cB;
        for (int t = 0; t < nt; t += 2) {
            const bool last = (t == nt - 2);
            const char* a1 = cA + (size_t)(t + 1) * kstep;
            const char* a2 = last ? nA : cA + (size_t)(t + 2) * kstep; const char* b2 = last ? nB : cB + (size_t)(t + 2) * kstep;
            const char* a3 = a2 + kstep; const char* b3 = b2 + kstep;
            if (last && has_next) S.a_ready(nxt);
            if constexpr (SP2) {
            PG8_LDB(B0, 0, 0); PG8_LDB(B1, 0, 1); PG8_SCHED; PG8_LDA(At, 0, 0); PG8_STAGE(PG8_SA(1, 1), a1 + hstep, voffA);
            PG8_WAIT_V(8); PG8_WAIT_L(0); PG8_BAR; PG8_MMA(0, 0, At, B0); PG8_MMA(0, 1, At, B1); PG8_BAR; PG8_SCHED;
            PG8_LDA(At, 0, 1); PG8_STAGE(PG8_SB(0, 0), b2, voffB); PG8_STAGE(PG8_SB(0, 1), b2 + hstep, voffB); PG8_STAGE(PG8_SA(0, 0), a2, voffA);
            PG8_WAIT_V(8); PG8_WAIT_L(0); PG8_BAR; PG8_MMA(1, 0, At, B0); PG8_MMA(1, 1, At, B1); PG8_BAR; PG8_SCHED;
            PG8_LDB(B0, 1, 0); PG8_LDB(B1, 1, 1); PG8_SCHED; PG8_LDA(At, 1, 0); PG8_STAGE(PG8_SA(0, 1), a2 + hstep, voffA);
            PG8_WAIT_V(8); PG8_WAIT_L(0); PG8_BAR; PG8_MMA(0, 0, At, B0); PG8_MMA(0, 1, At, B1); PG8_BAR; PG8_SCHED;
            PG8_LDA(At, 1, 1); PG8_STAGE(PG8_SB(1, 0), b3, voffB); PG8_STAGE(PG8_SB(1, 1), b3 + hstep, voffB); PG8_STAGE(PG8_SA(1, 0), a3, voffA);
            PG8_WAIT_V(8); PG8_WAIT_L(0); PG8_BAR; PG8_MMA(1, 0, At, B0); PG8_MMA(1, 1, At, B1); PG8_BAR; PG8_SCHED;
            } else {
            PG8_LDB(B0, 0, 0); PG8_SCHED; PG8_LDA(At, 0, 0); PG8_STAGE(PG8_SA(1, 1), a1 + hstep, voffA);
            PG8_WAIT_L(8); PG8_BAR; PG8_WAIT_L(0); PG8_MMA(0, 0, At, B0); PG8_BAR; PG8_SCHED;
            PG8_LDB(B1, 0, 1); PG8_STAGE(PG8_SB(0, 0), b2, voffB);
            PG8_BAR; PG8_WAIT_L(0); PG8_MMA(0, 1, At, B1); PG8_BAR;
            PG8_LDA(At, 0, 1); PG8_STAGE(PG8_SA(0, 0), a2, voffA);
            PG8_BAR; PG8_WAIT_L(0); PG8_MMA(1, 0, At, B0); PG8_BAR; PG8_SCHED;
            PG8_STAGE(PG8_SB(0, 1), b2 + hstep, voffB);
            PG8_WAIT_V(6); PG8_BAR; PG8_MMA(1, 1, At, B1); PG8_BAR;
            PG8_LDB(B0, 1, 0); PG8_SCHED; PG8_LDA(At, 1, 0); PG8_STAGE(PG8_SA(0, 1), a2 + hstep, voffA);
            PG8_WAIT_L(8); PG8_BAR; PG8_WAIT_L(0); PG8_MMA(0, 0, At, B0); PG8_BAR; PG8_SCHED;
            PG8_LDB(B1, 1, 1); PG8_STAGE(PG8_SB(1, 0), b3, voffB);
            PG8_BAR; PG8_WAIT_L(0); PG8_MMA(0, 1, At, B1); PG8_BAR;
            PG8_LDA(At, 1, 1); PG8_STAGE(PG8_SA(1, 0), a3, voffA);
            PG8_BAR; PG8_WAIT_L(0); PG8_MMA(1, 0, At, B0); PG8_BAR; PG8_SCHED;
            PG8_STAGE(PG8_SB(1, 1), b3 + hstep, voffB);
            PG8_WAIT_V(6); PG8_BAR; PG8_MMA(1, 1, At, B1); PG8_BAR;
            }
        }
        if constexpr (ALIGN_EPI) { if (wr == 0) PG8_BAR; }
        if constexpr (!Epi::AFTER_DRAIN) { E(acc, cur, wr, wc, fr, fq); S.done(cur); }
        if (!has_next) break;
#pragma unroll
        for (int a = 0; a < 2; ++a)
#pragma unroll
            for (int b = 0; b < 2; ++b)
#pragma unroll
                for (int m = 0; m < 4; ++m)
#pragma unroll
                    for (int n = 0; n < 2; ++n) acc[a][b][m][n] = (f32x4){0.f, 0.f, 0.f, 0.f};
        cur = nxt; cA = nA; cB = nB; ++ui;
        if constexpr (ALIGN_EPI) { if (wr == 1) PG8_BAR; }
    }
    PG8_WAIT_V(0);
    if constexpr (!ALIGN_EPI) { if (wr == 0) PG8_BAR; }
    PG8_BAR;
    if constexpr (Epi::AFTER_DRAIN) { E.fused(acc, cur, wr, wc, fr, fq, lds, wid, lane); S.done(cur); }
#undef PG8_SA
#undef PG8_SB
#undef PG8_STAGE
#undef PG8_LDA
#undef PG8_LDB
#undef PG8_MMA
#undef PG8_WAIT_V
#undef PG8_WAIT_L
#undef PG8_BAR
#undef PG8_SCHED
}
}

typedef f32x4 AccT[2][2][4][2];

struct EpiF32 {
    static constexpr bool PERM = false, AFTER_DRAIN = false;
    float* O; int ldc;
    __device__ __forceinline__ void operator()(const AccT& acc, const pg8::Unit& u, int wr, int wc, int fr, int fq) const {
        asm volatile("" : "+v"(fr), "+v"(fq));
        const int row0 = u.pm * 256 + wr * 64 + fr, col0 = u.pn * 256 + wc * 32 + 4 * fq;
#pragma unroll
        for (int ai = 0; ai < 2; ++ai)
#pragma unroll
            for (int m = 0; m < 4; ++m) { float* rowp = O + (size_t)(row0 + ai * 128 + m * 16) * ldc + col0;
#pragma unroll
                for (int bj = 0; bj < 2; ++bj)
#pragma unroll
                    for (int n = 0; n < 2; ++n) *(f32x4*)(rowp + bj * 128 + n * 16) = acc[ai][bj][m][n]; }
    }
};
struct EpiPart {
    static constexpr bool PERM = false, AFTER_DRAIN = false;
    float* P;
    __device__ __forceinline__ void operator()(const AccT& acc, const pg8::Unit& u, int wr, int wc, int fr, int fq) const {
        asm volatile("" : "+v"(fr), "+v"(fq));
        const int row0 = u.pm * 256 + wr * 64 + fr, col0 = u.pn * 256 + wc * 32 + 4 * fq;
        float* O = P + (size_t)u.pk * MS * DM;
#pragma unroll
        for (int ai = 0; ai < 2; ++ai)
#pragma unroll
            for (int m = 0; m < 4; ++m) { float* rowp = O + (size_t)(row0 + ai * 128 + m * 16) * DM + col0;
#pragma unroll
                for (int bj = 0; bj < 2; ++bj)
#pragma unroll
                    for (int n = 0; n < 2; ++n) *(f32x4*)(rowp + bj * 128 + n * 16) = acc[ai][bj][m][n]; }
    }
};
struct EpiResid {
    static constexpr bool PERM = false, AFTER_DRAIN = false;
    const float* xp; float* out; const float* gate;
    __device__ __forceinline__ void operator()(const AccT& acc, const pg8::Unit& u, int wr, int wc, int fr, int fq) const {
        asm volatile("" : "+v"(fr), "+v"(fq));
        const int row0 = u.pm * 256 + wr * 64 + fr, col0 = u.pn * 256 + wc * 32 + 4 * fq;
        const float* gp = gate + (size_t)(u.pm >> 4) * 6144 + col0;
        f32x4 gv[2][2];
#pragma unroll
        for (int bj = 0; bj < 2; ++bj)
#pragma unroll
            for (int n = 0; n < 2; ++n) gv[bj][n] = *(const f32x4*)(gp + bj * 128 + n * 16);
#pragma unroll
        for (int ai = 0; ai < 2; ++ai) {
            f32x4 xv[4][2][2];
#pragma unroll
            for (int m = 0; m < 4; ++m) { const float* xr = xp + (size_t)(row0 + ai * 128 + m * 16) * DM + col0;
#pragma unroll
                for (int bj = 0; bj < 2; ++bj)
#pragma unroll
                    for (int n = 0; n < 2; ++n) xv[m][bj][n] = *(const f32x4*)(xr + bj * 128 + n * 16); }
#pragma unroll
            for (int m = 0; m < 4; ++m) { float* op = out + (size_t)(row0 + ai * 128 + m * 16) * DM + col0;
#pragma unroll
                for (int bj = 0; bj < 2; ++bj)
#pragma unroll
                    for (int n = 0; n < 2; ++n) *(f32x4*)(op + bj * 128 + n * 16) = xv[m][bj][n] + gv[bj][n] * acc[ai][bj][m][n]; }
        }
    }
};
template <int ACT> struct EpiBf16 {
    static constexpr bool PERM = true, AFTER_DRAIN = false;
    bf16_t* O; int ldc;
    __device__ __forceinline__ void operator()(const AccT& acc, const pg8::Unit& u, int wr, int wc, int fr, int fq) const {
        asm volatile("" : "+v"(fr), "+v"(fq));
        const int row0 = u.pm * 256 + wr * 64 + fr, col0 = u.pn * 256 + wc * 32 + 8 * fq;
#pragma unroll
        for (int ai = 0; ai < 2; ++ai)
#pragma unroll
            for (int m = 0; m < 4; ++m) { bf16_t* rowp = O + (size_t)(row0 + ai * 128 + m * 16) * ldc + col0;
#pragma unroll
                for (int bj = 0; bj < 2; ++bj) { f32x4 v0 = acc[ai][bj][m][0], v1 = acc[ai][bj][m][1];
                    if (ACT == 1) {
#pragma unroll
                        for (int j = 0; j < 4; ++j) { const float a = fmaxf(v0[j], 0.f), b = fmaxf(v1[j], 0.f); v0[j] = a * a; v1[j] = b * b; } }
                    if (ACT == 2) {
#pragma unroll
                        for (int j = 0; j < 4; ++j) { v0[j] = gelu_tanh(v0[j]); v1[j] = gelu_tanh(v1[j]); } }
                    u32x4 w; w.x = cvt_pk_bf16(v0[0], v0[1]); w.y = cvt_pk_bf16(v0[2], v0[3]); w.z = cvt_pk_bf16(v1[0], v1[1]); w.w = cvt_pk_bf16(v1[2], v1[3]);
                    *(u32x4*)(rowp + bj * 128) = w; } }
    }
};
struct EpiVT {
    static constexpr bool PERM = true, AFTER_DRAIN = false;
    bf16_t* VT; float* SSV;
    __device__ __forceinline__ void operator()(const AccT& acc, const pg8::Unit& u, int wr, int wc, int fr, int fq) const {
        asm volatile("" : "+v"(fr), "+v"(fq));
        const int row0 = u.pm * 256 + wr * 64 + fr, col0 = u.pn * 256 + wc * 32 + 8 * fq;
        float s[2][2][4];
#pragma unroll
        for (int bj = 0; bj < 2; ++bj)
#pragma unroll
            for (int n = 0; n < 2; ++n)
#pragma unroll
                for (int j = 0; j < 4; ++j) s[bj][n][j] = 0.f;
#pragma unroll
        for (int ai = 0; ai < 2; ++ai)
#pragma unroll
            for (int m = 0; m < 4; ++m) { bf16_t* rowp = VT + (size_t)(row0 + ai * 128 + m * 16) * VTP + col0;
#pragma unroll
                for (int bj = 0; bj < 2; ++bj) { f32x4 v0 = acc[ai][bj][m][0], v1 = acc[ai][bj][m][1];
#pragma unroll
                    for (int j = 0; j < 4; ++j) { v0[j] = gelu_tanh(v0[j]); v1[j] = gelu_tanh(v1[j]); s[bj][0][j] += v0[j] * v0[j]; s[bj][1][j] += v1[j] * v1[j]; }
                    u32x4 w; w.x = cvt_pk_bf16(v0[0], v0[1]); w.y = cvt_pk_bf16(v0[2], v0[3]); w.z = cvt_pk_bf16(v1[0], v1[1]); w.w = cvt_pk_bf16(v1[2], v1[3]);
                    *(u32x4*)(rowp + bj * 128) = w; } }
        float* sp = SSV + (size_t)(u.pm * 2 + wr) * VTP + col0;
#pragma unroll
        for (int bj = 0; bj < 2; ++bj)
#pragma unroll
            for (int n = 0; n < 2; ++n) { f32x4 t;
#pragma unroll
                for (int j = 0; j < 4; ++j) { float x = s[bj][n][j]; x += swz_xor<1>(x); x += swz_xor<2>(x); x += swz_xor<4>(x); x += swz_xor<8>(x); t[j] = x; }
                if (fr == 0) *(f32x4*)(sp + bj * 128 + n * 4) = t; }
    }
};
__device__ __forceinline__ void head_ss(const AccT& acc, LAS float* red, int wr, int wc, int fr, int fq) {
    LAS float* rw = red + (wr * 64 + fr) * 8 + wc;
#pragma unroll
    for (int ai = 0; ai < 2; ++ai)
#pragma unroll
        for (int m = 0; m < 4; ++m)
#pragma unroll
            for (int bj = 0; bj < 2; ++bj) { const f32x4 a = acc[ai][bj][m][0], b = acc[ai][bj][m][1];
                float s = (a[0] * a[0] + a[1] * a[1]) + (a[2] * a[2] + a[3] * a[3]) + (b[0] * b[0] + b[1] * b[1]) + (b[2] * b[2] + b[3] * b[3]);
                s += swz_xor<16>(s); s = sum_x32(s);
                if (fq == 0) rw[(ai * 128 + m * 16) * 8 + bj * 4] = s; }
    asm volatile("s_waitcnt lgkmcnt(0)" ::: "memory"); __builtin_amdgcn_s_barrier(); asm volatile("" ::: "memory");
}
__device__ __forceinline__ float head_rs(const LAS float* red, int rowl, int bj) {
    const f32x4 t = *(const LAS f32x4*)(red + rowl * 8 + bj * 4);
    return __builtin_amdgcn_rsqf(((t[0] + t[1]) + (t[2] + t[3])) * (1.f / 128.f) + EPS);
}
__device__ __forceinline__ void head_done() { asm volatile("s_waitcnt lgkmcnt(0)" ::: "memory"); __builtin_amdgcn_s_barrier(); asm volatile("" ::: "memory"); }
struct EpiKN {
    static constexpr bool PERM = true, AFTER_DRAIN = false;
    bf16_t* KN; float* RS; const float* g; LAS float* red; int pm_off;
    __device__ __forceinline__ void operator()(const AccT& acc, const pg8::Unit& u, int wr, int wc, int fr, int fq) const {
        asm volatile("" : "+v"(fr), "+v"(fq));
        head_ss(acc, red, wr, wc, fr, fq);
        const int pmg = u.pm + pm_off; const int row0 = pmg * 256 + wr * 64 + fr, d0 = wc * 32 + 8 * fq;
        const float* gl = g + d0; asm volatile("" : "+v"(gl)); const f32x4 g0 = *(const f32x4*)gl, g1 = *(const f32x4*)(gl + 4);
#pragma unroll
        for (int ai = 0; ai < 2; ++ai)
#pragma unroll
            for (int m = 0; m < 4; ++m) { const int r = row0 + ai * 128 + m * 16;
#pragma unroll
                for (int bj = 0; bj < 2; ++bj) { const float s = head_rs(red + (wr * 64 + fr) * 8, ai * 128 + m * 16, bj); const int h = 2 * u.pn + bj;
                    if (wc == 0 && fq == 0) RS[(size_t)r * 8 + h] = s;
                    if (pmg < MT / 256) { const f32x4 v0 = acc[ai][bj][m][0] * s * g0, v1 = acc[ai][bj][m][1] * s * g1;
                        u32x4 w; w.x = cvt_pk_bf16(v0[0], v0[1]); w.y = cvt_pk_bf16(v0[2], v0[3]); w.z = cvt_pk_bf16(v1[0], v1[1]); w.w = cvt_pk_bf16(v1[2], v1[3]);
                        *(u32x4*)(KN + (size_t)r * 1024 + h * 128 + d0) = w; } } }
        head_done();
    }
};
struct EpiQ {
    static constexpr bool PERM = true, AFTER_DRAIN = false;
    bf16_t* Q; const float* gqn; const float* gqr; LAS float* red;
    __device__ __forceinline__ void operator()(const AccT& acc, const pg8::Unit& u, int wr, int wc, int fr, int fq) const {
        asm volatile("" : "+v"(fr), "+v"(fq));
        const int row0 = u.pm * 256 + wr * 64 + fr;
        if (u.pn < 4) {
            head_ss(acc, red, wr, wc, fr, fq);
            const int d0 = wc * 32 + 8 * fq;
            const float* gl = gqn + d0; asm volatile("" : "+v"(gl)); const f32x4 g0 = *(const f32x4*)gl, g1 = *(const f32x4*)(gl + 4);
#pragma unroll
            for (int ai = 0; ai < 2; ++ai)
#pragma unroll
                for (int m = 0; m < 4; ++m) { const int r = row0 + ai * 128 + m * 16;
#pragma unroll
                    for (int bj = 0; bj < 2; ++bj) { const float s = head_rs(red + (wr * 64 + fr) * 8, ai * 128 + m * 16, bj); const int h = 2 * u.pn + bj;
                        const f32x4 v0 = acc[ai][bj][m][0] * s * g0, v1 = acc[ai][bj][m][1] * s * g1;
                        u32x4 w; w.x = cvt_pk_bf16(v0[0], v0[1]); w.y = cvt_pk_bf16(v0[2], v0[3]); w.z = cvt_pk_bf16(v1[0], v1[1]); w.w = cvt_pk_bf16(v1[2], v1[3]);
                        *(u32x4*)(Q + (size_t)r * 1536 + h * 192 + d0) = w; } }
            head_done();
        } else {
            const int h = (u.pn - 4) * 4 + wc, i0c = 8 * fq;
            float gqa[8], gqb[8]; { const float* gl = gqr + i0c; asm volatile("" : "+v"(gl));
#pragma unroll
                for (int t = 0; t < 8; ++t) { gqa[t] = gl[t]; gqb[t] = gl[32 + t]; } }
#pragma unroll
            for (int ai = 0; ai < 2; ++ai)
#pragma unroll
                for (int m = 0; m < 4; ++m) { const int r = row0 + ai * 128 + m * 16; int i0 = i0c; asm volatile("" : "+v"(i0));
                    float ss = 0.f;
#pragma unroll
                    for (int n = 0; n < 2; ++n)
#pragma unroll
                        for (int j = 0; j < 4; ++j) { const float a = acc[ai][0][m][n][j], b = acc[ai][1][m][n][j]; ss += a * a + b * b; }
                    ss += swz_xor<16>(ss); ss = sum_x32(ss);
                    const float s = __builtin_amdgcn_rsqf(ss * (1.f / 64.f) + EPS); const float pos = (float)row_pos(r);
                    unsigned w1[4], w2[4];
#pragma unroll
                    for (int tp = 0; tp < 4; ++tp) { float oa[2], ob[2];
#pragma unroll
                        for (int e = 0; e < 2; ++e) { const int t = 2 * tp + e; float sn, cs; sincos_rev(pos * rope_inv(i0 + t), sn, cs);
                            const float y1 = acc[ai][0][m][t >> 2][t & 3] * s * gqa[t], y2 = acc[ai][1][m][t >> 2][t & 3] * s * gqb[t];
                            oa[e] = y1 * cs - y2 * sn; ob[e] = y2 * cs + y1 * sn; }
                        w1[tp] = cvt_pk_bf16(oa[0], oa[1]); w2[tp] = cvt_pk_bf16(ob[0], ob[1]); }
                    bf16_t* qp = Q + (size_t)r * 1536 + h * 192 + 128 + i0;
                    *(u32x4*)qp = (u32x4){w1[0], w1[1], w1[2], w1[3]}; *(u32x4*)(qp + 32) = (u32x4){w2[0], w2[1], w2[2], w2[3]};
                    asm volatile("" ::: "memory"); }
        }
    }
};

struct Args { const float* in[28]; float* out; unsigned char* ws; int ph_lo, ph_hi; };
struct Frame {
    LAS unsigned char* lds;
    int G;
    const float* const* in; float* out; unsigned char* ws;
};
#define LOCAL_IDS() int tid_l_ = threadIdx.x; asm volatile("" : "+v"(tid_l_)); const int tid = tid_l_, lane = tid & 63, wave = __builtin_amdgcn_readfirstlane(tid >> 6); (void)tid; (void)lane; (void)wave
#define LDS_WAIT() asm volatile("s_waitcnt lgkmcnt(0)" ::: "memory")

__device__ __forceinline__ void transpose_block(const float* W, int K, int N, bf16_t* WT, int k0, int n0, int drow, LAS float* scr, int lane) {
#pragma unroll 8
    for (int i = 0; i < 32; ++i) { const int kk = 2 * i + (lane >> 5); scr[kk * 33 + (lane & 31)] = W[(size_t)(k0 + kk) * N + n0 + (lane & 31)]; }
    LDS_WAIT(); asm volatile("" ::: "memory");
    const int c = lane & 7;
#pragma unroll
    for (int j = 0; j < 4; ++j) { const int n = (lane >> 3) + 8 * j; const LAS float* s = scr + (8 * c) * 33 + n;
        u32x4 o; o.x = cvt_pk_bf16(s[0 * 33], s[1 * 33]); o.y = cvt_pk_bf16(s[2 * 33], s[3 * 33]); o.z = cvt_pk_bf16(s[4 * 33], s[5 * 33]); o.w = cvt_pk_bf16(s[6 * 33], s[7 * 33]);
        *(u32x4*)(WT + (size_t)(drow + n) * K + k0 + 8 * c) = o; }
    LDS_WAIT(); asm volatile("" ::: "memory");
}
__device__ __forceinline__ void transpose_item(const float* W, int K, int N, bf16_t* WT, int item, bool qperm, LAS float* scr, int lane) {
    const int nblk = N / 32, kb = item / nblk, nb = item % nblk, n0 = 32 * nb;
    int drow = n0;
    if (qperm) { const int h = n0 / 192, e = n0 % 192; drow = (e < 128) ? h * 128 + e : 1024 + (h >> 2) * 256 + 128 * ((e - 128) >> 5) + 32 * (h & 3); }
    transpose_block(W, K, N, WT, 64 * kb, n0, drow, scr, lane);
}
__device__ __forceinline__ void ada_item(Frame& F, int item) {
    LOCAL_IDS();
    const int layer = item / 96, col0 = (item % 96) * 64, w = wave;
    LAS float* slab = (LAS float*)F.lds + w * 2560;
    const float* W = F.in[6] + (size_t)layer * 1024 * 6144;
    float acc[40];
#pragma unroll
    for (int b = 0; b < 40; ++b) acc[b] = 0.f;
    for (int hh = 0; hh < 2; ++hh) {
        const int kbase = 128 * w + 64 * hh;
#pragma unroll 8
        for (int b = 0; b < 40; ++b) { const float c = (b < NB_P ? F.in[4] + b * DM : F.in[5] + (b - NB_P) * DM)[kbase + lane];
            slab[lane * 40 + b] = c * __builtin_amdgcn_rcpf(1.f + __expf(-c)); }
        LDS_WAIT(); asm volatile("" ::: "memory");
        for (int kk = 0; kk < 64; ++kk) { const float wv = W[(size_t)(kbase + kk) * 6144 + col0 + lane];
#pragma unroll
            for (int b4 = 0; b4 < 10; ++b4) { const f32x4 s = *(const LAS f32x4*)(slab + kk * 40 + 4 * b4);
                acc[4 * b4 + 0] += s[0] * wv; acc[4 * b4 + 1] += s[1] * wv; acc[4 * b4 + 2] += s[2] * wv; acc[4 * b4 + 3] += s[3] * wv; } }
        LDS_WAIT(); asm volatile("" ::: "memory");
    }
    __syncthreads();
    LAS float* red = (LAS float*)F.lds;
#pragma unroll
    for (int b = 0; b < 40; ++b) red[(w * 40 + b) * 64 + lane] = acc[b];
    __syncthreads();
    float* MODF = (float*)(F.ws + WS_MODF) + (size_t)layer * 40 * 6144;
    const float* bias = F.in[7] + (size_t)layer * 6144;
    for (int o = tid; o < 2560; o += 512) { const int b = o >> 6, l = o & 63; float s = bias[col0 + l];
#pragma unroll
        for (int ww = 0; ww < 8; ++ww) s += red[(ww * 40 + b) * 64 + l];
        MODF[(size_t)b * 6144 + col0 + l] = s; }
    __syncthreads();
}
__device__ __forceinline__ void cvt8(const float* src, bf16_t* dst) {
    const f32x4 a = *(const f32x4*)src, b = *(const f32x4*)(src + 4);
    u32x4 w; w.x = cvt_pk_bf16(a[0], a[1]); w.y = cvt_pk_bf16(a[2], a[3]); w.z = cvt_pk_bf16(b[0], b[1]); w.w = cvt_pk_bf16(b[2], b[3]);
    *(u32x4*)dst = w;
}
__device__ __forceinline__ void p0_phase(Frame& F) {
    LOCAL_IDS();
    for (int it = blockIdx.x; it < 192; it += F.G) ada_item(F, it);
    LAS float* scr = (LAS float*)(F.lds + wave * 8704);
    const int gw = blockIdx.x * 8 + wave, NGW = F.G * 8;
    unsigned char* ws = F.ws;
    constexpr int I_WIN = 16 * 22, I_WQ = 6 * 48, I_WUK = 4 * 32, I_WO = 16 * 32, I_W1 = 16 * 128, I_W2 = 64 * 32;
    constexpr int NITEMS = I_WIN + I_WQ + 2 * I_WUK + I_WO + I_W1 + I_W2;
    for (int it = gw; it < NITEMS; it += NGW) {
        int r = it;
        if (r < I_WIN) { transpose_item(F.in[12], 1024, 704, (bf16_t*)(ws + WS_WIN), r, false, scr, lane); continue; } r -= I_WIN;
        if (r < I_WQ) { transpose_item(F.in[15], 384, 1536, (bf16_t*)(ws + WS_WQ), r, true, scr, lane); continue; } r -= I_WQ;
        if (r < I_WUK) { transpose_item(F.in[16], 256, 1024, (bf16_t*)(ws + WS_WUK), r, false, scr, lane); continue; } r -= I_WUK;
        if (r < I_WUK) { transpose_item(F.in[17], 256, 1024, (bf16_t*)(ws + WS_WUV), r, false, scr, lane); continue; } r -= I_WUK;
        if (r < I_WO) { transpose_item(F.in[22], 1024, 1024, (bf16_t*)(ws + WS_WO), r, false, scr, lane); continue; } r -= I_WO;
        if (r < I_W1) { transpose_item(F.in[10], 1024, 4096, (bf16_t*)(ws + WS_W1), r, false, scr, lane); continue; } r -= I_W1;
        transpose_item(F.in[11], 4096, 1024, (bf16_t*)(ws + WS_W2), r, false, scr, lane);
    }
    const long gt = (long)blockIdx.x * 512 + tid, NT = (long)F.G * 512;
    { const float* src = F.in[2]; bf16_t* dst = (bf16_t*)(ws + WS_CKV) + (size_t)MT * 256;
      for (long i = gt; i < (long)NCACHE * 256 / 8; i += NT) cvt8(src + i * 8, dst + i * 8); }
    { const float* src = F.in[3]; bf16_t* dst = (bf16_t*)(ws + WS_KPE);
      for (long i = gt; i < (long)NCACHE * 64 / 8; i += NT) cvt8(src + i * 8, dst + i * 8); }
    { const float* src = F.in[16]; const float* gk = F.in[20]; bf16_t* dst = (bf16_t*)(ws + WS_WUKN);
      for (long i = gt; i < 256 * 1024 / 8; i += NT) { const int d = (int)(i * 8) & 127;
          const f32x4 a = *(const f32x4*)(src + i * 8) * *(const f32x4*)(gk + d), b = *(const f32x4*)(src + i * 8 + 4) * *(const f32x4*)(gk + d + 4);
          u32x4 w; w.x = cvt_pk_bf16(a[0], a[1]); w.y = cvt_pk_bf16(a[2], a[3]); w.z = cvt_pk_bf16(b[0], b[1]); w.w = cvt_pk_bf16(b[2], b[3]);
          *(u32x4*)(dst + i * 8) = w; } }
}

__device__ __forceinline__ void deferred_transposes(Frame& F, int set, int widx, int nw) {
    LOCAL_IDS();
    LAS float* scr = (LAS float*)(F.lds + wave * 8704);
    unsigned char* ws = F.ws;
    constexpr int I_CWIN = 16 * 64, I_CWO = 16 * 32, I_W1 = 16 * 128, I_W2 = 64 * 32;
    if (set == 0) {
        for (int it = widx; it < I_CWIN + I_CWO + I_W1; it += nw) { int r = it;
            if (r < I_CWIN) { transpose_item(F.in[23], 1024, 2048, (bf16_t*)(ws + WS_CWIN), r, false, scr, lane); continue; } r -= I_CWIN;
            if (r < I_CWO) { transpose_item(F.in[27], 1024, 1024, (bf16_t*)(ws + WS_CWO), r, false, scr, lane); continue; } r -= I_CWO;
            transpose_item(F.in[10] + (size_t)1024 * 4096, 1024, 4096, (bf16_t*)(ws + WS_W1) + (size_t)4096 * 1024, r, false, scr, lane); }
    } else {
        for (int it = widx; it < I_W2; it += nw) transpose_item(F.in[11] + (size_t)1024 * 4096, 4096, 1024, (bf16_t*)(ws + WS_W2) + (size_t)4096 * 1024, it, false, scr, lane);
    }
}
__device__ __forceinline__ void tail_row(Frame& F, int row, int lane, const float* tgate, const float* tbase, f32x4 (&v)[4]) {
    const float* P = (const float*)(F.ws + WS_PBUF) + (size_t)(row - MP) * DM;
    const float* base = tbase ? tbase + (size_t)(row - MP) * DM : F.out + (size_t)row * DM;
    const float* gp = tgate + (size_t)row_seq(row) * 6144;
#pragma unroll
    for (int j = 0; j < 4; ++j) { const int c = 4 * lane + 256 * j; f32x4 s = *(const f32x4*)(P + c);
#pragma unroll
        for (int k = 1; k < KSPL; ++k) s += *(const f32x4*)(P + (size_t)k * MS * DM + c);
        v[j] = *(const f32x4*)(base + c) + *(const f32x4*)(gp + c) * s;
        *(f32x4*)(F.out + (size_t)row * DM + c) = v[j]; }
}
template <int SRC> __device__ __forceinline__ void modnorm_phase(Frame& F, int layer, int which, const float* tgate, const float* tbase) {
    LOCAL_IDS();
    const int gw = blockIdx.x * 8 + wave, NGW = F.G * 8;
    const float* g = (which ? F.in[9] : F.in[8]) + layer * DM;
    const float* MODF = (const float*)(F.ws + WS_MODF) + (size_t)layer * 40 * 6144;
    bf16_t* H = (bf16_t*)(F.ws + WS_H);
    for (int row = gw; row < MT; row += NGW) {
        const float* xr = SRC == 0 ? (row < MP ? F.in[0] + (size_t)row * DM : F.in[1] + (size_t)(row - MP) * DM) : F.out + (size_t)row * DM;
        const float* md = MODF + (size_t)row_seq(row) * 6144 + which * 3072;
        f32x4 v[4]; float ss = 0.f;
        if (tgate != nullptr && row >= MP) tail_row(F, row, lane, tgate, tbase, v);
        else {
#pragma unroll
            for (int j = 0; j < 4; ++j) v[j] = *(const f32x4*)(xr + 4 * lane + 256 * j); }
#pragma unroll
        for (int j = 0; j < 4; ++j) ss += (v[j][0] * v[j][0] + v[j][1] * v[j][1]) + (v[j][2] * v[j][2] + v[j][3] * v[j][3]);
        const float rs = __builtin_amdgcn_rsqf(wave_sum(ss) * (1.f / DM) + EPS);
#pragma unroll
        for (int j = 0; j < 4; ++j) { const int c = 4 * lane + 256 * j;
            const f32x4 gg = *(const f32x4*)(g + c), sh = *(const f32x4*)(md + c), sc = *(const f32x4*)(md + 1024 + c);
            const f32x4 o = v[j] * rs * gg * (sc + 1.f) + sh;
            u32x2 w; w.x = cvt_pk_bf16(o[0], o[1]); w.y = cvt_pk_bf16(o[2], o[3]);
            *(u32x2*)(H + (size_t)row * DM + c) = w; }
    }
}
__device__ __forceinline__ void final_tail_phase(Frame& F, const float* tgate) {
    LOCAL_IDS();
    const int gw = blockIdx.x * 8 + wave, NGW = F.G * 8;
    for (int row = MP + gw; row < MT; row += NGW) { f32x4 v[4]; tail_row(F, row, lane, tgate, nullptr, v); }
}

__device__ __forceinline__ void latent_phase(Frame& F) {
    LOCAL_IDS();
    const int gw = blockIdx.x * 8 + wave, NGW = F.G * 8;
    const float* A0 = (const float*)(F.ws + WS_A0);
    bf16_t* CQ = (bf16_t*)(F.ws + WS_CQ); bf16_t* CKV = (bf16_t*)(F.ws + WS_CKV); bf16_t* KR = (bf16_t*)(F.ws + WS_KR);
    const float* gqa = F.in[13]; const float* gkva = F.in[14]; const float* gkr = F.in[21];
    const float inv = rope_inv(lane & 31);
    for (int row = gw; row < MT; row += NGW) {
        const float* a = A0 + (size_t)row * 768;
        f32x2 q[3]; float s1 = 0.f;
#pragma unroll
        for (int j = 0; j < 3; ++j) { q[j] = *(const f32x2*)(a + 2 * lane + 128 * j); s1 += q[j][0] * q[j][0] + q[j][1] * q[j][1]; }
        const f32x4 kv = *(const f32x4*)(a + 384 + 4 * lane);
        float s2 = (kv[0] * kv[0] + kv[1] * kv[1]) + (kv[2] * kv[2] + kv[3] * kv[3]);
        const float kr = a[640 + lane]; float s3 = kr * kr;
        s1 = wave_sum(s1); s2 = wave_sum(s2); s3 = wave_sum(s3);
        const float r1 = __builtin_amdgcn_rsqf(s1 * (1.f / 384.f) + EPS), r2 = __builtin_amdgcn_rsqf(s2 * (1.f / 256.f) + EPS), r3 = __builtin_amdgcn_rsqf(s3 * (1.f / 64.f) + EPS);
#pragma unroll
        for (int j = 0; j < 3; ++j) { const int c = 2 * lane + 128 * j; const f32x2 gg = *(const f32x2*)(gqa + c);
            *(unsigned*)(CQ + (size_t)row * 384 + c) = cvt_pk_bf16(q[j][0] * r1 * gg[0], q[j][1] * r1 * gg[1]); }
        { const f32x4 gg = *(const f32x4*)(gkva + 4 * lane); const f32x4 o = kv * r2 * gg;
          float* op = row < MP ? F.out + OUT_CKVP + (size_t)row * 256 : F.out + OUT_CKVS + (size_t)(row - MP) * 256;
          *(f32x4*)(op + 4 * lane) = o;
          u32x2 w; w.x = cvt_pk_bf16(o[0], o[1]); w.y = cvt_pk_bf16(o[2], o[3]);
          *(u32x2*)(CKV + (size_t)row * 256 + 4 * lane) = w; }
        { const float y = kr * r3 * gkr[lane]; const auto yy = __builtin_amdgcn_permlane32_swap(__float_as_uint(y), __float_as_uint(y), false, false); const float yo = __uint_as_float(lane < 32 ? yy[1] : yy[0]);
          float sn, cs; sincos_rev((float)row_pos(row) * inv, sn, cs);
          const float o = lane < 32 ? y * cs - yo * sn : y * cs + yo * sn;
          float* op = row < MP ? F.out + OUT_KPEP + (size_t)row * 64 : F.out + OUT_KPES + (size_t)(row - MP) * 64;
          op[lane] = o; KR[(size_t)row * 64 + lane] = f2bf(o); }
    }
}

namespace att {
#define SBAR() __builtin_amdgcn_sched_barrier(0)
constexpr float THR = 8.f;
__device__ __forceinline__ int crow(int r, int hi) { return (r & 3) + 8 * (r >> 2) + 4 * hi; }
__device__ __forceinline__ void partialSM(f32x16& p0, f32x16& p1, float& m_reg, float& mn, float& alpha) {
    constexpr float C = SM_SCALE * 1.4426950408889634f;
    float pmax = p0[0];
#pragma unroll
    for (int r = 1; r < 16; ++r) pmax = fmaxf(pmax, p0[r]);
#pragma unroll
    for (int r = 0; r < 16; ++r) pmax = fmaxf(pmax, p1[r]);
    { auto rr = __builtin_amdgcn_permlane32_swap(__float_as_uint(pmax), __float_as_uint(pmax), false, false);
      pmax = fmaxf(__uint_as_float(rr[0]), __uint_as_float(rr[1])); }
    if (__builtin_expect(__all(pmax - m_reg <= THR / SM_SCALE), 1)) { mn = m_reg; alpha = 1.f; }
    else { mn = fmaxf(m_reg, pmax); alpha = __builtin_amdgcn_exp2f((m_reg - mn) * C); m_reg = mn; }
    const float mnC = -mn * C;
#pragma unroll
    for (int r = 0; r < 16; ++r) p0[r] = fmaf(p0[r], C, mnC);
#pragma unroll
    for (int r = 0; r < 16; ++r) p1[r] = fmaf(p1[r], C, mnC);
#pragma unroll
    for (int r = 0; r < 16; ++r) p0[r] = __builtin_amdgcn_exp2f(p0[r]);
}
__device__ __forceinline__ void finishSM(f32x16& p0, f32x16& p1, float alpha, float& l_reg, bf16x8& pa0, bf16x8& pa1, bf16x8& pa2, bf16x8& pa3) {
#pragma unroll
    for (int r = 0; r < 16; ++r) p1[r] = __builtin_amdgcn_exp2f(p1[r]);
    float ps = 0;
#pragma unroll
    for (int r = 0; r < 16; ++r) ps += p0[r];
#pragma unroll
    for (int r = 0; r < 16; ++r) ps += p1[r];
    { auto rr = __builtin_amdgcn_permlane32_swap(__float_as_uint(ps), __float_as_uint(ps), false, false);
      ps = __uint_as_float(rr[0]) + __uint_as_float(rr[1]); }
    l_reg = l_reg * alpha + ps;
#define PK4(P, BASE, OUT) do { unsigned a0 = cvt_pk_bf16(P[BASE + 0], P[BASE + 1]), a1 = cvt_pk_bf16(P[BASE + 2], P[BASE + 3]);   \
    unsigned b0 = cvt_pk_bf16(P[BASE + 4], P[BASE + 5]), b1 = cvt_pk_bf16(P[BASE + 6], P[BASE + 7]);                              \
    auto r0 = __builtin_amdgcn_permlane32_swap(a0, b0, false, false); auto r1 = __builtin_amdgcn_permlane32_swap(a1, b1, false, false); \
    u32x4 w = {r0[0], r1[0], r0[1], r1[1]}; OUT = *reinterpret_cast<bf16x8*>(&w); } while (0)
    PK4(p0, 0, pa0); PK4(p0, 8, pa1); PK4(p1, 0, pa2); PK4(p1, 8, pa3);
#undef PK4
}
__device__ __forceinline__ int v_st(int k, int c) { const int kk = (k & ~0xC) | ((k & 4) << 1) | ((k & 8) >> 1); return ((kk >> 3) * 4 + (c >> 5)) * 512 + ((kk & 7) * 32 + (c & 31)) * 2; }
__device__ __forceinline__ int v_rd_base(int lane) { return ((lane & 3) << 3) | (((lane >> 2) & 3) << 6) | (((lane >> 4) & 1) << 5) | (((lane >> 5) & 1) << 8); }
constexpr int v_rd_off(int d0, int ks, int half) { return d0 * 512 + ks * 4096 + half * 2048; }
template <int OFF> __device__ __forceinline__ s16x4 tr_read(int vb) {
    s16x4 r; asm volatile("ds_read_b64_tr_b16 %0, %1 offset:%2" : "=&v"(r) : "v"(vb), "i"(OFF) : "memory"); return r;
}
template <int D0> __device__ __forceinline__ void pv_one(f32x16& od, int vb, bf16x8 pa0, bf16x8 pa1, bf16x8 pa2, bf16x8 pa3) {
    const s16x4 l0 = tr_read<v_rd_off(D0, 0, 0)>(vb), h0 = tr_read<v_rd_off(D0, 0, 1)>(vb), l1 = tr_read<v_rd_off(D0, 1, 0)>(vb), h1 = tr_read<v_rd_off(D0, 1, 1)>(vb);
    const s16x4 l2 = tr_read<v_rd_off(D0, 2, 0)>(vb), h2 = tr_read<v_rd_off(D0, 2, 1)>(vb), l3 = tr_read<v_rd_off(D0, 3, 0)>(vb), h3 = tr_read<v_rd_off(D0, 3, 1)>(vb);
    asm volatile("s_waitcnt lgkmcnt(0)" ::: "memory"); SBAR();
#define PK(L, H) (bf16x8){L[0], L[1], L[2], L[3], H[0], H[1], H[2], H[3]}
    od = __builtin_amdgcn_mfma_f32_32x32x16_bf16(pa0, PK(l0, h0), od, 0, 0, 0);
    od = __builtin_amdgcn_mfma_f32_32x32x16_bf16(pa1, PK(l1, h1), od, 0, 0, 0);
    od = __builtin_amdgcn_mfma_f32_32x32x16_bf16(pa2, PK(l2, h2), od, 0, 0, 0);
    od = __builtin_amdgcn_mfma_f32_32x32x16_bf16(pa3, PK(l3, h3), od, 0, 0, 0);
#undef PK
}
__device__ __forceinline__ void pv_d0(f32x16* o, int vb, bf16x8 pa0, bf16x8 pa1, bf16x8 pa2, bf16x8 pa3) {
    pv_one<0>(o[0], vb, pa0, pa1, pa2, pa3); pv_one<1>(o[1], vb, pa0, pa1, pa2, pa3); pv_one<2>(o[2], vb, pa0, pa1, pa2, pa3); pv_one<3>(o[3], vb, pa0, pa1, pa2, pa3);
}

constexpr int P_SHM_V = 64 * 128 * 2, P_SHM_K = 64 * 192 * 2;
#define KSWZ192(row, colB) ((row) * 384 + ((colB) ^ (((row) & 7) << 4)))
__device__ __forceinline__ void qkt192(f32x16& p0, f32x16& p1, const LAS char* Ks, const int (&ka)[4], const bf16x8* qr, const LAS char* QRl, int hi, bool vis) {
    if (vis) {
        p0 = f32x16{}; p1 = f32x16{};
#pragma unroll
        for (int d0 = 0; d0 < 12; ++d0) {
            const bf16x8 b0 = *reinterpret_cast<const LAS bf16x8*>(Ks + ka[d0 & 3] + (d0 >> 2) * 128);
            const bf16x8 b1 = *reinterpret_cast<const LAS bf16x8*>(Ks + ka[d0 & 3] + (d0 >> 2) * 128 + 32 * 384);
            const bf16x8 qf = d0 < 8 ? qr[d0 < 8 ? d0 : 0] : *reinterpret_cast<const LAS bf16x8*>(QRl + ((d0 - 8) * 16 + hi * 8) * 2);
            p0 = __builtin_amdgcn_mfma_f32_32x32x16_bf16(b0, qf, p0, 0, 0, 0);
            p1 = __builtin_amdgcn_mfma_f32_32x32x16_bf16(b1, qf, p1, 0, 0, 0); }
    } else {
#pragma unroll
        for (int r = 0; r < 16; ++r) { p0[r] = -1e30f; p1[r] = -1e30f; }
    }
}
__device__ __forceinline__ void prompt_unit(int b, int h, int qb, const bf16_t* __restrict__ Q, const bf16_t* __restrict__ KN, const bf16_t* __restrict__ KR,
                                            const bf16_t* __restrict__ V, bf16_t* __restrict__ O, LAS char* lds) {
    int tid_l_ = threadIdx.x; asm volatile("" : "+v"(tid_l_));
    const int tid = tid_l_, wid = tid >> 6, lane = tid & 63, r32 = lane & 31, hi = lane >> 5;
    LAS char* V_lds = lds; LAS char* K_lds = lds + 2 * P_SHM_V;
    LAS float* wsc = (LAS float*)(lds + 2 * P_SHM_V + 2 * P_SHM_K) + wid * 64; LAS float* li_l = wsc; LAS float* al_l = wsc + 32;
    float m_reg = -1e30f, l_reg = 0; f32x16 o[4] = {}; bf16x8 qr[8];
    LAS char* QRl = lds + 2 * P_SHM_V + 2 * P_SHM_K + 2048 + wid * 4608 + r32 * 144;
    const size_t rowbase = (size_t)b * SEQ;
    const bf16_t* Qw = Q + (rowbase + qb * 256 + wid * 32 + r32) * 1536 + h * 192 + hi * 8;
#pragma unroll
    for (int d0 = 0; d0 < 8; ++d0) qr[d0] = *reinterpret_cast<const bf16x8*>(Qw + d0 * 16);
#pragma unroll
    for (int d0 = 8; d0 < 12; ++d0) *reinterpret_cast<LAS bf16x8*>(QRl + ((d0 - 8) * 16 + hi * 8) * 2) = *reinterpret_cast<const bf16x8*>(Qw + d0 * 16);
    int ka[4];
#pragma unroll
    for (int k = 0; k < 4; ++k) ka[k] = r32 * 384 + ((k * 32 + hi * 16) ^ ((r32 & 7) << 4));
    const int cw = 4 * qb + (wid >> 1);
    const int sr = tid >> 4, sc = (tid & 15) * 8, vst0 = v_st(sr, sc), vst1 = v_st(32 + sr, sc), krr = tid >> 3, krc = (tid & 7) * 8;
    const int vb0 = (int)(uintptr_t)V_lds + v_rd_base(lane);
    const bf16_t* Vh = V + rowbase * 1024 + h * 128; const bf16_t* Kh = KN + rowbase * 1024 + h * 128; const bf16_t* Rh = KR + rowbase * 64;
    struct { bf16x8 vs0, vs1, ks0, ks1, kr; } sr_[1];
#define SLOAD(i, k0) do { sr_[i].vs0 = *reinterpret_cast<const bf16x8*>(&Vh[(size_t)((k0) + sr) * 1024 + sc]); sr_[i].vs1 = *reinterpret_cast<const bf16x8*>(&Vh[(size_t)((k0) + 32 + sr) * 1024 + sc]); \
    sr_[i].ks0 = *reinterpret_cast<const bf16x8*>(&Kh[(size_t)((k0) + sr) * 1024 + sc]); sr_[i].ks1 = *reinterpret_cast<const bf16x8*>(&Kh[(size_t)((k0) + 32 + sr) * 1024 + sc]); \
    sr_[i].kr = *reinterpret_cast<const bf16x8*>(&Rh[(size_t)((k0) + krr) * 64 + krc]); } while (0)
#define SWRITE(bb, i) do { *(LAS bf16x8*)(V_lds + (bb) * P_SHM_V + vst0) = sr_[i].vs0; *(LAS bf16x8*)(V_lds + (bb) * P_SHM_V + vst1) = sr_[i].vs1; const int kc = sc * 2; \
    *(LAS bf16x8*)(K_lds + (bb) * P_SHM_K + KSWZ192(sr, kc)) = sr_[i].ks0; *(LAS bf16x8*)(K_lds + (bb) * P_SHM_K + KSWZ192(32 + sr, kc)) = sr_[i].ks1; \
    *(LAS bf16x8*)(K_lds + (bb) * P_SHM_K + KSWZ192(krr, 256 + krc * 2)) = sr_[i].kr; } while (0)
#define SWAIT() asm volatile("s_waitcnt vmcnt(0)" ::: "memory")
#define RESC(a) do { if (__any((a) < 1.f)) { if (hi == 0) al_l[r32] = (a); asm volatile("s_waitcnt lgkmcnt(0)" ::: "memory"); \
    _Pragma("unroll") for (int d = 0; d < 4; ++d) _Pragma("unroll") for (int r = 0; r < 16; ++r) o[d][r] *= al_l[crow(r, hi)]; } } while (0)
    f32x16 pA0, pA1, pB0, pB1; float mnA, mnB, alA, alB; bf16x8 pa0, pa1, pa2, pa3; const int NT = 4 * qb + 4;
    constexpr int SE = 0, SO = 0;
    SLOAD(SE, 0); asm volatile("s_waitcnt vmcnt(0)" ::: "memory"); SWRITE(0, SE); __syncthreads();
    qkt192(pA0, pA1, K_lds, ka, qr, QRl, hi, true); partialSM(pA0, pA1, m_reg, mnA, alA);
    SLOAD(SO, 64);
    SWAIT(); SWRITE(1, SO); __syncthreads();
    for (int j = 1; j + 1 < NT; j += 2) {
        SBAR(); qkt192(pB0, pB1, K_lds + P_SHM_K, ka, qr, QRl, hi, j <= cw);
        finishSM(pA0, pA1, alA, l_reg, pa0, pa1, pa2, pa3); SBAR();
        SLOAD(SO, (j + 1) * 64); SBAR();
        if (j - 1 <= cw) pv_d0(o, vb0, pa0, pa1, pa2, pa3);
        partialSM(pB0, pB1, m_reg, mnB, alB);
        __syncthreads(); SWAIT(); SWRITE(0, SE);
        RESC(alB); __syncthreads();
        SBAR(); qkt192(pA0, pA1, K_lds, ka, qr, QRl, hi, j + 1 <= cw);
        finishSM(pB0, pB1, alB, l_reg, pa0, pa1, pa2, pa3); SBAR();
        SLOAD(SE, (j + 2) * 64); SBAR();
        if (j <= cw) pv_d0(o, vb0 + P_SHM_V, pa0, pa1, pa2, pa3);
        partialSM(pA0, pA1, m_reg, mnA, alA);
        __syncthreads(); SWAIT(); SWRITE(1, SO);
        RESC(alA); __syncthreads();
    }
    SBAR(); qkt192(pB0, pB1, K_lds + P_SHM_K, ka, qr, QRl, hi, NT - 1 <= cw);
    finishSM(pA0, pA1, alA, l_reg, pa0, pa1, pa2, pa3); SBAR();
    if (NT - 2 <= cw) pv_d0(o, vb0, pa0, pa1, pa2, pa3);
    partialSM(pB0, pB1, m_reg, mnB, alB);
    __syncthreads(); RESC(alB);
    finishSM(pB0, pB1, alB, l_reg, pa0, pa1, pa2, pa3); SBAR();
    if (NT - 1 <= cw) pv_d0(o, vb0 + P_SHM_V, pa0, pa1, pa2, pa3);
    if (hi == 0) li_l[r32] = l_reg; asm volatile("s_waitcnt lgkmcnt(0)" ::: "memory");
    float rli[16];
#pragma unroll
    for (int r = 0; r < 16; ++r) rli[r] = __builtin_amdgcn_rcpf(li_l[crow(r, hi)]);
    bf16_t* Ow = O + (rowbase + qb * 256 + wid * 32) * 1024 + h * 128;
#pragma unroll
    for (int r = 0; r < 16; ++r) { const int orow = crow(r, hi);
#pragma unroll
        for (int d0 = 0; d0 < 4; ++d0) Ow[(size_t)orow * 1024 + d0 * 32 + r32] = f2bf(o[d0][r] * rli[r]); }
    __syncthreads();
#undef SLOAD
#undef SWRITE
#undef SWAIT
#undef RESC
}

constexpr int S_QP = 264;
constexpr int S_OFF_Q = 0, S_OFF_K = 8 * 16 * S_QP * 2  , S_OFF_V = S_OFF_K + 64 * 640  , S_OFF_RS = S_OFF_V + 32768, S_OFF_SC = S_OFF_RS + 2048  , S_END = S_OFF_SC + 2048;
static_assert(S_END <= LDS_MISC, "sample LDS map");
#define KSWZ320(row, colB) ((row) * 640 + ((colB) ^ (((row) & 7) << 4)))
__device__ __forceinline__ void sample_unit(int sb, int sp, const bf16_t* __restrict__ Q, const bf16_t* __restrict__ WUKN, const bf16_t* __restrict__ CKV, const bf16_t* __restrict__ KPE,
                                            const bf16_t* __restrict__ KR, const float* __restrict__ RS, float* __restrict__ PART, float* __restrict__ ML, LAS char* lds) {
    int tid_l_ = threadIdx.x; asm volatile("" : "+v"(tid_l_));
    const int tid = tid_l_, h = tid >> 6, lane = tid & 63, r32 = lane & 31, hi = lane >> 5, q16 = r32 & 15;
    LAS char* Q_lds = lds + S_OFF_Q + h * (16 * S_QP * 2); LAS char* K_lds = lds + S_OFF_K; LAS char* V_lds = lds + S_OFF_V;
    LAS float* rs_lds = (LAS float*)(lds + S_OFF_RS); LAS float* al_l = (LAS float*)(lds + S_OFF_SC) + h * 64;
    const size_t qrow = (size_t)MP + sb * 16 + q16;
    {
        bf16x8 qa[8];
#pragma unroll
        for (int ks = 0; ks < 8; ++ks) qa[ks] = *reinterpret_cast<const bf16x8*>(Q + qrow * 1536 + h * 192 + ks * 16 + hi * 8);
        LAS char* qw = Q_lds + ((4 * hi) * S_QP + r32) * 2;
        const bf16_t* wp = WUKN + (size_t)r32 * 1024 + h * 128 + hi * 8;
#pragma unroll 1
        for (int nb = 0; nb < 8; ++nb) {
            f32x16 acc = {};
#pragma unroll
            for (int ks = 0; ks < 8; ++ks) { const bf16x8 wb = *reinterpret_cast<const bf16x8*>(wp + ks * 16);
                acc = __builtin_amdgcn_mfma_f32_32x32x16_bf16(qa[ks], wb, acc, 0, 0, 0); }
#pragma unroll
            for (int r = 0; r < 8; ++r) *(LAS bf16_t*)(qw + (((r & 3) + 8 * (r >> 2)) * S_QP) * 2) = f2bf(acc[r]);
            qw += 64; wp += 32 * 1024;
        }
    }
    __syncthreads();
    const int hp = h & 3, vh = h >> 2, hl = 2 * hp + (r32 >> 4);
    bf16x8 qrp[4];
#pragma unroll
    for (int d0 = 0; d0 < 4; ++d0) qrp[d0] = *reinterpret_cast<const bf16x8*>(Q + qrow * 1536 + hl * 192 + 128 + d0 * 16 + hi * 8);
    float m_reg = -1e30f, l_reg = 0; f32x16 o[4] = {};
    const int vb0 = (int)(uintptr_t)V_lds + vh * 16384 + v_rd_base(lane);
    const int ntile = (sp == NSPLIT - 1) ? 17 : 16;
    const int krr = tid >> 3, krc = (tid & 7) * 8;
    const int skey = tid >> 5, cc = (tid & 31) * 8;
    LAS char* kst = K_lds + skey * 640 + ((cc * 2) ^ ((skey & 7) << 4));
    LAS char* vst = V_lds + (cc >> 7) * 16384 + v_st(skey, cc & 127);
    LAS char* krst = K_lds + krr * 640 + ((512 + krc * 2) ^ ((krr & 7) << 4));
    int ka[4];
#pragma unroll
    for (int k = 0; k < 4; ++k) ka[k] = r32 * 640 + ((k * 32 + hi * 16) ^ ((r32 & 7) << 4));
    const LAS char* qfp = lds + S_OFF_Q + hl * (16 * S_QP * 2) + (q16 * S_QP + hi * 8) * 2;
    const LAS float* rsp = rs_lds + (4 * hi) * 8 + hl;
    bf16x8 c[4], kr; float rsv;
#define S_LOAD(T) do { const bool nw_ = ((T) == 16); \
        const size_t crow0 = nw_ ? (size_t)MP + sb * 16 : (size_t)MT + (size_t)sb * PAST + sp * 1024 + (T) * 64; \
        const bf16_t* rsrc = nw_ ? KR + ((size_t)MP + sb * 16) * 64 : KPE + ((size_t)sb * PAST + sp * 1024 + (T) * 64) * 64; \
        _Pragma("unroll") for (int i = 0; i < 4; ++i) { const int key = skey + 16 * i; \
            c[i] = (!nw_ || key < 16) ? *reinterpret_cast<const bf16x8*>(CKV + (crow0 + key) * 256 + cc) : bf16x8{}; } \
        kr = (!nw_ || krr < 16) ? *reinterpret_cast<const bf16x8*>(rsrc + (size_t)krr * 64 + krc) : bf16x8{}; \
        rsv = (!nw_ || krr < 16) ? RS[(crow0 + krr) * 8 + (tid & 7)] : 0.f; } while (0)
    S_LOAD(0);
#pragma unroll 1
    for (int t = 0; t < ntile; ++t) {
        const bool isnew = (t == 16);
        __syncthreads();
#pragma unroll
        for (int i = 0; i < 4; ++i) { *(LAS bf16x8*)(kst + i * 16 * 640) = c[i];
            *(LAS bf16x8*)(vst + i * 4096) = c[i]; }
        *(LAS bf16x8*)krst = kr;
        rs_lds[krr * 8 + (tid & 7)] = rsv;
        __syncthreads();
        if (t + 1 < ntile) S_LOAD(t + 1);
        SBAR();
        f32x16 p0 = {}, p1 = {};
#pragma unroll
        for (int d0 = 0; d0 < 16; ++d0) { if ((d0 & 3) == 0) SBAR();
            const bf16x8 b0 = *reinterpret_cast<const LAS bf16x8*>(K_lds + ka[d0 & 3] + (d0 >> 2) * 128);
            const bf16x8 b1 = *reinterpret_cast<const LAS bf16x8*>(K_lds + ka[d0 & 3] + (d0 >> 2) * 128 + 32 * 640);
            const bf16x8 qf = *reinterpret_cast<const LAS bf16x8*>(qfp + d0 * 32);
            p0 = __builtin_amdgcn_mfma_f32_32x32x16_bf16(b0, qf, p0, 0, 0, 0);
            p1 = __builtin_amdgcn_mfma_f32_32x32x16_bf16(b1, qf, p1, 0, 0, 0); }
        SBAR();
#pragma unroll
        for (int r = 0; r < 16; ++r) { p0[r] *= rsp[((r & 3) + 8 * (r >> 2)) * 8]; p1[r] *= rsp[(32 + (r & 3) + 8 * (r >> 2)) * 8]; }
#pragma unroll
        for (int d0 = 0; d0 < 4; ++d0) {
            const bf16x8 b0 = *reinterpret_cast<const LAS bf16x8*>(K_lds + ka[d0] + 512);
            const bf16x8 b1 = *reinterpret_cast<const LAS bf16x8*>(K_lds + ka[d0] + 512 + 32 * 640);
            p0 = __builtin_amdgcn_mfma_f32_32x32x16_bf16(b0, qrp[d0], p0, 0, 0, 0);
            p1 = __builtin_amdgcn_mfma_f32_32x32x16_bf16(b1, qrp[d0], p1, 0, 0, 0); }
        if (isnew) {
#pragma unroll
            for (int r = 0; r < 16; ++r) { if (r >= 8) p0[r] = -1e30f; p1[r] = -1e30f; }
        }
        float mn, al; bf16x8 pa0, pa1, pa2, pa3;
        partialSM(p0, p1, m_reg, mn, al);
        finishSM(p0, p1, al, l_reg, pa0, pa1, pa2, pa3);
        if (__any(al < 1.f)) { if (hi == 0) al_l[r32] = al; asm volatile("s_waitcnt lgkmcnt(0)" ::: "memory");
#pragma unroll
            for (int d = 0; d < 4; ++d)
#pragma unroll
                for (int r = 0; r < 16; ++r) o[d][r] *= al_l[crow(r, hi)]; }
        pv_d0(o, vb0, pa0, pa1, pa2, pa3);
    }
    const size_t ubase = ((size_t)sb * NSPLIT + sp) * 8;
    if (vh == 0 && lane < 32) { const size_t pb = (ubase + hl) * 16 + q16; ML[pb * 2] = m_reg; ML[pb * 2 + 1] = l_reg; }
#pragma unroll
    for (int r = 0; r < 16; ++r) { const int row = crow(r, hi); const size_t pb = (ubase + 2 * hp + (row >> 4)) * 16 + (row & 15);
#pragma unroll
        for (int d = 0; d < 4; ++d) PART[pb * 256 + vh * 128 + d * 32 + r32] = o[d][r]; }
    __syncthreads();
#undef S_LOAD
}
}

__device__ __forceinline__ void attention_phase(Frame& F, unsigned* ctr, bool ctr_is_second = false) {
    LOCAL_IDS();
    volatile LAS unsigned* misc = (volatile LAS unsigned*)(F.lds + LDS_MISC);
    const bf16_t* Q = (const bf16_t*)(F.ws + WS_A0); const bf16_t* KN = (const bf16_t*)(F.ws + WS_KN); const bf16_t* KR = (const bf16_t*)(F.ws + WS_KR);
    const bf16_t* V = (const bf16_t*)(F.ws + WS_V); bf16_t* O = (bf16_t*)(F.ws + WS_H);
    constexpr int NSU = NB_S * NSPLIT, NPU = NB_P * NH * 16;
    for (;;) {
        __syncthreads();
        if (tid == 0) misc[0] = atomicAdd(ctr, 1u);
        __syncthreads();
        const int unit = (int)misc[0];
#ifdef REP_SAMPLE_ONLY
        if (unit >= (ctr_is_second ? NSU : NSU + NPU)) break;
#else
        if (unit >= NSU + NPU) break;
#endif
        if (unit < NSU) {
#ifndef NO_SAMPLE
            att::sample_unit(unit >> 2, unit & 3, Q, (const bf16_t*)(F.ws + WS_WUKN), (const bf16_t*)(F.ws + WS_CKV), (const bf16_t*)(F.ws + WS_KPE), KR,
                             (const float*)(F.ws + WS_RS), (float*)(F.ws + WS_PART), (float*)(F.ws + WS_ML), (LAS char*)F.lds);
#endif
        } else {
#ifndef NO_PROMPT
#ifdef ORDER_BH
            const int pu = unit - NSU, qb = 15 - (pu & 15), bh = pu >> 4;
#else
            const int pu = unit - NSU, qb = 15 - pu / 64, bh = pu % 64;
#endif
            att::prompt_unit(bh >> 3, bh & 7, qb, Q, KN, KR, V, O, (LAS char*)F.lds);
#endif
        }
    }
}

__device__ __forceinline__ void combine_phase(Frame& F) {
    LOCAL_IDS();
    const int gw = blockIdx.x * 8 + wave, NGW = F.G * 8;
    LAS float* ol = (LAS float*)(F.lds + wave * 16384);
    const float* PART = (const float*)(F.ws + WS_PART); const float* ML = (const float*)(F.ws + WS_ML); const float* wuv = F.in[17];
    bf16_t* O = (bf16_t*)(F.ws + WS_H);
    constexpr float C = SM_SCALE * 1.4426950408889634f;
    for (int item = gw; item < NB_S * NH; item += NGW) {
        const int sb = item >> 3, h = item & 7;
        for (int q = 0; q < 16; ++q) {
            float m[NSPLIT], l[NSPLIT], mx = -1e30f;
#pragma unroll
            for (int s = 0; s < NSPLIT; ++s) { const size_t pb = ((((size_t)sb * NSPLIT + s) * 8 + h) * 16 + q); m[s] = ML[pb * 2]; l[s] = ML[pb * 2 + 1]; mx = fmaxf(mx, m[s]); }
            float L = 0.f; f32x4 acc = {0.f, 0.f, 0.f, 0.f};
#pragma unroll
            for (int s = 0; s < NSPLIT; ++s) { const size_t pb = ((((size_t)sb * NSPLIT + s) * 8 + h) * 16 + q); const float f = __builtin_amdgcn_exp2f((m[s] - mx) * C);
                L += f * l[s]; acc += *(const f32x4*)(PART + pb * 256 + 4 * lane) * f; }
#ifdef E1_TEST
            *(LAS f32x4*)(ol + q * 256 + 4 * lane) = (f32x4){0.001f * (q + lane), 0.002f, 0.003f * sb, 0.004f * h};
#else
            *(LAS f32x4*)(ol + q * 256 + 4 * lane) = acc * (1.f / L);
#endif
        }
        LDS_WAIT(); asm volatile("" ::: "memory");
        float a0[16], a1[16];
#pragma unroll
        for (int q = 0; q < 16; ++q) { a0[q] = 0.f; a1[q] = 0.f; }
        for (int l4 = 0; l4 < 64; ++l4) {
            float w0[4], w1[4];
#pragma unroll
            for (int t = 0; t < 4; ++t) { w0[t] = wuv[(size_t)(4 * l4 + t) * 1024 + h * 128 + lane]; w1[t] = wuv[(size_t)(4 * l4 + t) * 1024 + h * 128 + 64 + lane]; }
#pragma unroll
            for (int q = 0; q < 16; ++q) { const f32x4 x = *(const LAS f32x4*)(ol + q * 256 + 4 * l4);
                a0[q] += x[0] * w0[0] + x[1] * w0[1] + x[2] * w0[2] + x[3] * w0[3]; a1[q] += x[0] * w1[0] + x[1] * w1[1] + x[2] * w1[2] + x[3] * w1[3]; }
        }
#pragma unroll
        for (int q = 0; q < 16; ++q) { bf16_t* op = O + ((size_t)MP + sb * 16 + q) * 1024 + h * 128; op[lane] = f2bf(a0[q]); op[64 + lane] = f2bf(a1[q]); }
        LDS_WAIT(); asm volatile("" ::: "memory");
    }
}

__device__ __forceinline__ void sgu_phase(Frame& F) {
    LOCAL_IDS();
    const int wid = wave, r32 = lane & 31, hi = lane >> 5;
    LAS float* rsv_l = (LAS float*)F.lds;
    const bf16_t* VT = (const bf16_t*)(F.ws + WS_VT); const bf16_t* U = (const bf16_t*)(F.ws + WS_U); bf16_t* Gt = (bf16_t*)(F.ws + WS_G);
    const float* SSV = (const float*)(F.ws + WS_SSV); const float* ws_ = F.in[25]; const float* bs = F.in[26]; const float* gv = F.in[24];
    const int mb = wid & 3, nb0 = (wid >> 2) * 2;
    for (int unit = blockIdx.x; unit < 288 * 8; unit += F.G) {
        const int ch = unit >> 3, g = unit & 7; const bool smp = ch >= 256;
        const int tok0 = smp ? MP + (ch - 256) * 16 : ch * 128, ntok = smp ? 16 : 128;
        const bool active = !smp || mb == 0;
        const int ksteps = smp ? 1 : (mb < 2 ? 4 : 8);
        float ssp[8];
        if (tid < 128) {
#pragma unroll
            for (int p = 0; p < 8; ++p) ssp[p] = (tid < ntok) ? SSV[(size_t)p * VTP + tok0 + tid] : 0.f; }
        bf16x8 b0[8], b1[8]; bf16_t uv0[16], uv1[16];
        const int c0 = g * 128 + nb0 * 32 + r32;
        const float* wrow = ws_ + (size_t)g * 16384 + (size_t)(32 * mb + r32) * 128 + hi * 8;
        if (active) {
            const bf16_t* v0p = VT + (size_t)c0 * VTP + tok0 + hi * 8; const bf16_t* v1p = v0p + (size_t)32 * VTP;
#pragma unroll
            for (int ks = 0; ks < 8; ++ks) if (ks < ksteps) {
                b0[ks] = *reinterpret_cast<const bf16x8*>(v0p + ks * 16); b1[ks] = *reinterpret_cast<const bf16x8*>(v1p + ks * 16); }
        }
        if (tid < 128) { float s = ((ssp[0] + ssp[1]) + (ssp[2] + ssp[3])) + ((ssp[4] + ssp[5]) + (ssp[6] + ssp[7]));
            rsv_l[tid] = (tid < ntok) ? __builtin_amdgcn_rsqf(s * (1.f / 1024.f) + EPS) : 0.f; }
        __syncthreads();
        if (active) {
#pragma unroll
            for (int r = 0; r < 16; ++r) { const int i = 32 * mb + att::crow(r, hi);
                if (i < ntok) { const size_t tok = (size_t)tok0 + i; uv0[r] = U[tok * 1024 + c0]; uv1[r] = U[tok * 1024 + c0 + 32]; } }
            f32x16 acc0 = {}, acc1 = {};
#pragma unroll
            for (int ks = 0; ks < 8; ++ks) if (ks < ksteps) { const int j0 = ks * 16 + hi * 8;
                const f32x4 ra = *(const LAS f32x4*)(rsv_l + j0), rb = *(const LAS f32x4*)(rsv_l + j0 + 4);
                const f32x4 xa = *(const f32x4*)(wrow + ks * 16) * ra, xb = *(const f32x4*)(wrow + ks * 16 + 4) * rb;
                u32x4 aw; aw.x = cvt_pk_bf16(xa[0], xa[1]); aw.y = cvt_pk_bf16(xa[2], xa[3]); aw.z = cvt_pk_bf16(xb[0], xb[1]); aw.w = cvt_pk_bf16(xb[2], xb[3]);
                const bf16x8 af = *reinterpret_cast<bf16x8*>(&aw);
                acc0 = __builtin_amdgcn_mfma_f32_32x32x16_bf16(af, b0[ks], acc0, 0, 0, 0);
                acc1 = __builtin_amdgcn_mfma_f32_32x32x16_bf16(af, b1[ks], acc1, 0, 0, 0); }
            const float g0 = gv[c0], g1 = gv[c0 + 32];
#pragma unroll
            for (int r = 0; r < 16; ++r) { const int i = 32 * mb + att::crow(r, hi);
                if (i < ntok) { const size_t tok = (size_t)tok0 + i; const float bias = bs[g * 128 + i];
                    Gt[tok * 1024 + c0] = f2bf(bf2f(uv0[r]) * (acc0[r] * g0 + bias));
                    Gt[tok * 1024 + c0 + 32] = f2bf(bf2f(uv1[r]) * (acc1[r] * g1 + bias)); } }
        }
        if (smp) {
            for (int idx = tid; idx < 2048; idx += 512) { const int t = idx >> 7, c = g * 128 + (idx & 127);
                F.out[OUT_VS + (size_t)((ch - 256) * 16 + t) * 1024 + c] = bf2f(VT[(size_t)c * VTP + tok0 + t]) * rsv_l[t] * gv[c]; }
        }
        __syncthreads();
    }
}

#define XB_TMO      128
#define XB_XCNT(j)  (256  + 64 * (j))
#define XB_XSUB(j)  (1280 + 64 * (j))
#define XB_XGEN(j)  (2304 + 64 * (j))
#define XB_TOP      3328
#define XB_TOPGEN   3392
#define XCD_BAR_WORDS 3456
#define XB_SPIN_CAP (1u << 18)

__device__ __forceinline__ unsigned xb_ld(unsigned* p)              { return __hip_atomic_load(p, __ATOMIC_RELAXED, __HIP_MEMORY_SCOPE_AGENT); }
__device__ __forceinline__ unsigned xb_add(unsigned* p, unsigned v) { return __hip_atomic_fetch_add(p, v, __ATOMIC_RELAXED, __HIP_MEMORY_SCOPE_AGENT); }
__device__ __forceinline__ unsigned xb_xcc_id() { return (unsigned)__builtin_amdgcn_s_getreg((3 << 11) | 20) & 0xFu; }
#define XB_SPIN(cond, bar) do { unsigned _sp = 0; while (cond) { __builtin_amdgcn_s_sleep(1); \
    if ((++_sp & 255u) == 0u) { if (xb_ld(&(bar)[XB_TMO])) break; if (_sp > XB_SPIN_CAP) { atomicAdd(&(bar)[XB_TMO], 1u); break; } } } } while (0)

struct XcdBarrier {
    unsigned* bar; unsigned x;
    volatile LAS unsigned* st;
};

__device__ __forceinline__ XcdBarrier xcd_barrier_post(unsigned* bar, volatile LAS unsigned* st) {
    XcdBarrier b; b.bar = bar; b.x = xb_xcc_id(); b.st = st;
    if (threadIdx.x == 0) (void)xb_add(&bar[XB_XCNT(b.x)], 1u);
    return b;
}
__device__ __forceinline__ void xcd_barrier_complete(unsigned* bar, unsigned x, unsigned& nloc, unsigned& nx) {
    const unsigned G = gridDim.x * gridDim.y * gridDim.z;
    unsigned sum, cnt, mine, sp = 0u;
    for (;;) {
        sum = 0u; cnt = 0u; mine = 0u;
#pragma unroll
        for (unsigned j = 0; j < 16; ++j) { const unsigned c = xb_ld(&bar[XB_XCNT(j)]); sum += c; cnt += (c > 0u) ? 1u : 0u; mine = (j == x) ? c : mine; }
        if (sum == G) break;
        __builtin_amdgcn_s_sleep(1);
        if ((++sp & 255u) == 0u) { if (xb_ld(&bar[XB_TMO])) break; if (sp > XB_SPIN_CAP) { atomicAdd(&bar[XB_TMO], 1u); break; } }
    }
    nloc = mine > 0u ? mine : 1u; nx = cnt > 0u ? cnt : 1u;
}

__device__ __forceinline__ void xcd_barrier(const XcdBarrier& b) {
    asm volatile("s_waitcnt vmcnt(0)" ::: "memory");
    __syncthreads();
    if (threadIdx.x == 0) {
        unsigned* bar = b.bar;
        __builtin_amdgcn_s_waitcnt(0);
        unsigned nloc = b.st[0], nx = b.st[1];
        if (nloc == 0u) { xcd_barrier_complete(bar, b.x, nloc, nx); b.st[0] = nloc; b.st[1] = nx; }
        const unsigned old = xb_add(&bar[XB_XSUB(b.x)], 1u);
        const unsigned gen = old / nloc;
        if (old + 1u == (gen + 1u) * nloc) {
            __builtin_amdgcn_fence(__ATOMIC_RELEASE, "agent");
            asm volatile("s_waitcnt vmcnt(0)" ::: "memory");
            const unsigned og = xb_add(&bar[XB_TOP], 1u);
            const unsigned tg = og / nx;
            if (og + 1u == (tg + 1u) * nx) xb_add(&bar[XB_TOPGEN], 1u);
            else XB_SPIN(xb_ld(&bar[XB_TOPGEN]) == tg, bar);
            __builtin_amdgcn_fence(__ATOMIC_ACQUIRE, "agent");
            xb_add(&bar[XB_XGEN(b.x)], 1u);
            asm volatile("s_waitcnt vmcnt(0)" ::: "memory");
        } else {
            XB_SPIN(xb_ld(&bar[XB_XGEN(b.x)]) == gen, bar);
            __builtin_amdgcn_fence(__ATOMIC_ACQUIRE, "agent");
            asm volatile("s_waitcnt vmcnt(0)" ::: "memory");
        }
    }
    __syncthreads();
}

constexpr int N_PHASES = 19;
__global__ void __launch_bounds__(512, 2) fwd_megakernel(Args args) {
    extern __shared__ __attribute__((aligned(16))) unsigned char lds_raw[];
    cg::grid_group grid = cg::this_grid();
    Frame F;
    F.lds = (LAS unsigned char*)lds_raw;
    F.G = gridDim.x;
    F.in = args.in; F.out = args.out; F.ws = args.ws;
    unsigned char* ws = args.ws;
    const int lo = args.ph_lo, hi = args.ph_hi;
    { volatile LAS unsigned* st = (volatile LAS unsigned*)(F.lds + LDS_MISC + 16); if (threadIdx.x < 2) st[threadIdx.x] = 0u; __syncthreads(); }
    XcdBarrier xbar = xcd_barrier_post((unsigned*)(ws + WS_CTL + 4096), (volatile LAS unsigned*)(F.lds + LDS_MISC + 16));
    LAS float* red = (LAS float*)(F.lds + LDS_RED);
    const float* MODF = (const float*)(ws + WS_MODF);
#ifndef PHASE_MASK
#define PHASE_MASK 0xFFFFFFFFu
#endif
#define PH(k) ((((PHASE_MASK) >> (k)) & 1u) && lo <= (k) && (k) < hi)
#ifndef REPEAT_MASK
#define REPEAT_MASK 0u
#endif
#define REP(k) for (int rep_ = 0; rep_ < 1 + (int)(((REPEAT_MASK) >> (k)) & 1u); ++rep_)
#define SEAM(k) do { if (PH(k) && PH((k) + 1)) { if ((k) == 0) { \
        asm volatile("s_waitcnt vmcnt(0) lgkmcnt(0)" ::: "memory"); __syncthreads(); \
        if (threadIdx.x == 0) { __builtin_amdgcn_fence(__ATOMIC_RELEASE, "agent"); asm volatile("s_waitcnt vmcnt(0)" ::: "memory"); } \
        grid.sync(); \
        if (threadIdx.x == 0) { __builtin_amdgcn_fence(__ATOMIC_ACQUIRE, "agent"); asm volatile("s_waitcnt vmcnt(0)" ::: "memory"); } \
        __syncthreads(); } else xcd_barrier(xbar); } } while (0)
#define GEMM(EPI, A_, B_, M_, N_, K_, E_) do { int k_ = (K_); asm volatile("" : "+s"(k_)); pg8::Gemm g_{(const bf16_t*)(A_), (const bf16_t*)(B_), (M_), (N_), k_, k_}; pg8::StaticOrder S_; S_.init((M_), (N_), F.G, (int)((blockIdx.x + gemm_rot_) % F.G)); \
        pg8::gemm_phase<EPI, pg8::StaticOrder, true, true>(F.lds, g_, S_, (E_)); } while (0)

#define GEMM_TAIL(A_, B_, KFULL_) do { int k_ = (KFULL_) / KSPL; asm volatile("" : "+s"(k_)); pg8::Gemm g_{(const bf16_t*)(A_), (const bf16_t*)(B_), MS, 1024, k_, (KFULL_)}; pg8::TailOrder S_; S_.init(MS, 1024, KSPL, F.G, (int)blockIdx.x); \
        EpiPart E_{(float*)(ws + WS_PBUF)}; pg8::gemm_phase<EpiPart, pg8::TailOrder, true, true>(F.lds, g_, S_, E_); } while (0)
    int gemm_rot_ = 0;
    if (PH(0)) REP(0) p0_phase(F);
    SEAM(0);
    if (PH(1)) REP(1) modnorm_phase<0>(F, 0, 0, nullptr, nullptr);
    SEAM(1);
    if (PH(2)) REP(2) { EpiF32 E{(float*)(ws + WS_A0), 768}; GEMM(EpiF32, ws + WS_H, ws + WS_WIN, MT, 768, 1024, E);
        if (blockIdx.x >= 134) { EpiKN E2{(bf16_t*)(ws + WS_KN), (float*)(ws + WS_RS), F.in[20], red, MKN / 256 - 92}; int k_ = 256; asm volatile("" : "+s"(k_));
            pg8::Gemm g_{(const bf16_t*)(ws + WS_CKV) + (size_t)(MKN / 256 - 92) * 256 * 256, (const bf16_t*)(ws + WS_WUK), 92 * 256, 1024, k_, k_}; pg8::StaticOrder S_; S_.init(92 * 256, 1024, 122, (int)blockIdx.x - 134);
            pg8::gemm_phase<EpiKN, pg8::StaticOrder, true, true>(F.lds, g_, S_, E2); } }
    SEAM(2);
    if (PH(3)) REP(3) latent_phase(F);
    SEAM(3);
    if (PH(4)) REP(4) {
#if !defined(P4_ONLY) || P4_ONLY == 1
        { EpiKN E{(bf16_t*)(ws + WS_KN), (float*)(ws + WS_RS), F.in[20], red, 0}; GEMM(EpiKN, ws + WS_CKV, ws + WS_WUK, MKN - 92 * 256, 1024, 256, E); }
#endif
#if !defined(P4_ONLY) || P4_ONLY == 2
        gemm_rot_ = 96;
        { EpiQ E{(bf16_t*)(ws + WS_A0), F.in[18], F.in[19], red}; GEMM(EpiQ, ws + WS_CQ, ws + WS_WQ, MT, 1536, 384, E); }
#endif
#if !defined(P4_ONLY) || P4_ONLY == 3
        gemm_rot_ = 56;
        { EpiBf16<0> E{(bf16_t*)(ws + WS_V), 1024}; GEMM(EpiBf16<0>, ws + WS_CKV, ws + WS_WUV, MT, 1024, 256, E); }
        gemm_rot_ = 0;
#endif
    }
    SEAM(4);
    if (PH(5)) REP(5) attention_phase(F, (unsigned*)(ws + WS_CTL) + rep_, rep_ != 0);
    SEAM(5);
    if (PH(6)) REP(6) combine_phase(F);
    SEAM(6);
    if (PH(7)) REP(7) { EpiResid E{F.in[0], F.out, MODF + 2048}; GEMM(EpiResid, ws + WS_H, ws + WS_WO, MP, 1024, 1024, E); GEMM_TAIL(ws + WS_H + (size_t)MP * 1024 * 2, ws + WS_WO, 1024); }
    SEAM(7);
    if (PH(8)) REP(8) modnorm_phase<1>(F, 0, 1, MODF + 2048, F.in[1]);
    SEAM(8);
    if (PH(9)) REP(9) { EpiBf16<1> E{(bf16_t*)(ws + WS_HF), 4096}; GEMM(EpiBf16<1>, ws + WS_H, ws + WS_W1, MT, 4096, 1024, E);
        if (blockIdx.x >= 32 && rep_ == 0) deferred_transposes(F, 0, ((int)blockIdx.x - 32) * 8 + __builtin_amdgcn_readfirstlane((int)threadIdx.x >> 6), (F.G - 32) * 8); }
    SEAM(9);
    if (PH(10)) REP(10) { EpiResid E{F.out, F.out, MODF + 5120}; GEMM(EpiResid, ws + WS_HF, ws + WS_W2, MP, 1024, 4096, E); GEMM_TAIL(ws + WS_HF + (size_t)MP * 4096 * 2, ws + WS_W2, 4096); }
#ifdef DUP_W2
    if (PH(10)) { EpiBf16<0> E{(bf16_t*)(ws + WS_H), 1024}; GEMM(EpiBf16<0>, ws + WS_HF, ws + WS_W2, MP, 1024, 4096, E); }
#endif
#ifdef EXTRA_SYNCS
    for (int es_ = 0; es_ < EXTRA_SYNCS; ++es_) SEAM(10);
#endif
    SEAM(10);
    if (PH(11)) REP(11) modnorm_phase<1>(F, 1, 0, MODF + 5120, nullptr);
    SEAM(11);
    if (PH(12)) REP(12) {
        { EpiBf16<2> E{(bf16_t*)(ws + WS_U), 1024}; GEMM(EpiBf16<2>, ws + WS_H, ws + WS_CWIN, MT, 1024, 1024, E); }
        gemm_rot_ = 128;
        { EpiVT E{(bf16_t*)(ws + WS_VT), (float*)(ws + WS_SSV)}; GEMM(EpiVT, ws + WS_CWIN + (size_t)1024 * 1024 * 2, ws + WS_H, 1024, MT, 1024, E); }
        gemm_rot_ = 0;
        { const int bx = (int)blockIdx.x; const bool busy = bx < 8 || (bx >= 128 && bx < 136);
          if (!busy && rep_ == 0) { const int hidx = bx < 128 ? bx - 8 : bx - 16; deferred_transposes(F, 1, hidx * 8 + __builtin_amdgcn_readfirstlane((int)threadIdx.x >> 6), (F.G - 16) * 8); } }
    }
    SEAM(12);
    if (PH(13)) REP(13) sgu_phase(F);
    SEAM(13);
    if (PH(14)) REP(14) { EpiResid E{F.out, F.out, MODF + 40 * 6144 + 2048}; GEMM(EpiResid, ws + WS_G, ws + WS_CWO, MP, 1024, 1024, E); GEMM_TAIL(ws + WS_G + (size_t)MP * 1024 * 2, ws + WS_CWO, 1024); }
    SEAM(14);
    if (PH(15)) REP(15) modnorm_phase<1>(F, 1, 1, MODF + 40 * 6144 + 2048, nullptr);
    SEAM(15);
    if (PH(16)) REP(16) { EpiBf16<1> E{(bf16_t*)(ws + WS_HF), 4096}; GEMM(EpiBf16<1>, ws + WS_H, ws + WS_W1 + (size_t)4096 * 1024 * 2, MT, 4096, 1024, E); }
    SEAM(16);
    if (PH(17)) REP(17) { EpiResid E{F.out, F.out, MODF + 40 * 6144 + 5120}; GEMM(EpiResid, ws + WS_HF, ws + WS_W2 + (size_t)4096 * 1024 * 2, MP, 1024, 4096, E); GEMM_TAIL(ws + WS_HF + (size_t)MP * 4096 * 2, ws + WS_W2 + (size_t)4096 * 1024 * 2, 4096); }
    SEAM(17);
    if (PH(18)) REP(18) final_tail_phase(F, MODF + 40 * 6144 + 5120);
#undef PH
#undef SEAM
#undef GEMM
#undef GEMM_TAIL
}

#ifndef MK_N_LAUNCHES
#define MK_N_LAUNCHES 1
#endif
extern "C" void kernel_launch(void* const* d_in, const int* in_sizes, int n_in, void* d_out, int out_size, void* d_ws, size_t ws_size, hipStream_t stream) {
    static int grid = 0;
    if (grid == 0) {
        if (n_in != 28 || (size_t)out_size != OUT_END || ws_size < WS_END) { fprintf(stderr, "kernel_launch: unexpected shapes: n_in %d out %d ws %zu\n", n_in, out_size, ws_size); grid = -1; return; }
        int dev = 0, cus = 0, per_cu = 0;
        hipGetDevice(&dev); hipDeviceGetAttribute(&cus, hipDeviceAttributeMultiprocessorCount, dev);
        if (hipFuncSetAttribute((const void*)fwd_megakernel, hipFuncAttributeMaxDynamicSharedMemorySize, LDS_BYTES) != hipSuccess) { fprintf(stderr, "kernel_launch: hipFuncSetAttribute failed\n"); grid = -1; return; }
        if (hipOccupancyMaxActiveBlocksPerMultiprocessor(&per_cu, (const void*)fwd_megakernel, 512, LDS_BYTES) != hipSuccess || per_cu < 1) { fprintf(stderr, "kernel_launch: occupancy query says %d\n", per_cu); per_cu = 1; }
        (void)hipGetLastError();
        grid = cus;
        fprintf(stderr, "kernel_launch: grid %d (per_cu %d)\n", grid, per_cu);
    }
    if (grid < 0) return;
    (void)hipMemsetAsync((char*)d_ws + WS_CTL, 0, CTL_BYTES, stream);
    Args a{};
    for (int i = 0; i < 28; ++i) a.in[i] = (const float*)d_in[i];
    a.out = (float*)d_out; a.ws = (unsigned char*)d_ws;
#if MK_N_LAUNCHES == 1
#ifndef PH_HI_TEST
#define PH_HI_TEST N_PHASES
#endif
    a.ph_lo = 0; a.ph_hi = PH_HI_TEST;
    void* params[] = {&a};
    hipError_t e = hipLaunchCooperativeKernel((const void*)fwd_megakernel, dim3(grid), dim3(512), params, LDS_BYTES, stream);
    if (e != hipSuccess) fprintf(stderr, "kernel_launch: cooperative launch failed: %s (grid %d)\n", hipGetErrorString(e), grid);
#else
    for (int p = 0; p < N_PHASES; ++p) { a.ph_lo = p; a.ph_hi = p + 1; hipLaunchKernelGGL(fwd_megakernel, dim3(grid), dim3(512), LDS_BYTES, stream, a); }
#endif
}
```

```cpp
#include <hip/hip_runtime.h>
#include <hip/hip_cooperative_groups.h>
#include <cstdio>
#include <cstdint>
namespace cg = cooperative_groups;

#define LAS __attribute__((address_space(3)))
typedef unsigned short bf16_t;
typedef short bf16x8 __attribute__((ext_vector_type(8)));
typedef short s16x4 __attribute__((ext_vector_type(4)));
typedef float f32x4 __attribute__((ext_vector_type(4)));
typedef float f32x2 __attribute__((ext_vector_type(2)));
typedef float f32x16 __attribute__((ext_vector_type(16)));
typedef unsigned u32x4 __attribute__((ext_vector_type(4)));
typedef unsigned u32x2 __attribute__((ext_vector_type(2)));

constexpr int DM = 1024, NB_P = 8, SEQ = 4096, NB_S = 32, DSEQ = 16, PAST = 4096;
constexpr int MP = NB_P * SEQ;
constexpr int MS = NB_S * DSEQ;
constexpr int MT = MP + MS;
constexpr int NSEQ = NB_P + NB_S;
constexpr int NH = 8, DNOPE = 128, DROPE = 64, DV = 128, QLORA = 384, KVLORA = 256, DFF = 4096;
constexpr int NCACHE = NB_S * PAST;
constexpr int MKN = MT + NCACHE;
constexpr int VTP = 33536;
constexpr float EPS = 1e-6f;
constexpr float SM_SCALE = 0.07216878364870322f;
constexpr int NSPLIT = 4;
constexpr size_t OUT_Y = 0, OUT_CKVP = (size_t)MT * DM, OUT_KPEP = OUT_CKVP + (size_t)MP * 256, OUT_CKVS = OUT_KPEP + (size_t)MP * 64,
                 OUT_KPES = OUT_CKVS + (size_t)MS * 256, OUT_VS = OUT_KPES + (size_t)MS * 64, OUT_END = OUT_VS + (size_t)MS * DM;
constexpr size_t MiB = 1u << 20;
constexpr size_t WS_CTL = 0, CTL_BYTES = 32768;
constexpr size_t WS_WIN = 1 * MiB;
constexpr size_t WS_WQ = WS_WIN + 768 * 1024 * 2;
constexpr size_t WS_WUK = WS_WQ + 1536 * 384 * 2;
constexpr size_t WS_WUV = WS_WUK + 1024 * 256 * 2;
constexpr size_t WS_WUKN = WS_WUV + 1024 * 256 * 2;
constexpr size_t WS_WO = WS_WUKN + 1024 * 256 * 2;
constexpr size_t WS_W1 = WS_WO + 1024 * 1024 * 2;
constexpr size_t WS_W2 = WS_W1 + 2ull * 4096 * 1024 * 2;
constexpr size_t WS_CWIN = WS_W2 + 2ull * 4096 * 1024 * 2;
constexpr size_t WS_CWO = WS_CWIN + 2048 * 1024 * 2;
constexpr size_t WS_WEND = WS_CWO + 1024 * 1024 * 2;
static_assert(WS_WEND <= 46 * MiB, "weights");
constexpr size_t WS_MODF = 46 * MiB;
constexpr size_t WS_SSV = 48 * MiB;
constexpr size_t WS_PBUF = 50 * MiB;
constexpr int KSPL = 8;
constexpr size_t WS_PART = 50 * MiB;
constexpr size_t WS_ML = 66 * MiB;
constexpr size_t WS_H = 67 * MiB;
constexpr size_t WS_A0 = 132 * MiB;
constexpr size_t WS_CQ = 230 * MiB;
constexpr size_t WS_CKV = 255 * MiB;
constexpr size_t WS_KR = 336 * MiB;
constexpr size_t WS_KPE = 341 * MiB;
constexpr size_t WS_RS = 357 * MiB;
constexpr size_t WS_KN = 363 * MiB;
constexpr size_t WS_V = 428 * MiB;
constexpr size_t WS_END = 493 * MiB;
constexpr size_t WS_HF = 132 * MiB;
constexpr size_t WS_U = 132 * MiB;
constexpr size_t WS_VT = 197 * MiB;
constexpr size_t WS_G = 263 * MiB;
static_assert(WS_CKV + (size_t)MKN * 256 * 2 <= WS_KR && WS_RS + (size_t)MKN * 32 <= WS_KN && WS_V + (size_t)MT * 2048 <= WS_END, "ws map");
static_assert(WS_VT + (size_t)1024 * VTP * 2 <= WS_G && WS_HF + (size_t)MT * 8192 <= WS_END, "ws map 2");
constexpr int LDS_BYTES = 147456;
constexpr int LDS_RED = 131072;
constexpr int LDS_MISC = 147392;

typedef __bf16 bf16x2_t __attribute__((ext_vector_type(2)));
__device__ __forceinline__ unsigned cvt_pk_bf16(float lo, float hi) { const f32x2 v = {lo, hi}; const bf16x2_t b = __builtin_convertvector(v, bf16x2_t); return __builtin_bit_cast(unsigned, b); }
__device__ __forceinline__ float bf2f(bf16_t b) { return __uint_as_float(((unsigned)b) << 16); }
__device__ __forceinline__ float bflo(unsigned w) { return __uint_as_float(w << 16); }
__device__ __forceinline__ float bfhi(unsigned w) { return __uint_as_float(w & 0xffff0000u); }
__device__ __forceinline__ bf16_t f2bf(float f) { return (bf16_t)(cvt_pk_bf16(f, 0.f) & 0xffffu); }
template <int X> __device__ __forceinline__ float swz_xor(float v) { return __int_as_float(__builtin_amdgcn_ds_swizzle(__float_as_int(v), (X << 10) | 0x1f)); }
__device__ __forceinline__ float sum_x32(float v) { auto rr = __builtin_amdgcn_permlane32_swap(__float_as_uint(v), __float_as_uint(v), false, false); return __uint_as_float(rr[0]) + __uint_as_float(rr[1]); }
__device__ __forceinline__ float wave_sum(float v) { v += swz_xor<1>(v); v += swz_xor<2>(v); v += swz_xor<4>(v); v += swz_xor<8>(v); v += swz_xor<16>(v); return sum_x32(v); }
__device__ __forceinline__ float gelu_tanh(float x) {
    const float u = 0.7978845608028654f * (x + 0.044715f * x * x * x);
    return x * __builtin_amdgcn_rcpf(1.f + __builtin_amdgcn_exp2f(-2.885390081777927f * u));
}
__device__ __forceinline__ void sincos_rev(float ang, float& s, float& c) {
    float rev = ang * 0.15915494309189535f; rev -= floorf(rev);
    s = __builtin_amdgcn_sinf(rev); c = __builtin_amdgcn_cosf(rev);
}
__device__ __forceinline__ float rope_inv(int i) { return __builtin_amdgcn_exp2f(-(float)i * (13.287712379549449f / 32.f)); }
__device__ __forceinline__ int row_pos(int r) { return r < MP ? (r & (SEQ - 1)) : PAST + ((r - MP) & (DSEQ - 1)); }
__device__ __forceinline__ int row_seq(int r) { return r < MP ? (r >> 12) : NB_P + ((r - MP) >> 4); }

namespace pg8 {
#define PG8_LAS __attribute__((address_space(3)))
constexpr int BM = 256, BK = 64, HALF = 128, HTB = HALF * BK * 2  , STAGE_BYTES = 8 * HTB, NXCD = 8, WGM = 8;
__host__ __device__ __forceinline__ int lds_byte(int r, int c) { const int st = (r >> 4) * 2 + (c >> 5), rr = r & 15, cc = c & 31, ob = rr * 64 + cc * 2; return st * 1024 + (ob ^ (((ob >> 9) & 1) << 5)); }
__host__ __device__ __forceinline__ void stage_rc(int b, int& R, int& C) { const int st = b / 1024, sb = b % 1024, swz = sb ^ (((sb >> 9) & 1) << 5); R = (st >> 1) * 16 + swz / 64; C = (st & 1) * 32 + (swz % 64) / 2; }
__host__ __device__ __forceinline__ int perm32(int rho) { const int n = rho >> 4, i = rho & 15; return 8 * (i >> 2) + 4 * n + (i & 3); }
struct Unit { int pm, pn, pk; };
struct Gemm { const bf16_t* A; const bf16_t* Bt; int M, N, K, ld; };
struct StaticOrder {
    int nM, nN, nwg, G, c;
    __host__ __device__ void init(int M, int N, int G_, int c_) { nM = M / BM; nN = N / BM; nwg = nM * nN; G = G_; c = c_; }
    __host__ __device__ bool next(int i, Unit& u) const {
        const long L = (long)i * G + c; if (L >= nwg) return false;
        int wgid = (int)L; { const int q = nwg / NXCD, r = nwg % NXCD, xcd = wgid % NXCD, off = wgid / NXCD; wgid = (xcd < r ? xcd * (q + 1) : r * (q + 1) + (xcd - r) * q) + off; }
        const int nig = WGM * nN, gid = wgid / nig, fm = gid * WGM, gsz = (nM - fm) < WGM ? (nM - fm) : WGM;
        u.pm = fm + ((wgid % nig) % gsz); u.pn = (wgid % nig) / gsz; u.pk = 0; return true;
    }
    __device__ __forceinline__ void a_ready(const Unit&) const {}
    __device__ __forceinline__ void done(const Unit&) const {}
};
struct TailOrder {
    int nM, nN, KS, G, c;
    __host__ __device__ void init(int M, int N, int KS_, int G_, int c_) { nM = M / BM; nN = N / BM; KS = KS_; G = G_; c = c_; }
    __host__ __device__ bool next(int i, Unit& u) const {
        const long L = (long)i * G + c; if (L >= (long)nM * nN * KS) return false;
        const int t = (int)L % (nM * nN); u.pk = (int)L / (nM * nN); u.pm = t % nM; u.pn = t / nM; return true;
    }
    __device__ __forceinline__ void a_ready(const Unit&) const {}
    __device__ __forceinline__ void done(const Unit&) const {}
};
template <class Epi, class Sched, bool ALIGN_EPI = false, bool SP2 = false>
__device__ __forceinline__ void gemm_phase(PG8_LAS unsigned char* lds, const Gemm g, const Sched& S, const Epi& E) {
    int tid_l = threadIdx.x; asm volatile("" : "+v"(tid_l));
    const int tid = tid_l, wid = __builtin_amdgcn_readfirstlane(tid >> 6), lane = tid & 63, wr = wid >> 2, wc = wid & 3, fr = lane & 15, fq = lane >> 4;
    const int K = g.K, nt = K / BK, ld = g.ld;
    unsigned voffA[2], voffB[2];
#pragma unroll
    for (int i = 0; i < 2; ++i) { int R, C; stage_rc(tid * 16 + i * 8192, R, C); const int Rb = Epi::PERM ? ((R & ~31) + perm32(R & 31)) : R;
        voffA[i] = (unsigned)(R * ld + C) * 2u; voffB[i] = (unsigned)(Rb * ld + C) * 2u; }
    const size_t kstep = (size_t)(BK * 2);
    const size_t hstep = (size_t)HALF * ld * 2;
    const size_t tstep = 2 * hstep;
    const unsigned ldsw = (unsigned)wid * 1024u;
    const int aoff = lds_byte(wr * 64 + fr, fq * 8), boff = lds_byte(wc * 32 + fr, fq * 8);
#define PG8_SA(b, h) (((b) * 2 + (h)) * HTB)
#define PG8_SB(b, h) ((4 + (b) * 2 + (h)) * HTB)
#define PG8_STAGE(bufoff, gbase, voff) do { _Pragma("unroll") for (int _i = 0; _i < 2; ++_i) \
        __builtin_amdgcn_global_load_lds((const unsigned*)((const char*)(gbase) + (voff)[_i]), (PG8_LAS unsigned*)(lds + (bufoff) + ldsw + _i * 8192), 16, 0, 0); } while (0)
#define PG8_LDA(dst, b, h) do { _Pragma("unroll") for (int m = 0; m < 4; ++m) _Pragma("unroll") for (int k = 0; k < 2; ++k) dst[m][k] = *(const PG8_LAS bf16x8*)(lds + PG8_SA(b, h) + aoff + m * 2048 + k * 1024); } while (0)
#define PG8_LDB(dst, b, h) do { _Pragma("unroll") for (int n = 0; n < 2; ++n) _Pragma("unroll") for (int k = 0; k < 2; ++k) dst[n][k] = *(const PG8_LAS bf16x8*)(lds + PG8_SB(b, h) + boff + n * 2048 + k * 1024); } while (0)
#define PG8_MMA(ai, bj, At, Bt) do { __builtin_amdgcn_s_setprio(1); _Pragma("unroll") for (int m = 0; m < 4; ++m) _Pragma("unroll") for (int n = 0; n < 2; ++n) _Pragma("unroll") for (int k = 0; k < 2; ++k) \
        acc[ai][bj][m][n] = __builtin_amdgcn_mfma_f32_16x16x32_bf16(Bt[n][k], At[m][k], acc[ai][bj][m][n], 0, 0, 0); __builtin_amdgcn_s_setprio(0); } while (0)
#define PG8_WAIT_V(n) asm volatile("s_waitcnt vmcnt(" #n ")" ::: "memory")
#define PG8_WAIT_L(n) asm volatile("s_waitcnt lgkmcnt(" #n ")" ::: "memory")
#define PG8_BAR __builtin_amdgcn_s_barrier()
#define PG8_SCHED __builtin_amdgcn_sched_barrier(0)
    Unit cur, nxt; int ui = 0;
    if (!S.next(0, cur)) return;
    f32x4 acc[2][2][4][2];
#pragma unroll
    for (int a = 0; a < 2; ++a)
#pragma unroll
        for (int b = 0; b < 2; ++b)
#pragma unroll
            for (int m = 0; m < 4; ++m)
#pragma unroll
                for (int n = 0; n < 2; ++n) acc[a][b][m][n] = (f32x4){0.f, 0.f, 0.f, 0.f};
    bf16x8 At[4][2], B0[2][2], B1[2][2];
    const char* cA = (const char*)g.A + (size_t)cur.pm * tstep + (size_t)cur.pk * K * 2; const char* cB = (const char*)g.Bt + (size_t)cur.pn * tstep + (size_t)cur.pk * K * 2;
    S.a_ready(cur);
    if constexpr (SP2) {
        PG8_STAGE(PG8_SB(0, 0), cB, voffB); PG8_STAGE(PG8_SB(0, 1), cB + hstep, voffB); PG8_STAGE(PG8_SA(0, 0), cA, voffA); PG8_STAGE(PG8_SA(0, 1), cA + hstep, voffA);
        if (wr == 1) PG8_BAR;
        PG8_WAIT_V(2); PG8_BAR;
        PG8_STAGE(PG8_SB(1, 0), cB + kstep, voffB); PG8_STAGE(PG8_SA(1, 0), cA + kstep, voffA); PG8_STAGE(PG8_SB(1, 1), cB + hstep + kstep, voffB);
        PG8_WAIT_V(6); PG8_BAR;
    } else {
        PG8_STAGE(PG8_SB(0, 0), cB, voffB); PG8_STAGE(PG8_SA(0, 0), cA, voffA); PG8_STAGE(PG8_SB(0, 1), cB + hstep, voffB); PG8_STAGE(PG8_SA(0, 1), cA + hstep, voffA);
        if (wr == 1) PG8_BAR;
        PG8_WAIT_V(4); PG8_BAR;
        PG8_STAGE(PG8_SB(1, 0), cB + kstep, voffB); PG8_STAGE(PG8_SA(1, 0), cA + kstep, voffA); PG8_STAGE(PG8_SB(1, 1), cB + hstep + kstep, voffB);
        PG8_WAIT_V(6); PG8_BAR;
    }
    for (;;) {
        const bool has_next = S.next(ui + 1, nxt);
        const char* nA = has_next ? (const char*)g.A + (size_t)nxt.pm * tstep + (size_t)nxt.pk * K * 2 : cA; const char* nB = has_next ? (const char*)g.Bt + (size_t)nxt.pn * tstep + (size_t)nxt.pk * K * 2 : cB;
        for (int t = 0; t < nt; t += 2) {
            const bool last = (t == nt - 2);
            const char* a1 = cA + (size_t)(t + 1) * kstep;
            const char* a2 = last ? nA : cA + (size_t)(t + 2) * kstep; const char* b2 = last ? nB : cB + (size_t)(t + 2) * kstep;
            const char* a3 = a2 + kstep; const char* b3 = b2 + kstep;
            if (last && has_next) S.a_ready(nxt);
            if constexpr (SP2) {
            PG8_LDB(B0, 0, 0); PG8_LDB(B1, 0, 1); PG8_SCHED; PG8_LDA(At, 0, 0); PG8_STAGE(PG8_SA(1, 1), a1 + hstep, voffA);
            PG8_WAIT_V(8); PG8_WAIT_L(0); PG8_BAR; PG8_MMA(0, 0, At, B0); PG8_MMA(0, 1, At, B1); PG8_BAR; PG8_SCHED;
            PG8_LDA(At, 0, 1); PG8_STAGE(PG8_SB(0, 0), b2, voffB); PG8_STAGE(PG8_SB(0, 1), b2 + hstep, voffB); PG8_STAGE(PG8_SA(0, 0), a2, voffA);
            PG8_WAIT_V(8); PG8_WAIT_L(0); PG8_BAR; PG8_MMA(1, 0, At, B0); PG8_MMA(1, 1, At, B1); PG8_BAR; PG8_SCHED;
            PG8_LDB(B0, 1, 0); PG8_LDB(B1, 1, 1); PG8_SCHED; PG8_LDA(At, 1, 0); PG8_STAGE(PG8_SA(0, 1), a2 + hstep, voffA);
            PG8_WAIT_V(8); PG8_WAIT_L(0); PG8_BAR; PG8_MMA(0, 0, At, B0); PG8_MMA(0, 1, At, B1); PG8_BAR; PG8_SCHED;
            PG8_LDA(At, 1, 1); PG8_STAGE(PG8_SB(1, 0), b3, voffB); PG8_STAGE(PG8_SB(1, 1), b3 + hstep, voffB); PG8_STAGE(PG8_SA(1, 0), a3, voffA);
            PG8_WAIT_V(8); PG8_WAIT_L(0); PG8_BAR; PG8_MMA(1, 0, At, B0); PG8_MMA(1, 1, At, B1); PG8_BAR; PG8_SCHED;
            } else {
            PG8_LDB(B0, 0, 0); PG8_SCHED; PG8_LDA(At, 0, 0); PG8_STAGE(PG8_SA(1, 1), a1 + hstep, voffA);
            PG8_WAIT_L(8); PG8_BAR; PG8_WAIT_L(0); PG8_MMA(0, 0, At, B0); PG8_BAR; PG8_SCHED;
            PG8_LDB(B1, 0, 1); PG8_STAGE(PG8_SB(0, 0), b2, voffB);
            PG8_BAR; PG8_WAIT_L(0); PG8_MMA(0, 1, At, B1); PG8_BAR;
            PG8_LDA(At, 0, 1); PG8_STAGE(PG8_SA(0, 0), a2, voffA);
            PG8_BAR; PG8_WAIT_L(0); PG8_MMA(1, 0, At, B0); PG8_BAR; PG8_SCHED;
            PG8_STAGE(PG8_SB(0, 1), b2 + hstep, voffB);
            PG8_WAIT_V(6); PG8_BAR; PG8_MMA(1, 1, At, B1); PG8_BAR;
            PG8_LDB(B0, 1, 0); PG8_SCHED; PG8_LDA(At, 1, 0); PG8_STAGE(PG8_SA(0, 1), a2 + hstep, voffA);
            PG8_WAIT_L(8); PG8_BAR; PG8_WAIT_L(0); PG8_MMA(0, 0, At, B0); PG8_BAR; PG8_SCHED;
            PG8_LDB(B1, 1, 1); PG8_STAGE(PG8_SB(1, 0), b3, voffB);
            PG8_BAR; PG8_WAIT_L(0); PG8_MMA(0, 1, At, B1); PG8_BAR;
            PG8_LDA(At, 1, 1); PG8_STAGE(PG8_SA(1, 0), a3, voffA);
            PG8_BAR; PG8_WAIT_L(0); PG8_MMA(1, 0, At, B0); PG8_BAR; PG8_SCHED;
            PG8_STAGE(PG8_SB(1, 1), b3 + hstep, voffB);
            PG8_WAIT_V(6); PG8_BAR; PG8_MMA(1, 1, At, B1); PG8_BAR;
            }
        }
        if constexpr (ALIGN_EPI) { if (wr == 0) PG8_BAR; }
        if constexpr (!Epi::AFTER_DRAIN) { E(acc, cur, wr, wc, fr, fq); S.done(cur); }
        if (!has_next) break;
#pragma unroll
        for (int a = 0; a < 2; ++a)
#pragma unroll
            for (int b = 0; b < 2; ++b)
#pragma unroll
                for (int m = 0; m < 4; ++m)
#pragma unroll
                    for (int n = 0; n < 2; ++n) acc[a][b][m][n] = (f32x4){0.f, 0.f, 0.f, 0.f};
        cur = nxt; cA = nA; cB = nB; ++ui;
        if constexpr (ALIGN_EPI) { if (wr == 1) PG8_BAR; }
    }
    PG8_WAIT_V(0);
    if constexpr (!ALIGN_EPI) { if (wr == 0) PG8_BAR; }
    PG8_BAR;
    if constexpr (Epi::AFTER_DRAIN) { E.fused(acc, cur, wr, wc, fr, fq, lds, wid, lane); S.done(cur); }
#undef PG8_SA
#undef PG8_SB
#undef PG8_STAGE
#undef PG8_LDA
#undef PG8_LDB
#undef PG8_MMA
#undef PG8_WAIT_V
#undef PG8_WAIT_L
#undef PG8_BAR
#undef PG8_SCHED
}
}

typedef f32x4 AccT[2][2][4][2];

struct EpiF32 {
    static constexpr bool PERM = false, AFTER_DRAIN = false;
    float* O; int ldc;
    __device__ __forceinline__ void operator()(const AccT& acc, const pg8::Unit& u, int wr, int wc, int fr, int fq) const {
        asm volatile("" : "+v"(fr), "+v"(fq));
        const int row0 = u.pm * 256 + wr * 64 + fr, col0 = u.pn * 256 + wc * 32 + 4 * fq;
#pragma unroll
        for (int ai = 0; ai < 2; ++ai)
#pragma unroll
            for (int m = 0; m < 4; ++m) { float* rowp = O + (size_t)(row0 + ai * 128 + m * 16) * ldc + col0;
#pragma unroll
                for (int bj = 0; bj < 2; ++bj)
#pragma unroll
                    for (int n = 0; n < 2; ++n) *(f32x4*)(rowp + bj * 128 + n * 16) = acc[ai][bj][m][n]; }
    }
};
struct EpiPart {
    static constexpr bool PERM = false, AFTER_DRAIN = false;
    float* P;
    __device__ __forceinline__ void operator()(const AccT& acc, const pg8::Unit& u, int wr, int wc, int fr, int fq) const {
        asm volatile("" : "+v"(fr), "+v"(fq));
        const int row0 = u.pm * 256 + wr * 64 + fr, col0 = u.pn * 256 + wc * 32 + 4 * fq;
        float* O = P + (size_t)u.pk * MS * DM;
#pragma unroll
        for (int ai = 0; ai < 2; ++ai)
#pragma unroll
            for (int m = 0; m < 4; ++m) { float* rowp = O + (size_t)(row0 + ai * 128 + m * 16) * DM + col0;
#pragma unroll
                for (int bj = 0; bj < 2; ++bj)
#pragma unroll
                    for (int n = 0; n < 2; ++n) *(f32x4*)(rowp + bj * 128 + n * 16) = acc[ai][bj][m][n]; }
    }
};
struct EpiResid {
    static constexpr bool PERM = false, AFTER_DRAIN = false;
    const float* xp; float* out; const float* gate;
    __device__ __forceinline__ void operator()(const AccT& acc, const pg8::Unit& u, int wr, int wc, int fr, int fq) const {
        asm volatile("" : "+v"(fr), "+v"(fq));
        const int row0 = u.pm * 256 + wr * 64 + fr, col0 = u.pn * 256 + wc * 32 + 4 * fq;
        const float* gp = gate + (size_t)(u.pm >> 4) * 6144 + col0;
        f32x4 gv[2][2];
#pragma unroll
        for (int bj = 0; bj < 2; ++bj)
#pragma unroll
            for (int n = 0; n < 2; ++n) gv[bj][n] = *(const f32x4*)(gp + bj * 128 + n * 16);
#pragma unroll
        for (int ai = 0; ai < 2; ++ai) {
            f32x4 xv[4][2][2];
#pragma unroll
            for (int m = 0; m < 4; ++m) { const float* xr = xp + (size_t)(row0 + ai * 128 + m * 16) * DM + col0;
#pragma unroll
                for (int bj = 0; bj < 2; ++bj)
#pragma unroll
                    for (int n = 0; n < 2; ++n) xv[m][bj][n] = *(const f32x4*)(xr + bj * 128 + n * 16); }
#pragma unroll
            for (int m = 0; m < 4; ++m) { float* op = out + (size_t)(row0 + ai * 128 + m * 16) * DM + col0;
#pragma unroll
                for (int bj = 0; bj < 2; ++bj)
#pragma unroll
                    for (int n = 0; n < 2; ++n) *(f32x4*)(op + bj * 128 + n * 16) = xv[m][bj][n] + gv[bj][n] * acc[ai][bj][m][n]; }
        }
    }
};
template <bool IN32, bool OUT32> struct EpiResidB {
    static constexpr bool PERM = true, AFTER_DRAIN = false;
    const void* xin; void* xout; const float* gate;
    __device__ __forceinline__ void operator()(const AccT& acc, const pg8::Unit& u, int wr, int wc, int fr, int fq) const {
        asm volatile("" : "+v"(fr), "+v"(fq));
        const int row0 = u.pm * 256 + wr * 64 + fr, col0 = u.pn * 256 + wc * 32 + 8 * fq;
        const float* gp = gate + (size_t)(u.pm >> 4) * 6144 + col0;
        f32x4 gv[2][2];
#pragma unroll
        for (int bj = 0; bj < 2; ++bj) { gv[bj][0] = *(const f32x4*)(gp + bj * 128); gv[bj][1] = *(const f32x4*)(gp + bj * 128 + 4); }
#pragma unroll
        for (int ai = 0; ai < 2; ++ai) {
            f32x4 xa[4][2][2];
#pragma unroll
            for (int m = 0; m < 4; ++m) { const size_t ro = (size_t)(row0 + ai * 128 + m * 16) * DM + col0;
#pragma unroll
                for (int bj = 0; bj < 2; ++bj) {
                    if (IN32) { const float* xr = (const float*)xin + ro + bj * 128; xa[m][bj][0] = *(const f32x4*)xr; xa[m][bj][1] = *(const f32x4*)(xr + 4); }
                    else { const u32x4 w = *(const u32x4*)((const bf16_t*)xin + ro + bj * 128);
                        xa[m][bj][0] = (f32x4){bflo(w.x), bfhi(w.x), bflo(w.y), bfhi(w.y)}; xa[m][bj][1] = (f32x4){bflo(w.z), bfhi(w.z), bflo(w.w), bfhi(w.w)}; } } }
#pragma unroll
            for (int m = 0; m < 4; ++m) { const size_t ro = (size_t)(row0 + ai * 128 + m * 16) * DM + col0;
#pragma unroll
                for (int bj = 0; bj < 2; ++bj) { const f32x4 x0 = xa[m][bj][0] + gv[bj][0] * acc[ai][bj][m][0], x1 = xa[m][bj][1] + gv[bj][1] * acc[ai][bj][m][1];
                    if (OUT32) { float* op = (float*)xout + ro + bj * 128; *(f32x4*)op = x0; *(f32x4*)(op + 4) = x1; }
                    else { u32x4 w; w.x = cvt_pk_bf16(x0[0], x0[1]); w.y = cvt_pk_bf16(x0[2], x0[3]); w.z = cvt_pk_bf16(x1[0], x1[1]); w.w = cvt_pk_bf16(x1[2], x1[3]);
                        *(u32x4*)((bf16_t*)xout + ro + bj * 128) = w; } } }
        }
    }
};
template <int ACT> struct EpiBf16 {
    static constexpr bool PERM = true, AFTER_DRAIN = false;
    bf16_t* O; int ldc;
    __device__ __forceinline__ void operator()(const AccT& acc, const pg8::Unit& u, int wr, int wc, int fr, int fq) const {
        asm volatile("" : "+v"(fr), "+v"(fq));
        const int row0 = u.pm * 256 + wr * 64 + fr, col0 = u.pn * 256 + wc * 32 + 8 * fq;
#pragma unroll
        for (int ai = 0; ai < 2; ++ai)
#pragma unroll
            for (int m = 0; m < 4; ++m) { bf16_t* rowp = O + (size_t)(row0 + ai * 128 + m * 16) * ldc + col0;
#pragma unroll
                for (int bj = 0; bj < 2; ++bj) { f32x4 v0 = acc[ai][bj][m][0], v1 = acc[ai][bj][m][1];
                    if (ACT == 1) {
#pragma unroll
                        for (int j = 0; j < 4; ++j) { const float a = fmaxf(v0[j], 0.f), b = fmaxf(v1[j], 0.f); v0[j] = a * a; v1[j] = b * b; } }
                    if (ACT == 2) {
#pragma unroll
                        for (int j = 0; j < 4; ++j) { v0[j] = gelu_tanh(v0[j]); v1[j] = gelu_tanh(v1[j]); } }
                    u32x4 w; w.x = cvt_pk_bf16(v0[0], v0[1]); w.y = cvt_pk_bf16(v0[2], v0[3]); w.z = cvt_pk_bf16(v1[0], v1[1]); w.w = cvt_pk_bf16(v1[2], v1[3]);
                    *(u32x4*)(rowp + bj * 128) = w; } }
    }
};
struct EpiVT {
    static constexpr bool PERM = true, AFTER_DRAIN = false;
    bf16_t* VT; float* SSV;
    __device__ __forceinline__ void operator()(const AccT& acc, const pg8::Unit& u, int wr, int wc, int fr, int fq) const {
        asm volatile("" : "+v"(fr), "+v"(fq));
        const int row0 = u.pm * 256 + wr * 64 + fr, col0 = u.pn * 256 + wc * 32 + 8 * fq;
        float s[2][2][4];
#pragma unroll
        for (int bj = 0; bj < 2; ++bj)
#pragma unroll
            for (int n = 0; n < 2; ++n)
#pragma unroll
                for (int j = 0; j < 4; ++j) s[bj][n][j] = 0.f;
#pragma unroll
        for (int ai = 0; ai < 2; ++ai)
#pragma unroll
            for (int m = 0; m < 4; ++m) { bf16_t* rowp = VT + (size_t)(row0 + ai * 128 + m * 16) * VTP + col0;
#pragma unroll
                for (int bj = 0; bj < 2; ++bj) { f32x4 v0 = acc[ai][bj][m][0], v1 = acc[ai][bj][m][1];
#pragma unroll
                    for (int j = 0; j < 4; ++j) { v0[j] = gelu_tanh(v0[j]); v1[j] = gelu_tanh(v1[j]); s[bj][0][j] += v0[j] * v0[j]; s[bj][1][j] += v1[j] * v1[j]; }
                    u32x4 w; w.x = cvt_pk_bf16(v0[0], v0[1]); w.y = cvt_pk_bf16(v0[2], v0[3]); w.z = cvt_pk_bf16(v1[0], v1[1]); w.w = cvt_pk_bf16(v1[2], v1[3]);
                    *(u32x4*)(rowp + bj * 128) = w; } }
        float* sp = SSV + (size_t)(u.pm * 2 + wr) * VTP + col0;
#pragma unroll
        for (int bj = 0; bj < 2; ++bj)
#pragma unroll
            for (int n = 0; n < 2; ++n) { f32x4 t;
#pragma unroll
                for (int j = 0; j < 4; ++j) { float x = s[bj][n][j]; x += swz_xor<1>(x); x += swz_xor<2>(x); x += swz_xor<4>(x); x += swz_xor<8>(x); t[j] = x; }
                if (fr == 0) *(f32x4*)(sp + bj * 128 + n * 4) = t; }
    }
};
__device__ __forceinline__ void head_ss(const AccT& acc, LAS float* red, int wr, int wc, int fr, int fq) {
    LAS float* rw = red + (wr * 64 + fr) * 8 + wc;
#pragma unroll
    for (int ai = 0; ai < 2; ++ai)
#pragma unroll
        for (int m = 0; m < 4; ++m)
#pragma unroll
            for (int bj = 0; bj < 2; ++bj) { const f32x4 a = acc[ai][bj][m][0], b = acc[ai][bj][m][1];
                float s = (a[0] * a[0] + a[1] * a[1]) + (a[2] * a[2] + a[3] * a[3]) + (b[0] * b[0] + b[1] * b[1]) + (b[2] * b[2] + b[3] * b[3]);
                s += swz_xor<16>(s); s = sum_x32(s);
                if (fq == 0) rw[(ai * 128 + m * 16) * 8 + bj * 4] = s; }
    asm volatile("s_waitcnt lgkmcnt(0)" ::: "memory"); __builtin_amdgcn_s_barrier(); asm volatile("" ::: "memory");
}
__device__ __forceinline__ float head_rs(const LAS float* red, int rowl, int bj) {
    const f32x4 t = *(const LAS f32x4*)(red + rowl * 8 + bj * 4);
    return __builtin_amdgcn_rsqf(((t[0] + t[1]) + (t[2] + t[3])) * (1.f / 128.f) + EPS);
}
__device__ __forceinline__ void head_done() { asm volatile("s_waitcnt lgkmcnt(0)" ::: "memory"); __builtin_amdgcn_s_barrier(); asm volatile("" ::: "memory"); }
struct EpiKN {
    static constexpr bool PERM = true, AFTER_DRAIN = false;
    bf16_t* KN; float* RS; const float* g; LAS float* red; int pm_off;
    __device__ __forceinline__ void operator()(const AccT& acc, const pg8::Unit& u, int wr, int wc, int fr, int fq) const {
        asm volatile("" : "+v"(fr), "+v"(fq));
        head_ss(acc, red, wr, wc, fr, fq);
        const int pmg = u.pm + pm_off; const int row0 = pmg * 256 + wr * 64 + fr, d0 = wc * 32 + 8 * fq;
        const float* gl = g + d0; asm volatile("" : "+v"(gl)); const f32x4 g0 = *(const f32x4*)gl, g1 = *(const f32x4*)(gl + 4);
#pragma unroll
        for (int ai = 0; ai < 2; ++ai)
#pragma unroll
            for (int m = 0; m < 4; ++m) { const int r = row0 + ai * 128 + m * 16;
#pragma unroll
                for (int bj = 0; bj < 2; ++bj) { const float s = head_rs(red + (wr * 64 + fr) * 8, ai * 128 + m * 16, bj); const int h = 2 * u.pn + bj;
                    if (wc == 0 && fq == 0) RS[(size_t)r * 8 + h] = s;
                    if (pmg < MT / 256) { const f32x4 v0 = acc[ai][bj][m][0] * s * g0, v1 = acc[ai][bj][m][1] * s * g1;
                        u32x4 w; w.x = cvt_pk_bf16(v0[0], v0[1]); w.y = cvt_pk_bf16(v0[2], v0[3]); w.z = cvt_pk_bf16(v1[0], v1[1]); w.w = cvt_pk_bf16(v1[2], v1[3]);
                        *(u32x4*)(KN + (size_t)r * 1024 + h * 128 + d0) = w; } } }
        head_done();
    }
};
struct EpiQ {
    static constexpr bool PERM = true, AFTER_DRAIN = false;
    bf16_t* Q; const float* gqn; const float* gqr; LAS float* red;
    __device__ __forceinline__ void operator()(const AccT& acc, const pg8::Unit& u, int wr, int wc, int fr, int fq) const {
        asm volatile("" : "+v"(fr), "+v"(fq));
        const int row0 = u.pm * 256 + wr * 64 + fr;
        if (u.pn < 4) {
            head_ss(acc, red, wr, wc, fr, fq);
            const int d0 = wc * 32 + 8 * fq;
            const float* gl = gqn + d0; asm volatile("" : "+v"(gl)); const f32x4 g0 = *(const f32x4*)gl, g1 = *(const f32x4*)(gl + 4);
#pragma unroll
            for (int ai = 0; ai < 2; ++ai)
#pragma unroll
                for (int m = 0; m < 4; ++m) { const int r = row0 + ai * 128 + m * 16;
#pragma unroll
                    for (int bj = 0; bj < 2; ++bj) { const float s = head_rs(red + (wr * 64 + fr) * 8, ai * 128 + m * 16, bj); const int h = 2 * u.pn + bj;
                        const f32x4 v0 = acc[ai][bj][m][0] * s * g0, v1 = acc[ai][bj][m][1] * s * g1;
                        u32x4 w; w.x = cvt_pk_bf16(v0[0], v0[1]); w.y = cvt_pk_bf16(v0[2], v0[3]); w.z = cvt_pk_bf16(v1[0], v1[1]); w.w = cvt_pk_bf16(v1[2], v1[3]);
                        *(u32x4*)(Q + (size_t)r * 1536 + h * 192 + d0) = w; } }
            head_done();
        } else {
            const int h = (u.pn - 4) * 4 + wc, i0c = 8 * fq;
            float gqa[8], gqb[8]; { const float* gl = gqr + i0c; asm volatile("" : "+v"(gl));
#pragma unroll
                for (int t = 0; t < 8; ++t) { gqa[t] = gl[t]; gqb[t] = gl[32 + t]; } }
#pragma unroll
            for (int ai = 0; ai < 2; ++ai)
#pragma unroll
                for (int m = 0; m < 4; ++m) { const int r = row0 + ai * 128 + m * 16; int i0 = i0c; asm volatile("" : "+v"(i0));
                    float ss = 0.f;
#pragma unroll
                    for (int n = 0; n < 2; ++n)
#pragma unroll
                        for (int j = 0; j < 4; ++j) { const float a = acc[ai][0][m][n][j], b = acc[ai][1][m][n][j]; ss += a * a + b * b; }
                    ss += swz_xor<16>(ss); ss = sum_x32(ss);
                    const float s = __builtin_amdgcn_rsqf(ss * (1.f / 64.f) + EPS); const float pos = (float)row_pos(r);
                    unsigned w1[4], w2[4];
#pragma unroll
                    for (int tp = 0; tp < 4; ++tp) { float oa[2], ob[2];
#pragma unroll
                        for (int e = 0; e < 2; ++e) { const int t = 2 * tp + e; float sn, cs; sincos_rev(pos * rope_inv(i0 + t), sn, cs);
                            const float y1 = acc[ai][0][m][t >> 2][t & 3] * s * gqa[t], y2 = acc[ai][1][m][t >> 2][t & 3] * s * gqb[t];
                            oa[e] = y1 * cs - y2 * sn; ob[e] = y2 * cs + y1 * sn; }
                        w1[tp] = cvt_pk_bf16(oa[0], oa[1]); w2[tp] = cvt_pk_bf16(ob[0], ob[1]); }
                    bf16_t* qp = Q + (size_t)r * 1536 + h * 192 + 128 + i0;
                    *(u32x4*)qp = (u32x4){w1[0], w1[1], w1[2], w1[3]}; *(u32x4*)(qp + 32) = (u32x4){w2[0], w2[1], w2[2], w2[3]};
                    asm volatile("" ::: "memory"); }
        }
    }
};

struct Args { const float* in[28]; float* out; unsigned char* ws; int ph_lo, ph_hi; };
struct Frame {
    LAS unsigned char* lds;
    int G;
    const float* const* in; float* out; unsigned char* ws;
};
#define LOCAL_IDS() int tid_l_ = threadIdx.x; asm volatile("" : "+v"(tid_l_)); const int tid = tid_l_, lane = tid & 63, wave = __builtin_amdgcn_readfirstlane(tid >> 6); (void)tid; (void)lane; (void)wave
#define LDS_WAIT() asm volatile("s_waitcnt lgkmcnt(0)" ::: "memory")

__device__ __forceinline__ void transpose_block(const float* W, int K, int N, bf16_t* WT, int k0, int n0, int drow, LAS float* scr, int lane) {
#pragma unroll 8
    for (int i = 0; i < 32; ++i) { const int kk = 2 * i + (lane >> 5); scr[kk * 33 + (lane & 31)] = W[(size_t)(k0 + kk) * N + n0 + (lane & 31)]; }
    LDS_WAIT(); asm volatile("" ::: "memory");
    const int c = lane & 7;
#pragma unroll
    for (int j = 0; j < 4; ++j) { const int n = (lane >> 3) + 8 * j; const LAS float* s = scr + (8 * c) * 33 + n;
        u32x4 o; o.x = cvt_pk_bf16(s[0 * 33], s[1 * 33]); o.y = cvt_pk_bf16(s[2 * 33], s[3 * 33]); o.z = cvt_pk_bf16(s[4 * 33], s[5 * 33]); o.w = cvt_pk_bf16(s[6 * 33], s[7 * 33]);
        *(u32x4*)(WT + (size_t)(drow + n) * K + k0 + 8 * c) = o; }
    LDS_WAIT(); asm volatile("" ::: "memory");
}
__device__ __forceinline__ void transpose_item(const float* W, int K, int N, bf16_t* WT, int item, bool qperm, LAS float* scr, int lane) {
    const int nblk = N / 32, kb = item / nblk, nb = item % nblk, n0 = 32 * nb;
    int drow = n0;
    if (qperm) { const int h = n0 / 192, e = n0 % 192; drow = (e < 128) ? h * 128 + e : 1024 + (h >> 2) * 256 + 128 * ((e - 128) >> 5) + 32 * (h & 3); }
    transpose_block(W, K, N, WT, 64 * kb, n0, drow, scr, lane);
}
__device__ __forceinline__ void ada_item(Frame& F, int item) {
    LOCAL_IDS();
    const int layer = item / 96, col0 = (item % 96) * 64, w = wave;
    LAS float* slab = (LAS float*)F.lds + w * 2560;
    const float* W = F.in[6] + (size_t)layer * 1024 * 6144;
    float acc[40];
#pragma unroll
    for (int b = 0; b < 40; ++b) acc[b] = 0.f;
    for (int hh = 0; hh < 2; ++hh) {
        const int kbase = 128 * w + 64 * hh;
#pragma unroll 8
        for (int b = 0; b < 40; ++b) { const float c = (b < NB_P ? F.in[4] + b * DM : F.in[5] + (b - NB_P) * DM)[kbase + lane];
            slab[lane * 40 + b] = c * __builtin_amdgcn_rcpf(1.f + __expf(-c)); }
        LDS_WAIT(); asm volatile("" ::: "memory");
        for (int kk = 0; kk < 64; ++kk) { const float wv = W[(size_t)(kbase + kk) * 6144 + col0 + lane];
#pragma unroll
            for (int b4 = 0; b4 < 10; ++b4) { const f32x4 s = *(const LAS f32x4*)(slab + kk * 40 + 4 * b4);
                acc[4 * b4 + 0] += s[0] * wv; acc[4 * b4 + 1] += s[1] * wv; acc[4 * b4 + 2] += s[2] * wv; acc[4 * b4 + 3] += s[3] * wv; } }
        LDS_WAIT(); asm volatile("" ::: "memory");
    }
    __syncthreads();
    LAS float* red = (LAS float*)F.lds;
#pragma unroll
    for (int b = 0; b < 40; ++b) red[(w * 40 + b) * 64 + lane] = acc[b];
    __syncthreads();
    float* MODF = (float*)(F.ws + WS_MODF) + (size_t)layer * 40 * 6144;
    const float* bias = F.in[7] + (size_t)layer * 6144;
    for (int o = tid; o < 2560; o += 512) { const int b = o >> 6, l = o & 63; float s = bias[col0 + l];
#pragma unroll
        for (int ww = 0; ww < 8; ++ww) s += red[(ww * 40 + b) * 64 + l];
        MODF[(size_t)b * 6144 + col0 + l] = s; }
    __syncthreads();
}
__device__ __forceinline__ void cvt8(const float* src, bf16_t* dst) {
    const f32x4 a = *(const f32x4*)src, b = *(const f32x4*)(src + 4);
    u32x4 w; w.x = cvt_pk_bf16(a[0], a[1]); w.y = cvt_pk_bf16(a[2], a[3]); w.z = cvt_pk_bf16(b[0], b[1]); w.w = cvt_pk_bf16(b[2], b[3]);
    *(u32x4*)dst = w;
}
__device__ __forceinline__ void p0_phase(Frame& F) {
    LOCAL_IDS();
    for (int it = blockIdx.x; it < 192; it += F.G) ada_item(F, it);
    LAS float* scr = (LAS float*)(F.lds + wave * 8704);
    const int gw = blockIdx.x * 8 + wave, NGW = F.G * 8;
    unsigned char* ws = F.ws;
    constexpr int I_WIN = 16 * 22, I_WQ = 6 * 48, I_WUK = 4 * 32, I_WO = 16 * 32, I_W1 = 16 * 128, I_W2 = 64 * 32, I_CWIN = 16 * 64;
    constexpr int NITEMS = I_WIN + I_WQ + 2 * I_WUK + I_WO + 2 * I_W1 + 2 * I_W2 + I_CWIN + I_WO;
    for (int it = gw; it < NITEMS; it += NGW) {
        int r = it;
        if (r < I_WIN) { transpose_item(F.in[12], 1024, 704, (bf16_t*)(ws + WS_WIN), r, false, scr, lane); continue; } r -= I_WIN;
        if (r < I_WQ) { transpose_item(F.in[15], 384, 1536, (bf16_t*)(ws + WS_WQ), r, true, scr, lane); continue; } r -= I_WQ;
        if (r < I_WUK) { transpose_item(F.in[16], 256, 1024, (bf16_t*)(ws + WS_WUK), r, false, scr, lane); continue; } r -= I_WUK;
        if (r < I_WUK) { transpose_item(F.in[17], 256, 1024, (bf16_t*)(ws + WS_WUV), r, false, scr, lane); continue; } r -= I_WUK;
        if (r < I_WO) { transpose_item(F.in[22], 1024, 1024, (bf16_t*)(ws + WS_WO), r, false, scr, lane); continue; } r -= I_WO;
        if (r < 2 * I_W1) { const int l = r / I_W1; transpose_item(F.in[10] + (size_t)l * 1024 * 4096, 1024, 4096, (bf16_t*)(ws + WS_W1) + (size_t)l * 4096 * 1024, r % I_W1, false, scr, lane); continue; } r -= 2 * I_W1;
        if (r < 2 * I_W2) { const int l = r / I_W2; transpose_item(F.in[11] + (size_t)l * 1024 * 4096, 4096, 1024, (bf16_t*)(ws + WS_W2) + (size_t)l * 4096 * 1024, r % I_W2, false, scr, lane); continue; } r -= 2 * I_W2;
        if (r < I_CWIN) { transpose_item(F.in[23], 1024, 2048, (bf16_t*)(ws + WS_CWIN), r, false, scr, lane); continue; } r -= I_CWIN;
        transpose_item(F.in[27], 1024, 1024, (bf16_t*)(ws + WS_CWO), r, false, scr, lane);
    }
    const long gt = (long)blockIdx.x * 512 + tid, NT = (long)F.G * 512;
    { const float* src = F.in[2]; bf16_t* dst = (bf16_t*)(ws + WS_CKV) + (size_t)MT * 256;
      for (long i = gt; i < (long)NCACHE * 256 / 8; i += NT) cvt8(src + i * 8, dst + i * 8); }
    { const float* src = F.in[3]; bf16_t* dst = (bf16_t*)(ws + WS_KPE);
      for (long i = gt; i < (long)NCACHE * 64 / 8; i += NT) cvt8(src + i * 8, dst + i * 8); }
    { const float* src = F.in[16]; const float* gk = F.in[20]; bf16_t* dst = (bf16_t*)(ws + WS_WUKN);
      for (long i = gt; i < 256 * 1024 / 8; i += NT) { const int d = (int)(i * 8) & 127;
          const f32x4 a = *(const f32x4*)(src + i * 8) * *(const f32x4*)(gk + d), b = *(const f32x4*)(src + i * 8 + 4) * *(const f32x4*)(gk + d + 4);
          u32x4 w; w.x = cvt_pk_bf16(a[0], a[1]); w.y = cvt_pk_bf16(a[2], a[3]); w.z = cvt_pk_bf16(b[0], b[1]); w.w = cvt_pk_bf16(b[2], b[3]);
          *(u32x4*)(dst + i * 8) = w; } }
}

__device__ __forceinline__ void xb_load(const bf16_t* p, f32x4& v) { const u32x2 w = *(const u32x2*)p; v = (f32x4){bflo(w.x), bfhi(w.x), bflo(w.y), bfhi(w.y)}; }
__device__ __forceinline__ void tail_row(Frame& F, int row, int lane, const float* tgate, const float* tbase, f32x4 (&v)[4], bool to_out) {
    const float* P = (const float*)(F.ws + WS_PBUF) + (size_t)(row - MP) * DM;
    bf16_t* XB = (bf16_t*)(F.ws + WS_V);
    const float* gp = tgate + (size_t)row_seq(row) * 6144;
#pragma unroll
    for (int j = 0; j < 4; ++j) { const int c = 4 * lane + 256 * j; f32x4 s = *(const f32x4*)(P + c);
#pragma unroll
        for (int k = 1; k < KSPL; ++k) s += *(const f32x4*)(P + (size_t)k * MS * DM + c);
        f32x4 base; if (tbase) base = *(const f32x4*)(tbase + (size_t)(row - MP) * DM + c); else xb_load(XB + (size_t)row * DM + c, base);
        v[j] = base + *(const f32x4*)(gp + c) * s;
        if (to_out) *(f32x4*)(F.out + (size_t)row * DM + c) = v[j];
        else { u32x2 w; w.x = cvt_pk_bf16(v[j][0], v[j][1]); w.y = cvt_pk_bf16(v[j][2], v[j][3]); *(u32x2*)(XB + (size_t)row * DM + c) = w; } }
}
template <int SRC> __device__ __forceinline__ void modnorm_phase(Frame& F, int layer, int which, const float* tgate, const float* tbase) {
    LOCAL_IDS();
    const int gw = blockIdx.x * 8 + wave, NGW = F.G * 8;
    const float* g = (which ? F.in[9] : F.in[8]) + layer * DM;
    const float* MODF = (const float*)(F.ws + WS_MODF) + (size_t)layer * 40 * 6144;
    bf16_t* H = (bf16_t*)(F.ws + WS_H);
    for (int row = gw; row < MT; row += NGW) {
        const float* xr = SRC == 0 ? (row < MP ? F.in[0] + (size_t)row * DM : F.in[1] + (size_t)(row - MP) * DM) : F.out + (size_t)row * DM;
        const float* md = MODF + (size_t)row_seq(row) * 6144 + which * 3072;
        f32x4 v[4]; float ss = 0.f;
        if (tgate != nullptr && row >= MP) tail_row(F, row, lane, tgate, tbase, v, false);
        else {
#pragma unroll
            for (int j = 0; j < 4; ++j) { if (SRC == 0) v[j] = *(const f32x4*)(xr + 4 * lane + 256 * j); else xb_load((const bf16_t*)(F.ws + WS_V) + (size_t)row * DM + 4 * lane + 256 * j, v[j]); } }
#pragma unroll
        for (int j = 0; j < 4; ++j) ss += (v[j][0] * v[j][0] + v[j][1] * v[j][1]) + (v[j][2] * v[j][2] + v[j][3] * v[j][3]);
        const float rs = __builtin_amdgcn_rsqf(wave_sum(ss) * (1.f / DM) + EPS);
#pragma unroll
        for (int j = 0; j < 4; ++j) { const int c = 4 * lane + 256 * j;
            const f32x4 gg = *(const f32x4*)(g + c), sh = *(const f32x4*)(md + c), sc = *(const f32x4*)(md + 1024 + c);
            const f32x4 o = v[j] * rs * gg * (sc + 1.f) + sh;
            u32x2 w; w.x = cvt_pk_bf16(o[0], o[1]); w.y = cvt_pk_bf16(o[2], o[3]);
            *(u32x2*)(H + (size_t)row * DM + c) = w; }
    }
}
__device__ __forceinline__ void final_tail_phase(Frame& F, const float* tgate) {
    LOCAL_IDS();
    const int gw = blockIdx.x * 8 + wave, NGW = F.G * 8;
    for (int row = MP + gw; row < MT; row += NGW) { f32x4 v[4]; tail_row(F, row, lane, tgate, nullptr, v, true); }
}

__device__ __forceinline__ void latent_phase(Frame& F) {
    LOCAL_IDS();
    const int gw = blockIdx.x * 8 + wave, NGW = F.G * 8;
    const float* A0 = (const float*)(F.ws + WS_A0);
    bf16_t* CQ = (bf16_t*)(F.ws + WS_CQ); bf16_t* CKV = (bf16_t*)(F.ws + WS_CKV); bf16_t* KR = (bf16_t*)(F.ws + WS_KR);
    const float* gqa = F.in[13]; const float* gkva = F.in[14]; const float* gkr = F.in[21];
    const float inv = rope_inv(lane & 31);
    for (int row = gw; row < MT; row += NGW) {
        const float* a = A0 + (size_t)row * 768;
        f32x2 q[3]; float s1 = 0.f;
#pragma unroll
        for (int j = 0; j < 3; ++j) { q[j] = *(const f32x2*)(a + 2 * lane + 128 * j); s1 += q[j][0] * q[j][0] + q[j][1] * q[j][1]; }
        const f32x4 kv = *(const f32x4*)(a + 384 + 4 * lane);
        float s2 = (kv[0] * kv[0] + kv[1] * kv[1]) + (kv[2] * kv[2] + kv[3] * kv[3]);
        const float kr = a[640 + lane]; float s3 = kr * kr;
        s1 = wave_sum(s1); s2 = wave_sum(s2); s3 = wave_sum(s3);
        const float r1 = __builtin_amdgcn_rsqf(s1 * (1.f / 384.f) + EPS), r2 = __builtin_amdgcn_rsqf(s2 * (1.f / 256.f) + EPS), r3 = __builtin_amdgcn_rsqf(s3 * (1.f / 64.f) + EPS);
#pragma unroll
        for (int j = 0; j < 3; ++j) { const int c = 2 * lane + 128 * j; const f32x2 gg = *(const f32x2*)(gqa + c);
            *(unsigned*)(CQ + (size_t)row * 384 + c) = cvt_pk_bf16(q[j][0] * r1 * gg[0], q[j][1] * r1 * gg[1]); }
        { const f32x4 gg = *(const f32x4*)(gkva + 4 * lane); const f32x4 o = kv * r2 * gg;
          float* op = row < MP ? F.out + OUT_CKVP + (size_t)row * 256 : F.out + OUT_CKVS + (size_t)(row - MP) * 256;
          *(f32x4*)(op + 4 * lane) = o;
          u32x2 w; w.x = cvt_pk_bf16(o[0], o[1]); w.y = cvt_pk_bf16(o[2], o[3]);
          *(u32x2*)(CKV + (size_t)row * 256 + 4 * lane) = w; }
        { const float y = kr * r3 * gkr[lane]; const auto yy = __builtin_amdgcn_permlane32_swap(__float_as_uint(y), __float_as_uint(y), false, false); const float yo = __uint_as_float(lane < 32 ? yy[1] : yy[0]);
          float sn, cs; sincos_rev((float)row_pos(row) * inv, sn, cs);
          const float o = lane < 32 ? y * cs - yo * sn : y * cs + yo * sn;
          float* op = row < MP ? F.out + OUT_KPEP + (size_t)row * 64 : F.out + OUT_KPES + (size_t)(row - MP) * 64;
          op[lane] = o; KR[(size_t)row * 64 + lane] = f2bf(o); }
    }
}

namespace att {
#define SBAR() __builtin_amdgcn_sched_barrier(0)
constexpr float THR = 8.f;
__device__ __forceinline__ int crow(int r, int hi) { return (r & 3) + 8 * (r >> 2) + 4 * hi; }
__device__ __forceinline__ void partialSM(f32x16& p0, f32x16& p1, float& m_reg, float& mn, float& alpha) {
    constexpr float C = SM_SCALE * 1.4426950408889634f;
    float pmax = p0[0];
#pragma unroll
    for (int r = 1; r < 16; ++r) pmax = fmaxf(pmax, p0[r]);
#pragma unroll
    for (int r = 0; r < 16; ++r) pmax = fmaxf(pmax, p1[r]);
    { auto rr = __builtin_amdgcn_permlane32_swap(__float_as_uint(pmax), __float_as_uint(pmax), false, false);
      pmax = fmaxf(__uint_as_float(rr[0]), __uint_as_float(rr[1])); }
    if (__builtin_expect(__all(pmax - m_reg <= THR / SM_SCALE), 1)) { mn = m_reg; alpha = 1.f; }
    else { mn = fmaxf(m_reg, pmax); alpha = __builtin_amdgcn_exp2f((m_reg - mn) * C); m_reg = mn; }
    const float mnC = -mn * C;
#pragma unroll
    for (int r = 0; r < 16; ++r) p0[r] = fmaf(p0[r], C, mnC);
#pragma unroll
    for (int r = 0; r < 16; ++r) p1[r] = fmaf(p1[r], C, mnC);
#pragma unroll
    for (int r = 0; r < 16; ++r) p0[r] = __builtin_amdgcn_exp2f(p0[r]);
}
__device__ __forceinline__ void finishSM(f32x16& p0, f32x16& p1, float alpha, float& l_reg, bf16x8& pa0, bf16x8& pa1, bf16x8& pa2, bf16x8& pa3) {
#pragma unroll
    for (int r = 0; r < 16; ++r) p1[r] = __builtin_amdgcn_exp2f(p1[r]);
    float ps = 0;
#pragma unroll
    for (int r = 0; r < 16; ++r) ps += p0[r];
#pragma unroll
    for (int r = 0; r < 16; ++r) ps += p1[r];
    { auto rr = __builtin_amdgcn_permlane32_swap(__float_as_uint(ps), __float_as_uint(ps), false, false);
      ps = __uint_as_float(rr[0]) + __uint_as_float(rr[1]); }
    l_reg = l_reg * alpha + ps;
#define PK4(P, BASE, OUT) do { unsigned a0 = cvt_pk_bf16(P[BASE + 0], P[BASE + 1]), a1 = cvt_pk_bf16(P[BASE + 2], P[BASE + 3]);   \
    unsigned b0 = cvt_pk_bf16(P[BASE + 4], P[BASE + 5]), b1 = cvt_pk_bf16(P[BASE + 6], P[BASE + 7]);                              \
    auto r0 = __builtin_amdgcn_permlane32_swap(a0, b0, false, false); auto r1 = __builtin_amdgcn_permlane32_swap(a1, b1, false, false); \
    u32x4 w = {r0[0], r1[0], r0[1], r1[1]}; OUT = *reinterpret_cast<bf16x8*>(&w); } while (0)
    PK4(p0, 0, pa0); PK4(p0, 8, pa1); PK4(p1, 0, pa2); PK4(p1, 8, pa3);
#undef PK4
}
__device__ __forceinline__ int v_st(int k, int c) { const int kk = (k & ~0xC) | ((k & 4) << 1) | ((k & 8) >> 1); return ((kk >> 3) * 4 + (c >> 5)) * 512 + ((kk & 7) * 32 + (c & 31)) * 2; }
__device__ __forceinline__ int v_rd_base(int lane) { return ((lane & 3) << 3) | (((lane >> 2) & 3) << 6) | (((lane >> 4) & 1) << 5) | (((lane >> 5) & 1) << 8); }
constexpr int v_rd_off(int d0, int ks, int half) { return d0 * 512 + ks * 4096 + half * 2048; }
template <int OFF> __device__ __forceinline__ s16x4 tr_read(int vb) {
    s16x4 r; asm volatile("ds_read_b64_tr_b16 %0, %1 offset:%2" : "=&v"(r) : "v"(vb), "i"(OFF) : "memory"); return r;
}
template <int D0> __device__ __forceinline__ void pv_one(f32x16& od, int vb, bf16x8 pa0, bf16x8 pa1, bf16x8 pa2, bf16x8 pa3) {
    const s16x4 l0 = tr_read<v_rd_off(D0, 0, 0)>(vb), h0 = tr_read<v_rd_off(D0, 0, 1)>(vb), l1 = tr_read<v_rd_off(D0, 1, 0)>(vb), h1 = tr_read<v_rd_off(D0, 1, 1)>(vb);
    const s16x4 l2 = tr_read<v_rd_off(D0, 2, 0)>(vb), h2 = tr_read<v_rd_off(D0, 2, 1)>(vb), l3 = tr_read<v_rd_off(D0, 3, 0)>(vb), h3 = tr_read<v_rd_off(D0, 3, 1)>(vb);
    asm volatile("s_waitcnt lgkmcnt(0)" ::: "memory"); SBAR();
#define PK(L, H) (bf16x8){L[0], L[1], L[2], L[3], H[0], H[1], H[2], H[3]}
    od = __builtin_amdgcn_mfma_f32_32x32x16_bf16(pa0, PK(l0, h0), od, 0, 0, 0);
    od = __builtin_amdgcn_mfma_f32_32x32x16_bf16(pa1, PK(l1, h1), od, 0, 0, 0);
    od = __builtin_amdgcn_mfma_f32_32x32x16_bf16(pa2, PK(l2, h2), od, 0, 0, 0);
    od = __builtin_amdgcn_mfma_f32_32x32x16_bf16(pa3, PK(l3, h3), od, 0, 0, 0);
#undef PK
}
__device__ __forceinline__ void pv_d0(f32x16* o, int vb, bf16x8 pa0, bf16x8 pa1, bf16x8 pa2, bf16x8 pa3) {
    pv_one<0>(o[0], vb, pa0, pa1, pa2, pa3); pv_one<1>(o[1], vb, pa0, pa1, pa2, pa3); pv_one<2>(o[2], vb, pa0, pa1, pa2, pa3); pv_one<3>(o[3], vb, pa0, pa1, pa2, pa3);
}

constexpr int P_SHM_V = 64 * 128 * 2, P_SHM_K = 64 * 192 * 2;
#define KSWZ192(row, colB) ((row) * 384 + ((colB) ^ (((row) & 7) << 4)))
__device__ __forceinline__ void qkt192(f32x16& p0, f32x16& p1, const LAS char* Ks, const int (&ka)[4], const bf16x8* qr, const LAS char* QRl, int hi, bool vis) {
    if (vis) {
        p0 = f32x16{}; p1 = f32x16{};
#pragma unroll
        for (int d0 = 0; d0 < 12; ++d0) {
            const bf16x8 b0 = *reinterpret_cast<const LAS bf16x8*>(Ks + ka[d0 & 3] + (d0 >> 2) * 128);
            const bf16x8 b1 = *reinterpret_cast<const LAS bf16x8*>(Ks + ka[d0 & 3] + (d0 >> 2) * 128 + 32 * 384);
            const bf16x8 qf = d0 < 8 ? qr[d0 < 8 ? d0 : 0] : *reinterpret_cast<const LAS bf16x8*>(QRl + ((d0 - 8) * 16 + hi * 8) * 2);
            p0 = __builtin_amdgcn_mfma_f32_32x32x16_bf16(b0, qf, p0, 0, 0, 0);
            p1 = __builtin_amdgcn_mfma_f32_32x32x16_bf16(b1, qf, p1, 0, 0, 0); }
    } else {
#pragma unroll
        for (int r = 0; r < 16; ++r) { p0[r] = -1e30f; p1[r] = -1e30f; }
    }
}
__device__ __forceinline__ void prompt_unit(int b, int h, int qb, const bf16_t* __restrict__ Q, const bf16_t* __restrict__ KN, const bf16_t* __restrict__ KR,
                                            const bf16_t* __restrict__ V, bf16_t* __restrict__ O, LAS char* lds) {
    int tid_l_ = threadIdx.x; asm volatile("" : "+v"(tid_l_));
    const int tid = tid_l_, wid = tid >> 6, lane = tid & 63, r32 = lane & 31, hi = lane >> 5;
    LAS char* V_lds = lds; LAS char* K_lds = lds + 2 * P_SHM_V;
    LAS float* wsc = (LAS float*)(lds + 2 * P_SHM_V + 2 * P_SHM_K) + wid * 64; LAS float* li_l = wsc; LAS float* al_l = wsc + 32;
    float m_reg = -1e30f, l_reg = 0; f32x16 o[4] = {}; bf16x8 qr[8];
    LAS char* QRl = lds + 2 * P_SHM_V + 2 * P_SHM_K + 2048 + wid * 4608 + r32 * 144;
    const size_t rowbase = (size_t)b * SEQ;
    const bf16_t* Qw = Q + (rowbase + qb * 256 + wid * 32 + r32) * 1536 + h * 192 + hi * 8;
#pragma unroll
    for (int d0 = 0; d0 < 8; ++d0) qr[d0] = *reinterpret_cast<const bf16x8*>(Qw + d0 * 16);
#pragma unroll
    for (int d0 = 8; d0 < 12; ++d0) *reinterpret_cast<LAS bf16x8*>(QRl + ((d0 - 8) * 16 + hi * 8) * 2) = *reinterpret_cast<const bf16x8*>(Qw + d0 * 16);
    int ka[4];
#pragma unroll
    for (int k = 0; k < 4; ++k) ka[k] = r32 * 384 + ((k * 32 + hi * 16) ^ ((r32 & 7) << 4));
    const int cw = 4 * qb + (wid >> 1);
    const int sr = tid >> 4, sc = (tid & 15) * 8, vst0 = v_st(sr, sc), vst1 = v_st(32 + sr, sc), krr = tid >> 3, krc = (tid & 7) * 8;
    const int vb0 = (int)(uintptr_t)V_lds + v_rd_base(lane);
    const bf16_t* Vh = V + rowbase * 1024 + h * 128; const bf16_t* Kh = KN + rowbase * 1024 + h * 128; const bf16_t* Rh = KR + rowbase * 64;
    struct { bf16x8 vs0, vs1, ks0, ks1, kr; } sr_[1];
#define SLOAD(i, k0) do { sr_[i].vs0 = *reinterpret_cast<const bf16x8*>(&Vh[(size_t)((k0) + sr) * 1024 + sc]); sr_[i].vs1 = *reinterpret_cast<const bf16x8*>(&Vh[(size_t)((k0) + 32 + sr) * 1024 + sc]); \
    sr_[i].ks0 = *reinterpret_cast<const bf16x8*>(&Kh[(size_t)((k0) + sr) * 1024 + sc]); sr_[i].ks1 = *reinterpret_cast<const bf16x8*>(&Kh[(size_t)((k0) + 32 + sr) * 1024 + sc]); \
    sr_[i].kr = *reinterpret_cast<const bf16x8*>(&Rh[(size_t)((k0) + krr) * 64 + krc]); } while (0)
#define SWRITE(bb, i) do { *(LAS bf16x8*)(V_lds + (bb) * P_SHM_V + vst0) = sr_[i].vs0; *(LAS bf16x8*)(V_lds + (bb) * P_SHM_V + vst1) = sr_[i].vs1; const int kc = sc * 2; \
    *(LAS bf16x8*)(K_lds + (bb) * P_SHM_K + KSWZ192(sr, kc)) = sr_[i].ks0; *(LAS bf16x8*)(K_lds + (bb) * P_SHM_K + KSWZ192(32 + sr, kc)) = sr_[i].ks1; \
    *(LAS bf16x8*)(K_lds + (bb) * P_SHM_K + KSWZ192(krr, 256 + krc * 2)) = sr_[i].kr; } while (0)
#define SWAIT() asm volatile("s_waitcnt vmcnt(0)" ::: "memory")
#define RESC(a) do { if (__any((a) < 1.f)) { if (hi == 0) al_l[r32] = (a); asm volatile("s_waitcnt lgkmcnt(0)" ::: "memory"); \
    _Pragma("unroll") for (int d = 0; d < 4; ++d) _Pragma("unroll") for (int r = 0; r < 16; ++r) o[d][r] *= al_l[crow(r, hi)]; } } while (0)
    f32x16 pA0, pA1, pB0, pB1; float mnA, mnB, alA, alB; bf16x8 pa0, pa1, pa2, pa3; const int NT = 4 * qb + 4;
    constexpr int SE = 0, SO = 0;
    SLOAD(SE, 0); asm volatile("s_waitcnt vmcnt(0)" ::: "memory"); SWRITE(0, SE); __syncthreads();
    qkt192(pA0, pA1, K_lds, ka, qr, QRl, hi, true); partialSM(pA0, pA1, m_reg, mnA, alA);
    SLOAD(SO, 64);
    SWAIT(); SWRITE(1, SO); __syncthreads();
    for (int j = 1; j + 1 < NT; j += 2) {
        SBAR(); qkt192(pB0, pB1, K_lds + P_SHM_K, ka, qr, QRl, hi, j <= cw);
        finishSM(pA0, pA1, alA, l_reg, pa0, pa1, pa2, pa3); SBAR();
        SLOAD(SO, (j + 1) * 64); SBAR();
        if (j - 1 <= cw) pv_d0(o, vb0, pa0, pa1, pa2, pa3);
        partialSM(pB0, pB1, m_reg, mnB, alB);
        __syncthreads(); SWAIT(); SWRITE(0, SE);
        RESC(alB); __syncthreads();
        SBAR(); qkt192(pA0, pA1, K_lds, ka, qr, QRl, hi, j + 1 <= cw);
        finishSM(pB0, pB1, alB, l_reg, pa0, pa1, pa2, pa3); SBAR();
        SLOAD(SE, (j + 2) * 64); SBAR();
        if (j <= cw) pv_d0(o, vb0 + P_SHM_V, pa0, pa1, pa2, pa3);
        partialSM(pA0, pA1, m_reg, mnA, alA);
        __syncthreads(); SWAIT(); SWRITE(1, SO);
        RESC(alA); __syncthreads();
    }
    SBAR(); qkt192(pB0, pB1, K_lds + P_SHM_K, ka, qr, QRl, hi, NT - 1 <= cw);
    finishSM(pA0, pA1, alA, l_reg, pa0, pa1, pa2, pa3); SBAR();
    if (NT - 2 <= cw) pv_d0(o, vb0, pa0, pa1, pa2, pa3);
    partialSM(pB0, pB1, m_reg, mnB, alB);
    __syncthreads(); RESC(alB);
    finishSM(pB0, pB1, alB, l_reg, pa0, pa1, pa2, pa3); SBAR();
    if (NT - 1 <= cw) pv_d0(o, vb0 + P_SHM_V, pa0, pa1, pa2, pa3);
    if (hi == 0) li_l[r32] = l_reg; asm volatile("s_waitcnt lgkmcnt(0)" ::: "memory");
    float rli[16];
#pragma unroll
    for (int r = 0; r < 16; ++r) rli[r] = __builtin_amdgcn_rcpf(li_l[crow(r, hi)]);
    bf16_t* Ow = O + (rowbase + qb * 256 + wid * 32) * 1024 + h * 128;
#pragma unroll
    for (int r = 0; r < 16; ++r) { const int orow = crow(r, hi);
#pragma unroll
        for (int d0 = 0; d0 < 4; ++d0) Ow[(size_t)orow * 1024 + d0 * 32 + r32] = f2bf(o[d0][r] * rli[r]); }
    __syncthreads();
#undef SLOAD
#undef SWRITE
#undef SWAIT
#undef RESC
}

constexpr int S_QP = 264;
constexpr int S_OFF_Q = 0, S_OFF_K = 8 * 16 * S_QP * 2  , S_OFF_V = S_OFF_K + 64 * 640  , S_OFF_RS = S_OFF_V + 32768, S_OFF_SC = S_OFF_RS + 2048  , S_END = S_OFF_SC + 2048;
static_assert(S_END <= LDS_MISC, "sample LDS map");
#define KSWZ320(row, colB) ((row) * 640 + ((colB) ^ (((row) & 7) << 4)))
__device__ __forceinline__ void sample_unit(int sb, int sp, const bf16_t* __restrict__ Q, const bf16_t* __restrict__ WUKN, const bf16_t* __restrict__ CKV, const bf16_t* __restrict__ KPE,
                                            const bf16_t* __restrict__ KR, const float* __restrict__ RS, float* __restrict__ PART, float* __restrict__ ML, LAS char* lds) {
    int tid_l_ = threadIdx.x; asm volatile("" : "+v"(tid_l_));
    const int tid = tid_l_, h = tid >> 6, lane = tid & 63, r32 = lane & 31, hi = lane >> 5, q16 = r32 & 15;
    LAS char* Q_lds = lds + S_OFF_Q + h * (16 * S_QP * 2); LAS char* K_lds = lds + S_OFF_K; LAS char* V_lds = lds + S_OFF_V;
    LAS float* rs_lds = (LAS float*)(lds + S_OFF_RS); LAS float* al_l = (LAS float*)(lds + S_OFF_SC) + h * 64;
    const size_t qrow = (size_t)MP + sb * 16 + q16;
    {
        bf16x8 qa[8];
#pragma unroll
        for (int ks = 0; ks < 8; ++ks) qa[ks] = *reinterpret_cast<const bf16x8*>(Q + qrow * 1536 + h * 192 + ks * 16 + hi * 8);
        LAS char* qw = Q_lds + ((4 * hi) * S_QP + r32) * 2;
        const bf16_t* wp = WUKN + (size_t)r32 * 1024 + h * 128 + hi * 8;
#pragma unroll 1
        for (int nb = 0; nb < 8; ++nb) {
            f32x16 acc = {};
#pragma unroll
            for (int ks = 0; ks < 8; ++ks) { const bf16x8 wb = *reinterpret_cast<const bf16x8*>(wp + ks * 16);
                acc = __builtin_amdgcn_mfma_f32_32x32x16_bf16(qa[ks], wb, acc, 0, 0, 0); }
#pragma unroll
            for (int r = 0; r < 8; ++r) *(LAS bf16_t*)(qw + (((r & 3) + 8 * (r >> 2)) * S_QP) * 2) = f2bf(acc[r]);
            qw += 64; wp += 32 * 1024;
        }
    }
    __syncthreads();
    const int hp = h & 3, vh = h >> 2, hl = 2 * hp + (r32 >> 4);
    bf16x8 qrp[4];
#pragma unroll
    for (int d0 = 0; d0 < 4; ++d0) qrp[d0] = *reinterpret_cast<const bf16x8*>(Q + qrow * 1536 + hl * 192 + 128 + d0 * 16 + hi * 8);
    float m_reg = -1e30f, l_reg = 0; f32x16 o[4] = {};
    const int vb0 = (int)(uintptr_t)V_lds + vh * 16384 + v_rd_base(lane);
    const int ntile = (sp == NSPLIT - 1) ? 17 : 16;
    const int krr = tid >> 3, krc = (tid & 7) * 8;
    const int skey = tid >> 5, cc = (tid & 31) * 8;
    LAS char* kst = K_lds + skey * 640 + ((cc * 2) ^ ((skey & 7) << 4));
    LAS char* vst = V_lds + (cc >> 7) * 16384 + v_st(skey, cc & 127);
    LAS char* krst = K_lds + krr * 640 + ((512 + krc * 2) ^ ((krr & 7) << 4));
    int ka[4];
#pragma unroll
    for (int k = 0; k < 4; ++k) ka[k] = r32 * 640 + ((k * 32 + hi * 16) ^ ((r32 & 7) << 4));
    const LAS char* qfp = lds + S_OFF_Q + hl * (16 * S_QP * 2) + (q16 * S_QP + hi * 8) * 2;
    const LAS float* rsp = rs_lds + (4 * hi) * 8 + hl;
    bf16x8 c[4], kr; float rsv;
#define S_LOAD(T) do { const bool nw_ = ((T) == 16); \
        const size_t crow0 = nw_ ? (size_t)MP + sb * 16 : (size_t)MT + (size_t)sb * PAST + sp * 1024 + (T) * 64; \
        const bf16_t* rsrc = nw_ ? KR + ((size_t)MP + sb * 16) * 64 : KPE + ((size_t)sb * PAST + sp * 1024 + (T) * 64) * 64; \
        _Pragma("unroll") for (int i = 0; i < 4; ++i) { const int key = skey + 16 * i; \
            c[i] = (!nw_ || key < 16) ? *reinterpret_cast<const bf16x8*>(CKV + (crow0 + key) * 256 + cc) : bf16x8{}; } \
        kr = (!nw_ || krr < 16) ? *reinterpret_cast<const bf16x8*>(rsrc + (size_t)krr * 64 + krc) : bf16x8{}; \
        rsv = (!nw_ || krr < 16) ? RS[(crow0 + krr) * 8 + (tid & 7)] : 0.f; } while (0)
    S_LOAD(0);
#pragma unroll 1
    for (int t = 0; t < ntile; ++t) {
        const bool isnew = (t == 16);
        __syncthreads();
#pragma unroll
        for (int i = 0; i < 4; ++i) { *(LAS bf16x8*)(kst + i * 16 * 640) = c[i];
            *(LAS bf16x8*)(vst + i * 4096) = c[i]; }
        *(LAS bf16x8*)krst = kr;
        rs_lds[krr * 8 + (tid & 7)] = rsv;
        __syncthreads();
        if (t + 1 < ntile) S_LOAD(t + 1);
        SBAR();
        f32x16 p0 = {}, p1 = {};
#pragma unroll
        for (int d0 = 0; d0 < 16; ++d0) { if ((d0 & 3) == 0) SBAR();
            const bf16x8 b0 = *reinterpret_cast<const LAS bf16x8*>(K_lds + ka[d0 & 3] + (d0 >> 2) * 128);
            const bf16x8 b1 = *reinterpret_cast<const LAS bf16x8*>(K_lds + ka[d0 & 3] + (d0 >> 2) * 128 + 32 * 640);
            const bf16x8 qf = *reinterpret_cast<const LAS bf16x8*>(qfp + d0 * 32);
            p0 = __builtin_amdgcn_mfma_f32_32x32x16_bf16(b0, qf, p0, 0, 0, 0);
            p1 = __builtin_amdgcn_mfma_f32_32x32x16_bf16(b1, qf, p1, 0, 0, 0); }
        SBAR();
#pragma unroll
        for (int r = 0; r < 16; ++r) { p0[r] *= rsp[((r & 3) + 8 * (r >> 2)) * 8]; p1[r] *= rsp[(32 + (r & 3) + 8 * (r >> 2)) * 8]; }
#pragma unroll
        for (int d0 = 0; d0 < 4; ++d0) {
            const bf16x8 b0 = *reinterpret_cast<const LAS bf16x8*>(K_lds + ka[d0] + 512);
            const bf16x8 b1 = *reinterpret_cast<const LAS bf16x8*>(K_lds + ka[d0] + 512 + 32 * 640);
            p0 = __builtin_amdgcn_mfma_f32_32x32x16_bf16(b0, qrp[d0], p0, 0, 0, 0);
            p1 = __builtin_amdgcn_mfma_f32_32x32x16_bf16(b1, qrp[d0], p1, 0, 0, 0); }
        if (isnew) {
#pragma unroll
            for (int r = 0; r < 16; ++r) { if (r >= 8) p0[r] = -1e30f; p1[r] = -1e30f; }
        }
        float mn, al; bf16x8 pa0, pa1, pa2, pa3;
        partialSM(p0, p1, m_reg, mn, al);
        finishSM(p0, p1, al, l_reg, pa0, pa1, pa2, pa3);
        if (__any(al < 1.f)) { if (hi == 0) al_l[r32] = al; asm volatile("s_waitcnt lgkmcnt(0)" ::: "memory");
#pragma unroll
            for (int d = 0; d < 4; ++d)
#pragma unroll
                for (int r = 0; r < 16; ++r) o[d][r] *= al_l[crow(r, hi)]; }
        pv_d0(o, vb0, pa0, pa1, pa2, pa3);
    }
    const size_t ubase = ((size_t)sb * NSPLIT + sp) * 8;
    if (vh == 0 && lane < 32) { const size_t pb = (ubase + hl) * 16 + q16; ML[pb * 2] = m_reg; ML[pb * 2 + 1] = l_reg; }
#pragma unroll
    for (int r = 0; r < 16; ++r) { const int row = crow(r, hi); const size_t pb = (ubase + 2 * hp + (row >> 4)) * 16 + (row & 15);
#pragma unroll
        for (int d = 0; d < 4; ++d) PART[pb * 256 + vh * 128 + d * 32 + r32] = o[d][r]; }
    __syncthreads();
#undef S_LOAD
}
}

__device__ __forceinline__ void attention_phase(Frame& F, unsigned* ctr, bool ctr_is_second = false) {
    LOCAL_IDS();
    volatile LAS unsigned* misc = (volatile LAS unsigned*)(F.lds + LDS_MISC);
    const bf16_t* Q = (const bf16_t*)(F.ws + WS_A0); const bf16_t* KN = (const bf16_t*)(F.ws + WS_KN); const bf16_t* KR = (const bf16_t*)(F.ws + WS_KR);
    const bf16_t* V = (const bf16_t*)(F.ws + WS_V); bf16_t* O = (bf16_t*)(F.ws + WS_H);
    constexpr int NSU = NB_S * NSPLIT, NPU = NB_P * NH * 16;
    for (;;) {
        __syncthreads();
        if (tid == 0) misc[0] = atomicAdd(ctr, 1u);
        __syncthreads();
        const int unit = (int)misc[0];
#ifdef REP_SAMPLE_ONLY
        if (unit >= (ctr_is_second ? NSU : NSU + NPU)) break;
#else
        if (unit >= NSU + NPU) break;
#endif
        if (unit < NSU) {
#ifndef NO_SAMPLE
            att::sample_unit(unit >> 2, unit & 3, Q, (const bf16_t*)(F.ws + WS_WUKN), (const bf16_t*)(F.ws + WS_CKV), (const bf16_t*)(F.ws + WS_KPE), KR,
                             (const float*)(F.ws + WS_RS), (float*)(F.ws + WS_PART), (float*)(F.ws + WS_ML), (LAS char*)F.lds);
#endif
        } else {
#ifndef NO_PROMPT
#ifdef ORDER_BH
            const int pu = unit - NSU, qb = 15 - (pu & 15), bh = pu >> 4;
#else
            const int pu = unit - NSU, qb = 15 - pu / 64, bh = pu % 64;
#endif
            att::prompt_unit(bh >> 3, bh & 7, qb, Q, KN, KR, V, O, (LAS char*)F.lds);
#endif
        }
    }
}

__device__ __forceinline__ void combine_phase(Frame& F) {
    LOCAL_IDS();
    const int gw = blockIdx.x * 8 + wave, NGW = F.G * 8;
    LAS float* ol = (LAS float*)(F.lds + wave * 16384);
    const float* PART = (const float*)(F.ws + WS_PART); const float* ML = (const float*)(F.ws + WS_ML); const float* wuv = F.in[17];
    bf16_t* O = (bf16_t*)(F.ws + WS_H);
    constexpr float C = SM_SCALE * 1.4426950408889634f;
    for (int item = gw; item < NB_S * NH; item += NGW) {
        const int sb = item >> 3, h = item & 7;
        for (int q = 0; q < 16; ++q) {
            float m[NSPLIT], l[NSPLIT], mx = -1e30f;
#pragma unroll
            for (int s = 0; s < NSPLIT; ++s) { const size_t pb = ((((size_t)sb * NSPLIT + s) * 8 + h) * 16 + q); m[s] = ML[pb * 2]; l[s] = ML[pb * 2 + 1]; mx = fmaxf(mx, m[s]); }
            float L = 0.f; f32x4 acc = {0.f, 0.f, 0.f, 0.f};
#pragma unroll
            for (int s = 0; s < NSPLIT; ++s) { const size_t pb = ((((size_t)sb * NSPLIT + s) * 8 + h) * 16 + q); const float f = __builtin_amdgcn_exp2f((m[s] - mx) * C);
                L += f * l[s]; acc += *(const f32x4*)(PART + pb * 256 + 4 * lane) * f; }
#ifdef E1_TEST
            *(LAS f32x4*)(ol + q * 256 + 4 * lane) = (f32x4){0.001f * (q + lane), 0.002f, 0.003f * sb, 0.004f * h};
#else
            *(LAS f32x4*)(ol + q * 256 + 4 * lane) = acc * (1.f / L);
#endif
        }
        LDS_WAIT(); asm volatile("" ::: "memory");
        float a0[16], a1[16];
#pragma unroll
        for (int q = 0; q < 16; ++q) { a0[q] = 0.f; a1[q] = 0.f; }
        for (int l4 = 0; l4 < 64; ++l4) {
            float w0[4], w1[4];
#pragma unroll
            for (int t = 0; t < 4; ++t) { w0[t] = wuv[(size_t)(4 * l4 + t) * 1024 + h * 128 + lane]; w1[t] = wuv[(size_t)(4 * l4 + t) * 1024 + h * 128 + 64 + lane]; }
#pragma unroll
            for (int q = 0; q < 16; ++q) { const f32x4 x = *(const LAS f32x4*)(ol + q * 256 + 4 * l4);
                a0[q] += x[0] * w0[0] + x[1] * w0[1] + x[2] * w0[2] + x[3] * w0[3]; a1[q] += x[0] * w1[0] + x[1] * w1[1] + x[2] * w1[2] + x[3] * w1[3]; }
        }
#pragma unroll
        for (int q = 0; q < 16; ++q) { bf16_t* op = O + ((size_t)MP + sb * 16 + q) * 1024 + h * 128; op[lane] = f2bf(a0[q]); op[64 + lane] = f2bf(a1[q]); }
        LDS_WAIT(); asm volatile("" ::: "memory");
    }
}

__device__ __forceinline__ void sgu_phase(Frame& F) {
    LOCAL_IDS();
    const int wid = wave, r32 = lane & 31, hi = lane >> 5;
    LAS float* rsv_l = (LAS float*)F.lds;
    const bf16_t* VT = (const bf16_t*)(F.ws + WS_VT); const bf16_t* U = (const bf16_t*)(F.ws + WS_U); bf16_t* Gt = (bf16_t*)(F.ws + WS_G);
    const float* SSV = (const float*)(F.ws + WS_SSV); const float* ws_ = F.in[25]; const float* bs = F.in[26]; const float* gv = F.in[24];
    const int mb = wid & 3, nb0 = (wid >> 2) * 2;
    for (int unit = blockIdx.x; unit < 288 * 8; unit += F.G) {
        const int ch = unit >> 3, g = unit & 7; const bool smp = ch >= 256;
        const int tok0 = smp ? MP + (ch - 256) * 16 : ch * 128, ntok = smp ? 16 : 128;
        const bool active = !smp || mb == 0;
        const int ksteps = smp ? 1 : (mb < 2 ? 4 : 8);
        float ssp[8];
        if (tid < 128) {
#pragma unroll
            for (int p = 0; p < 8; ++p) ssp[p] = (tid < ntok) ? SSV[(size_t)p * VTP + tok0 + tid] : 0.f; }
        bf16x8 b0[8], b1[8]; bf16_t uv0[16], uv1[16];
        const int c0 = g * 128 + nb0 * 32 + r32;
        const float* wrow = ws_ + (size_t)g * 16384 + (size_t)(32 * mb + r32) * 128 + hi * 8;
        if (active) {
            const bf16_t* v0p = VT + (size_t)c0 * VTP + tok0 + hi * 8; const bf16_t* v1p = v0p + (size_t)32 * VTP;
#pragma unroll
            for (int ks = 0; ks < 8; ++ks) if (ks < ksteps) {
                b0[ks] = *reinterpret_cast<const bf16x8*>(v0p + ks * 16); b1[ks] = *reinterpret_cast<const bf16x8*>(v1p + ks * 16); }
        }
        if (tid < 128) { float s = ((ssp[0] + ssp[1]) + (ssp[2] + ssp[3])) + ((ssp[4] + ssp[5]) + (ssp[6] + ssp[7]));
            rsv_l[tid] = (tid < ntok) ? __builtin_amdgcn_rsqf(s * (1.f / 1024.f) + EPS) : 0.f; }
        __syncthreads();
        if (active) {
#pragma unroll
            for (int r = 0; r < 16; ++r) { const int i = 32 * mb + att::crow(r, hi);
                if (i < ntok) { const size_t tok = (size_t)tok0 + i; uv0[r] = U[tok * 1024 + c0]; uv1[r] = U[tok * 1024 + c0 + 32]; } }
            f32x16 acc0 = {}, acc1 = {};
#pragma unroll
            for (int ks = 0; ks < 8; ++ks) if (ks < ksteps) { const int j0 = ks * 16 + hi * 8;
                const f32x4 ra = *(const LAS f32x4*)(rsv_l + j0), rb = *(const LAS f32x4*)(rsv_l + j0 + 4);
                const f32x4 xa = *(const f32x4*)(wrow + ks * 16) * ra, xb = *(const f32x4*)(wrow + ks * 16 + 4) * rb;
                u32x4 aw; aw.x = cvt_pk_bf16(xa[0], xa[1]); aw.y = cvt_pk_bf16(xa[2], xa[3]); aw.z = cvt_pk_bf16(xb[0], xb[1]); aw.w = cvt_pk_bf16(xb[2], xb[3]);
                const bf16x8 af = *reinterpret_cast<bf16x8*>(&aw);
                acc0 = __builtin_amdgcn_mfma_f32_32x32x16_bf16(af, b0[ks], acc0, 0, 0, 0);
                acc1 = __builtin_amdgcn_mfma_f32_32x32x16_bf16(af, b1[ks], acc1, 0, 0, 0); }
            const float g0 = gv[c0], g1 = gv[c0 + 32];
#pragma unroll
            for (int r = 0; r < 16; ++r) { const int i = 32 * mb + att::crow(r, hi);
                if (i < ntok) { const size_t tok = (size_t)tok0 + i; const float bias = bs[g * 128 + i];
                    Gt[tok * 1024 + c0] = f2bf(bf2f(uv0[r]) * (acc0[r] * g0 + bias));
                    Gt[tok * 1024 + c0 + 32] = f2bf(bf2f(uv1[r]) * (acc1[r] * g1 + bias)); } }
        }
        if (smp) {
            for (int idx = tid; idx < 2048; idx += 512) { const int t = idx >> 7, c = g * 128 + (idx & 127);
                F.out[OUT_VS + (size_t)((ch - 256) * 16 + t) * 1024 + c] = bf2f(VT[(size_t)c * VTP + tok0 + t]) * rsv_l[t] * gv[c]; }
        }
        __syncthreads();
    }
}

#define XB_TMO      128
#define XB_XCNT(j)  (256  + 64 * (j))
#define XB_XSUB(j)  (1280 + 64 * (j))
#define XB_XGEN(j)  (2304 + 64 * (j))
#define XB_TOP      3328
#define XB_TOPGEN   3392
#define XCD_BAR_WORDS 3456
#define XB_SPIN_CAP (1u << 18)

__device__ __forceinline__ unsigned xb_ld(unsigned* p)              { return __hip_atomic_load(p, __ATOMIC_RELAXED, __HIP_MEMORY_SCOPE_AGENT); }
__device__ __forceinline__ unsigned xb_add(unsigned* p, unsigned v) { return __hip_atomic_fetch_add(p, v, __ATOMIC_RELAXED, __HIP_MEMORY_SCOPE_AGENT); }
__device__ __forceinline__ unsigned xb_xcc_id() { return (unsigned)__builtin_amdgcn_s_getreg((3 << 11) | 20) & 0xFu; }
#define XB_SPIN(cond, bar) do { unsigned _sp = 0; while (cond) { __builtin_amdgcn_s_sleep(1); \
    if ((++_sp & 255u) == 0u) { if (xb_ld(&(bar)[XB_TMO])) break; if (_sp > XB_SPIN_CAP) { atomicAdd(&(bar)[XB_TMO], 1u); break; } } } } while (0)

struct XcdBarrier {
    unsigned* bar; unsigned x;
    volatile LAS unsigned* st;
};

__device__ __forceinline__ XcdBarrier xcd_barrier_post(unsigned* bar, volatile LAS unsigned* st) {
    XcdBarrier b; b.bar = bar; b.x = xb_xcc_id(); b.st = st;
    if (threadIdx.x == 0) (void)xb_add(&bar[XB_XCNT(b.x)], 1u);
    return b;
}
__device__ __forceinline__ void xcd_barrier_complete(unsigned* bar, unsigned x, unsigned& nloc, unsigned& nx) {
    const unsigned G = gridDim.x * gridDim.y * gridDim.z;
    unsigned sum, cnt, mine, sp = 0u;
    for (;;) {
        sum = 0u; cnt = 0u; mine = 0u;
#pragma unroll
        for (unsigned j = 0; j < 16; ++j) { const unsigned c = xb_ld(&bar[XB_XCNT(j)]); sum += c; cnt += (c > 0u) ? 1u : 0u; mine = (j == x) ? c : mine; }
        if (sum == G) break;
        __builtin_amdgcn_s_sleep(1);
        if ((++sp & 255u) == 0u) { if (xb_ld(&bar[XB_TMO])) break; if (sp > XB_SPIN_CAP) { atomicAdd(&bar[XB_TMO], 1u); break; } }
    }
    nloc = mine > 0u ? mine : 1u; nx = cnt > 0u ? cnt : 1u;
}

__device__ __forceinline__ void xcd_barrier(const XcdBarrier& b) {
    asm volatile("s_waitcnt vmcnt(0)" ::: "memory");
    __syncthreads();
    if (threadIdx.x == 0) {
        unsigned* bar = b.bar;
        __builtin_amdgcn_s_waitcnt(0);
        unsigned nloc = b.st[0], nx = b.st[1];
        if (nloc == 0u) { xcd_barrier_complete(bar, b.x, nloc, nx); b.st[0] = nloc; b.st[1] = nx; }
        const unsigned old = xb_add(&bar[XB_XSUB(b.x)], 1u);
        const unsigned gen = old / nloc;
        if (old + 1u == (gen + 1u) * nloc) {
            __builtin_amdgcn_fence(__ATOMIC_RELEASE, "agent");
            asm volatile("s_waitcnt vmcnt(0)" ::: "memory");
            const unsigned og = xb_add(&bar[XB_TOP], 1u);
            const unsigned tg = og / nx;
            if (og + 1u == (tg + 1u) * nx) xb_add(&bar[XB_TOPGEN], 1u);
            else XB_SPIN(xb_ld(&bar[XB_TOPGEN]) == tg, bar);
            __builtin_amdgcn_fence(__ATOMIC_ACQUIRE, "agent");
            xb_add(&bar[XB_XGEN(b.x)], 1u);
            asm volatile("s_waitcnt vmcnt(0)" ::: "memory");
        } else {
            XB_SPIN(xb_ld(&bar[XB_XGEN(b.x)]) == gen, bar);
            __builtin_amdgcn_fence(__ATOMIC_ACQUIRE, "agent");
            asm volatile("s_waitcnt vmcnt(0)" ::: "memory");
        }
    }
    __syncthreads();
}

typedef EpiResidB<true, false> RB_TF; typedef EpiResidB<false, false> RB_FF; typedef EpiResidB<false, true> RB_FT;
constexpr int N_PHASES = 19;
__global__ void __launch_bounds__(512, 2) fwd_megakernel(Args args) {
    extern __shared__ __attribute__((aligned(16))) unsigned char lds_raw[];
    cg::grid_group grid = cg::this_grid();
    Frame F;
    F.lds = (LAS unsigned char*)lds_raw;
    F.G = gridDim.x;
    F.in = args.in; F.out = args.out; F.ws = args.ws;
    unsigned char* ws = args.ws;
    const int lo = args.ph_lo, hi = args.ph_hi;
    { volatile LAS unsigned* st = (volatile LAS unsigned*)(F.lds + LDS_MISC + 16); if (threadIdx.x < 2) st[threadIdx.x] = 0u; __syncthreads(); }
    XcdBarrier xbar = xcd_barrier_post((unsigned*)(ws + WS_CTL + 4096), (volatile LAS unsigned*)(F.lds + LDS_MISC + 16));
    LAS float* red = (LAS float*)(F.lds + LDS_RED);
    const float* MODF = (const float*)(ws + WS_MODF);
#ifndef PHASE_MASK
#define PHASE_MASK 0xFFFFFFFFu
#endif
#define PH(k) ((((PHASE_MASK) >> (k)) & 1u) && lo <= (k) && (k) < hi)
#ifndef REPEAT_MASK
#define REPEAT_MASK 0u
#endif
#define REP(k) for (int rep_ = 0; rep_ < 1 + (int)(((REPEAT_MASK) >> (k)) & 1u); ++rep_)
#define SEAM(k) do { if (PH(k) && PH((k) + 1)) { if ((k) == 0) { \
        asm volatile("s_waitcnt vmcnt(0) lgkmcnt(0)" ::: "memory"); __syncthreads(); \
        if (threadIdx.x == 0) { __builtin_amdgcn_fence(__ATOMIC_RELEASE, "agent"); asm volatile("s_waitcnt vmcnt(0)" ::: "memory"); } \
        grid.sync(); \
        if (threadIdx.x == 0) { __builtin_amdgcn_fence(__ATOMIC_ACQUIRE, "agent"); asm volatile("s_waitcnt vmcnt(0)" ::: "memory"); } \
        __syncthreads(); } else xcd_barrier(xbar); } } while (0)
#define GEMM(EPI, A_, B_, M_, N_, K_, E_) do { int k_ = (K_); asm volatile("" : "+s"(k_)); pg8::Gemm g_{(const bf16_t*)(A_), (const bf16_t*)(B_), (M_), (N_), k_, k_}; pg8::StaticOrder S_; S_.init((M_), (N_), F.G, (int)((blockIdx.x + gemm_rot_) % F.G)); \
        pg8::gemm_phase<EPI, pg8::StaticOrder, true, true>(F.lds, g_, S_, (E_)); } while (0)

#define GEMM_TAIL(A_, B_, KFULL_) do { int k_ = (KFULL_) / KSPL; asm volatile("" : "+s"(k_)); pg8::Gemm g_{(const bf16_t*)(A_), (const bf16_t*)(B_), MS, 1024, k_, (KFULL_)}; pg8::TailOrder S_; S_.init(MS, 1024, KSPL, F.G, (int)blockIdx.x); \
        EpiPart E_{(float*)(ws + WS_PBUF)}; pg8::gemm_phase<EpiPart, pg8::TailOrder, true, true>(F.lds, g_, S_, E_); } while (0)
    int gemm_rot_ = 0;
    if (PH(0)) REP(0) p0_phase(F);
    SEAM(0);
    if (PH(1)) REP(1) modnorm_phase<0>(F, 0, 0, nullptr, nullptr);
    SEAM(1);
    if (PH(2)) REP(2) { EpiF32 E{(float*)(ws + WS_A0), 768}; GEMM(EpiF32, ws + WS_H, ws + WS_WIN, MT, 768, 1024, E);
        if (blockIdx.x >= 134) { EpiKN E2{(bf16_t*)(ws + WS_KN), (float*)(ws + WS_RS), F.in[20], red, MKN / 256 - 92}; int k_ = 256; asm volatile("" : "+s"(k_));
            pg8::Gemm g_{(const bf16_t*)(ws + WS_CKV) + (size_t)(MKN / 256 - 92) * 256 * 256, (const bf16_t*)(ws + WS_WUK), 92 * 256, 1024, k_, k_}; pg8::StaticOrder S_; S_.init(92 * 256, 1024, 122, (int)blockIdx.x - 134);
            pg8::gemm_phase<EpiKN, pg8::StaticOrder, true, true>(F.lds, g_, S_, E2); } }
    SEAM(2);
    if (PH(3)) REP(3) latent_phase(F);
    SEAM(3);
    if (PH(4)) REP(4) {
#if !defined(P4_ONLY) || P4_ONLY == 1
        { EpiKN E{(bf16_t*)(ws + WS_KN), (float*)(ws + WS_RS), F.in[20], red, 0}; GEMM(EpiKN, ws + WS_CKV, ws + WS_WUK, MKN - 92 * 256, 1024, 256, E); }
#endif
#if !defined(P4_ONLY) || P4_ONLY == 2
        gemm_rot_ = 96;
        { EpiQ E{(bf16_t*)(ws + WS_A0), F.in[18], F.in[19], red}; GEMM(EpiQ, ws + WS_CQ, ws + WS_WQ, MT, 1536, 384, E); }
#endif
#if !defined(P4_ONLY) || P4_ONLY == 3
        gemm_rot_ = 56;
        { EpiBf16<0> E{(bf16_t*)(ws + WS_V), 1024}; GEMM(EpiBf16<0>, ws + WS_CKV, ws + WS_WUV, MT, 1024, 256, E); }
        gemm_rot_ = 0;
#endif
    }
    SEAM(4);
    if (PH(5)) REP(5) attention_phase(F, (unsigned*)(ws + WS_CTL) + rep_, rep_ != 0);
    SEAM(5);
    if (PH(6)) REP(6) combine_phase(F);
    SEAM(6);
    if (PH(7)) REP(7) { EpiResidB<true, false> E{F.in[0], ws + WS_V, MODF + 2048}; GEMM(RB_TF, ws + WS_H, ws + WS_WO, MP, 1024, 1024, E); GEMM_TAIL(ws + WS_H + (size_t)MP * 1024 * 2, ws + WS_WO, 1024); }
    SEAM(7);
    if (PH(8)) REP(8) modnorm_phase<1>(F, 0, 1, MODF + 2048, F.in[1]);
    SEAM(8);
    if (PH(9)) REP(9) { EpiBf16<1> E{(bf16_t*)(ws + WS_HF), 4096}; GEMM(EpiBf16<1>, ws + WS_H, ws + WS_W1, MT, 4096, 1024, E); }
    SEAM(9);
    if (PH(10)) REP(10) { EpiResidB<false, false> E{ws + WS_V, ws + WS_V, MODF + 5120}; GEMM(RB_FF, ws + WS_HF, ws + WS_W2, MP, 1024, 4096, E); GEMM_TAIL(ws + WS_HF + (size_t)MP * 4096 * 2, ws + WS_W2, 4096); }
#ifdef DUP_W2
    if (PH(10)) { EpiBf16<0> E{(bf16_t*)(ws + WS_H), 1024}; GEMM(EpiBf16<0>, ws + WS_HF, ws + WS_W2, MP, 1024, 4096, E); }
#endif
#ifdef EXTRA_SYNCS
    for (int es_ = 0; es_ < EXTRA_SYNCS; ++es_) SEAM(10);
#endif
    SEAM(10);
    if (PH(11)) REP(11) modnorm_phase<1>(F, 1, 0, MODF + 5120, nullptr);
    SEAM(11);
    if (PH(12)) REP(12) {
        { EpiBf16<2> E{(bf16_t*)(ws + WS_U), 1024}; GEMM(EpiBf16<2>, ws + WS_H, ws + WS_CWIN, MT, 1024, 1024, E); }
        gemm_rot_ = 128;
        { EpiVT E{(bf16_t*)(ws + WS_VT), (float*)(ws + WS_SSV)}; GEMM(EpiVT, ws + WS_CWIN + (size_t)1024 * 1024 * 2, ws + WS_H, 1024, MT, 1024, E); }
        gemm_rot_ = 0;
    }
    SEAM(12);
    if (PH(13)) REP(13) sgu_phase(F);
    SEAM(13);
    if (PH(14)) REP(14) { EpiResidB<false, false> E{ws + WS_V, ws + WS_V, MODF + 40 * 6144 + 2048}; GEMM(RB_FF, ws + WS_G, ws + WS_CWO, MP, 1024, 1024, E); GEMM_TAIL(ws + WS_G + (size_t)MP * 1024 * 2, ws + WS_CWO, 1024); }
    SEAM(14);
    if (PH(15)) REP(15) modnorm_phase<1>(F, 1, 1, MODF + 40 * 6144 + 2048, nullptr);
    SEAM(15);
    if (PH(16)) REP(16) { EpiBf16<1> E{(bf16_t*)(ws + WS_HF), 4096}; GEMM(EpiBf16<1>, ws + WS_H, ws + WS_W1 + (size_t)4096 * 1024 * 2, MT, 4096, 1024, E); }
    SEAM(16);
    if (PH(17)) REP(17) { EpiResidB<false, true> E{ws + WS_V, F.out, MODF + 40 * 6144 + 5120}; GEMM(RB_FT, ws + WS_HF, ws + WS_W2 + (size_t)4096 * 1024 * 2, MP, 1024, 4096, E); GEMM_TAIL(ws + WS_HF + (size_t)MP * 4096 * 2, ws + WS_W2 + (size_t)4096 * 1024 * 2, 4096); }
    SEAM(17);
    if (PH(18)) REP(18) final_tail_phase(F, MODF + 40 * 6144 + 5120);
#undef PH
#undef SEAM
#undef GEMM
#undef GEMM_TAIL
}

#ifndef MK_N_LAUNCHES
#define MK_N_LAUNCHES 1
#endif
extern "C" void kernel_launch(void* const* d_in, const int* in_sizes, int n_in, void* d_out, int out_size, void* d_ws, size_t ws_size, hipStream_t stream) {
    static int grid = 0;
    if (grid == 0) {
        if (n_in != 28 || (size_t)out_size != OUT_END || ws_size < WS_END) { fprintf(stderr, "kernel_launch: unexpected shapes: n_in %d out %d ws %zu\n", n_in, out_size, ws_size); grid = -1; return; }
        int dev = 0, cus = 0, per_cu = 0;
        hipGetDevice(&dev); hipDeviceGetAttribute(&cus, hipDeviceAttributeMultiprocessorCount, dev);
        if (hipFuncSetAttribute((const void*)fwd_megakernel, hipFuncAttributeMaxDynamicSharedMemorySize, LDS_BYTES) != hipSuccess) { fprintf(stderr, "kernel_launch: hipFuncSetAttribute failed\n"); grid = -1; return; }
        if (hipOccupancyMaxActiveBlocksPerMultiprocessor(&per_cu, (const void*)fwd_megakernel, 512, LDS_BYTES) != hipSuccess || per_cu < 1) { fprintf(stderr, "kernel_launch: occupancy query says %d\n", per_cu); per_cu = 1; }
        (void)hipGetLastError();
        grid = cus;
        fprintf(stderr, "kernel_launch: grid %d (per_cu %d)\n", grid, per_cu);
    }
    if (grid < 0) return;
    (void)hipMemsetAsync((char*)d_ws + WS_CTL, 0, CTL_BYTES, stream);
    Args a{};
    for (int i = 0; i < 28; ++i) a.in[i] = (const float*)d_in[i];
    a.out = (float*)d_out; a.ws = (unsigned char*)d_ws;
#if MK_N_LAUNCHES == 1
#ifndef PH_HI_TEST
#define PH_HI_TEST N_PHASES
#endif
    a.ph_lo = 0; a.ph_hi = PH_HI_TEST;
    void* params[] = {&a};
    hipError_t e = hipLaunchCooperativeKernel((const void*)fwd_megakernel, dim3(grid), dim3(512), params, LDS_BYTES, stream);
    if (e != hipSuccess) fprintf(stderr, "kernel_launch: cooperative launch failed: %s (grid %d)\n", hipGetErrorString(e), grid);
#else
    for (int p = 0; p < N_PHASES; ++p) { a.ph_lo = p; a.ph_hi = p + 1; hipLaunchKernelGGL(fwd_megakernel, dim3(grid), dim3(512), LDS_BYTES, stream, a); }
#endif
}
```

```cpp
#include <hip/hip_runtime.h>
#include <hip/hip_cooperative_groups.h>
#include <cstdio>
#include <cstdint>
namespace cg = cooperative_groups;

#define LAS __attribute__((address_space(3)))
typedef unsigned short bf16_t;
typedef short bf16x8 __attribute__((ext_vector_type(8)));
typedef short s16x4 __attribute__((ext_vector_type(4)));
typedef float f32x4 __attribute__((ext_vector_type(4)));
typedef float f32x2 __attribute__((ext_vector_type(2)));
typedef float f32x16 __attribute__((ext_vector_type(16)));
typedef unsigned u32x4 __attribute__((ext_vector_type(4)));
typedef unsigned u32x2 __attribute__((ext_vector_type(2)));

constexpr int DM = 1024, NB_P = 8, SEQ = 4096, NB_S = 32, DSEQ = 16, PAST = 4096;
constexpr int MP = NB_P * SEQ;
constexpr int MS = NB_S * DSEQ;
constexpr int MT = MP + MS;
constexpr int NSEQ = NB_P + NB_S;
constexpr int NH = 8, DNOPE = 128, DROPE = 64, DV = 128, QLORA = 384, KVLORA = 256, DFF = 4096;
constexpr int NCACHE = NB_S * PAST;
constexpr int MKN = MT + NCACHE;
constexpr int VTP = 33536;
constexpr float EPS = 1e-6f;
constexpr float SM_SCALE = 0.07216878364870322f;
constexpr int NSPLIT = 4;
constexpr size_t OUT_Y = 0, OUT_CKVP = (size_t)MT * DM, OUT_KPEP = OUT_CKVP + (size_t)MP * 256, OUT_CKVS = OUT_KPEP + (size_t)MP * 64,
                 OUT_KPES = OUT_CKVS + (size_t)MS * 256, OUT_VS = OUT_KPES + (size_t)MS * 64, OUT_END = OUT_VS + (size_t)MS * DM;
constexpr size_t MiB = 1u << 20;
constexpr size_t WS_CTL = 0, CTL_BYTES = 32768;
constexpr size_t WS_WIN = 1 * MiB;
constexpr size_t WS_WQ = WS_WIN + 768 * 1024 * 2;
constexpr size_t WS_WUK = WS_WQ + 1536 * 384 * 2;
constexpr size_t WS_WUV = WS_WUK + 1024 * 256 * 2;
constexpr size_t WS_WUKN = WS_WUV + 1024 * 256 * 2;
constexpr size_t WS_WO = WS_WUKN + 1024 * 256 * 2;
constexpr size_t WS_W1 = WS_WO + 1024 * 1024 * 2;
constexpr size_t WS_W2 = WS_W1 + 2ull * 4096 * 1024 * 2;
constexpr size_t WS_CWIN = WS_W2 + 2ull * 4096 * 1024 * 2;
constexpr size_t WS_CWO = WS_CWIN + 2048 * 1024 * 2;
constexpr size_t WS_WEND = WS_CWO + 1024 * 1024 * 2;
static_assert(WS_WEND <= 46 * MiB, "weights");
constexpr size_t WS_MODF = 46 * MiB;
constexpr size_t WS_SSV = 48 * MiB;
constexpr size_t WS_PBUF = 50 * MiB;
constexpr int KSPL = 8;
constexpr size_t WS_PART = 50 * MiB;
constexpr size_t WS_ML = 66 * MiB;
constexpr size_t WS_H = 67 * MiB;
constexpr size_t WS_A0 = 132 * MiB;
constexpr size_t WS_CQ = 230 * MiB;
constexpr size_t WS_CKV = 255 * MiB;
constexpr size_t WS_KR = 336 * MiB;
constexpr size_t WS_KPE = 341 * MiB;
constexpr size_t WS_RS = 357 * MiB;
constexpr size_t WS_KN = 363 * MiB;
constexpr size_t WS_V = 428 * MiB;
constexpr size_t WS_END = 493 * MiB;
constexpr size_t WS_HF = 132 * MiB;
constexpr size_t WS_U = 132 * MiB;
constexpr size_t WS_VT = 197 * MiB;
constexpr size_t WS_G = 263 * MiB;
static_assert(WS_CKV + (size_t)MKN * 256 * 2 <= WS_KR && WS_RS + (size_t)MKN * 32 <= WS_KN && WS_V + (size_t)MT * 2048 <= WS_END, "ws map");
static_assert(WS_VT + (size_t)1024 * VTP * 2 <= WS_G && WS_HF + (size_t)MT * 8192 <= WS_END, "ws map 2");
constexpr int LDS_BYTES = 147456;
constexpr int LDS_RED = 131072;
constexpr int LDS_MISC = 147392;

typedef __bf16 bf16x2_t __attribute__((ext_vector_type(2)));
__device__ __forceinline__ unsigned cvt_pk_bf16(float lo, float hi) { const f32x2 v = {lo, hi}; const bf16x2_t b = __builtin_convertvector(v, bf16x2_t); return __builtin_bit_cast(unsigned, b); }
__device__ __forceinline__ float bf2f(bf16_t b) { return __uint_as_float(((unsigned)b) << 16); }
__device__ __forceinline__ float bflo(unsigned w) { return __uint_as_float(w << 16); }
__device__ __forceinline__ float bfhi(unsigned w) { return __uint_as_float(w & 0xffff0000u); }
__device__ __forceinline__ bf16_t f2bf(float f) { return (bf16_t)(cvt_pk_bf16(f, 0.f) & 0xffffu); }
template <int X> __device__ __forceinline__ float swz_xor(float v) { return __int_as_float(__builtin_amdgcn_ds_swizzle(__float_as_int(v), (X << 10) | 0x1f)); }
__device__ __forceinline__ float sum_x32(float v) { auto rr = __builtin_amdgcn_permlane32_swap(__float_as_uint(v), __float_as_uint(v), false, false); return __uint_as_float(rr[0]) + __uint_as_float(rr[1]); }
__device__ __forceinline__ float wave_sum(float v) { v += swz_xor<1>(v); v += swz_xor<2>(v); v += swz_xor<4>(v); v += swz_xor<8>(v); v += swz_xor<16>(v); return sum_x32(v); }
__device__ __forceinline__ float gelu_tanh(float x) {
    const float u = 0.7978845608028654f * (x + 0.044715f * x * x * x);
    return x * __builtin_amdgcn_rcpf(1.f + __builtin_amdgcn_exp2f(-2.885390081777927f * u));
}
__device__ __forceinline__ void sincos_rev(float ang, float& s, float& c) {
    float rev = ang * 0.15915494309189535f; rev -= floorf(rev);
    s = __builtin_amdgcn_sinf(rev); c = __builtin_amdgcn_cosf(rev);
}
__device__ __forceinline__ float rope_inv(int i) { return __builtin_amdgcn_exp2f(-(float)i * (13.287712379549449f / 32.f)); }
__device__ __forceinline__ int row_pos(int r) { return r < MP ? (r & (SEQ - 1)) : PAST + ((r - MP) & (DSEQ - 1)); }
__device__ __forceinline__ int row_seq(int r) { return r < MP ? (r >> 12) : NB_P + ((r - MP) >> 4); }

namespace pg8 {
#define PG8_LAS __attribute__((address_space(3)))
constexpr int BM = 256, BK = 64, HALF = 128, HTB = HALF * BK * 2  , STAGE_BYTES = 8 * HTB, NXCD = 8, WGM = 8;
__host__ __device__ __forceinline__ int lds_byte(int r, int c) { const int st = (r >> 4) * 2 + (c >> 5), rr = r & 15, cc = c & 31, ob = rr * 64 + cc * 2; return st * 1024 + (ob ^ (((ob >> 9) & 1) << 5)); }
__host__ __device__ __forceinline__ void stage_rc(int b, int& R, int& C) { const int st = b / 1024, sb = b % 1024, swz = sb ^ (((sb >> 9) & 1) << 5); R = (st >> 1) * 16 + swz / 64; C = (st & 1) * 32 + (swz % 64) / 2; }
__host__ __device__ __forceinline__ int perm32(int rho) { const int n = rho >> 4, i = rho & 15; return 8 * (i >> 2) + 4 * n + (i & 3); }
struct Unit { int pm, pn, pk; };
struct Gemm { const bf16_t* A; const bf16_t* Bt; int M, N, K, ld; };
struct StaticOrder {
    int nM, nN, nwg, G, c;
    __host__ __device__ void init(int M, int N, int G_, int c_) { nM = M / BM; nN = N / BM; nwg = nM * nN; G = G_; c = c_; }
    __host__ __device__ bool next(int i, Unit& u) const {
        const long L = (long)i * G + c; if (L >= nwg) return false;
        int wgid = (int)L; { const int q = nwg / NXCD, r = nwg % NXCD, xcd = wgid % NXCD, off = wgid / NXCD; wgid = (xcd < r ? xcd * (q + 1) : r * (q + 1) + (xcd - r) * q) + off; }
        const int nig = WGM * nN, gid = wgid / nig, fm = gid * WGM, gsz = (nM - fm) < WGM ? (nM - fm) : WGM;
        u.pm = fm + ((wgid % nig) % gsz); u.pn = (wgid % nig) / gsz; u.pk = 0; return true;
    }
    __device__ __forceinline__ void a_ready(const Unit&) const {}
    __device__ __forceinline__ void done(const Unit&) const {}
};
struct TailOrder {
    int nM, nN, KS, G, c;
    __host__ __device__ void init(int M, int N, int KS_, int G_, int c_) { nM = M / BM; nN = N / BM; KS = KS_; G = G_; c = c_; }
    __host__ __device__ bool next(int i, Unit& u) const {
        const long L = (long)i * G + c; if (L >= (long)nM * nN * KS) return false;
        const int t = (int)L % (nM * nN); u.pk = (int)L / (nM * nN); u.pm = t % nM; u.pn = t / nM; return true;
    }
    __device__ __forceinline__ void a_ready(const Unit&) const {}
    __device__ __forceinline__ void done(const Unit&) const {}
};
template <class Epi, class Sched, bool ALIGN_EPI = false, bool SP2 = false>
__device__ __forceinline__ void gemm_phase(PG8_LAS unsigned char* lds, const Gemm g, const Sched& S, const Epi& E) {
    int tid_l = threadIdx.x; asm volatile("" : "+v"(tid_l));
    const int tid = tid_l, wid = __builtin_amdgcn_readfirstlane(tid >> 6), lane = tid & 63, wr = wid >> 2, wc = wid & 3, fr = lane & 15, fq = lane >> 4;
    const int K = g.K, nt = K / BK, ld = g.ld;
    unsigned voffA[2], voffB[2];
#pragma unroll
    for (int i = 0; i < 2; ++i) { int R, C; stage_rc(tid * 16 + i * 8192, R, C); const int Rb = Epi::PERM ? ((R & ~31) + perm32(R & 31)) : R;
        voffA[i] = (unsigned)(R * ld + C) * 2u; voffB[i] = (unsigned)(Rb * ld + C) * 2u; }
    const size_t kstep = (size_t)(BK * 2);
    const size_t hstep = (size_t)HALF * ld * 2;
    const size_t tstep = 2 * hstep;
    const unsigned ldsw = (unsigned)wid * 1024u;
    const int aoff = lds_byte(wr * 64 + fr, fq * 8), boff = lds_byte(wc * 32 + fr, fq * 8);
#define PG8_SA(b, h) (((b) * 2 + (h)) * HTB)
#define PG8_SB(b, h) ((4 + (b) * 2 + (h)) * HTB)
#define PG8_STAGE(bufoff, gbase, voff) do { _Pragma("unroll") for (int _i = 0; _i < 2; ++_i) \
        __builtin_amdgcn_global_load_lds((const unsigned*)((const char*)(gbase) + (voff)[_i]), (PG8_LAS unsigned*)(lds + (bufoff) + ldsw + _i * 8192), 16, 0, 0); } while (0)
#define PG8_LDA(dst, b, h) do { _Pragma("unroll") for (int m = 0; m < 4; ++m) _Pragma("unroll") for (int k = 0; k < 2; ++k) dst[m][k] = *(const PG8_LAS bf16x8*)(lds + PG8_SA(b, h) + aoff + m * 2048 + k * 1024); } while (0)
#define PG8_LDB(dst, b, h) do { _Pragma("unroll") for (int n = 0; n < 2; ++n) _Pragma("unroll") for (int k = 0; k < 2; ++k) dst[n][k] = *(const PG8_LAS bf16x8*)(lds + PG8_SB(b, h) + boff + n * 2048 + k * 1024); } while (0)
#define PG8_MMA(ai, bj, At, Bt) do { __builtin_amdgcn_s_setprio(1); _Pragma("unroll") for (int m = 0; m < 4; ++m) _Pragma("unroll") for (int n = 0; n < 2; ++n) _Pragma("unroll") for (int k = 0; k < 2; ++k) \
        acc[ai][bj][m][n] = __builtin_amdgcn_mfma_f32_16x16x32_bf16(Bt[n][k], At[m][k], acc[ai][bj][m][n], 0, 0, 0); __builtin_amdgcn_s_setprio(0); } while (0)
#define PG8_WAIT_V(n) asm volatile("s_waitcnt vmcnt(" #n ")" ::: "memory")
#define PG8_WAIT_L(n) asm volatile("s_waitcnt lgkmcnt(" #n ")" ::: "memory")
#define PG8_BAR __builtin_amdgcn_s_barrier()
#define PG8_SCHED __builtin_amdgcn_sched_barrier(0)
    Unit cur, nxt; int ui = 0;
    if (!S.next(0, cur)) return;
    f32x4 acc[2][2][4][2];
#pragma unroll
    for (int a = 0; a < 2; ++a)
#pragma unroll
        for (int b = 0; b < 2; ++b)
#pragma unroll
            for (int m = 0; m < 4; ++m)
#pragma unroll
                for (int n = 0; n < 2; ++n) acc[a][b][m][n] = (f32x4){0.f, 0.f, 0.f, 0.f};
    bf16x8 At[4][2], B0[2][2], B1[2][2];
    const char* cA = (const char*)g.A + (size_t)cur.pm * tstep + (size_t)cur.pk * K * 2; const char* cB = (const char*)g.Bt + (size_t)cur.pn * tstep + (size_t)cur.pk * K * 2;
    S.a_ready(cur);
    if constexpr (SP2) {
        PG8_STAGE(PG8_SB(0, 0), cB, voffB); PG8_STAGE(PG8_SB(0, 1), cB + hstep, voffB); PG8_STAGE(PG8_SA(0, 0), cA, voffA); PG8_STAGE(PG8_SA(0, 1), cA + hstep, voffA);
        if (wr == 1) PG8_BAR;
        PG8_WAIT_V(2); PG8_BAR;
        PG8_STAGE(PG8_SB(1, 0), cB + kstep, voffB); PG8_STAGE(PG8_SA(1, 0), cA + kstep, voffA); PG8_STAGE(PG8_SB(1, 1), cB + hstep + kstep, voffB);
        PG8_WAIT_V(6); PG8_BAR;
    } else {
        PG8_STAGE(PG8_SB(0, 0), cB, voffB); PG8_STAGE(PG8_SA(0, 0), cA, voffA); PG8_STAGE(PG8_SB(0, 1), cB + hstep, voffB); PG8_STAGE(PG8_SA(0, 1), cA + hstep, voffA);
        if (wr == 1) PG8_BAR;
        PG8_WAIT_V(4); PG8_BAR;
        PG8_STAGE(PG8_SB(1, 0), cB + kstep, voffB); PG8_STAGE(PG8_SA(1, 0), cA + kstep, voffA); PG8_STAGE(PG8_SB(1, 1), cB + hstep + kstep, voffB);
        PG8_WAIT_V(6); PG8_BAR;
    }
    for (;;) {
        const bool has_next = S.next(ui + 1, nxt);
        const char* nA = has_next ? (const char*)g.A + (size_t)nxt.pm * tstep + (size_t)nxt.pk * K * 2 : cA; const char* nB = has_next ? (const char*)g.Bt + (size_t)nxt.pn * tstep + (size_t)nxt.pk * K * 2 : cB;
        for (int t = 0; t < nt; t += 2) {
            const bool last = (t == nt - 2);
            const char* a1 = cA + (size_t)(t + 1) * kstep;
            const char* a2 = last ? nA : cA + (size_t)(t + 2) * kstep; const char* b2 = last ? nB : cB + (size_t)(t + 2) * kstep;
            const char* a3 = a2 + kstep; const char* b3 = b2 + kstep;
            if (last && has_next) S.a_ready(nxt);
            if constexpr (SP2) {
            PG8_LDB(B0, 0, 0); PG8_LDB(B1, 0, 1); PG8_SCHED; PG8_LDA(At, 0, 0); PG8_STAGE(PG8_SA(1, 1), a1 + hstep, voffA);
            PG8_WAIT_V(8); PG8_WAIT_L(0); PG8_BAR; PG8_MMA(0, 0, At, B0); PG8_MMA(0, 1, At, B1); PG8_BAR; PG8_SCHED;
            PG8_LDA(At, 0, 1); PG8_STAGE(PG8_SB(0, 0), b2, voffB); PG8_STAGE(PG8_SB(0, 1), b2 + hstep, voffB); PG8_STAGE(PG8_SA(0, 0), a2, voffA);
            PG8_WAIT_V(8); PG8_WAIT_L(0); PG8_BAR; PG8_MMA(1, 0, At, B0); PG8_MMA(1, 1, At, B1); PG8_BAR; PG8_SCHED;
            PG8_LDB(B0, 1, 0); PG8_LDB(B1, 1, 1); PG8_SCHED; PG8_LDA(At, 1, 0); PG8_STAGE(PG8_SA(0, 1), a2 + hstep, voffA);
            PG8_WAIT_V(8); PG8_WAIT_L(0); PG8_BAR; PG8_MMA(0, 0, At, B0); PG8_MMA(0, 1, At, B1); PG8_BAR; PG8_SCHED;
            PG8_LDA(At, 1, 1); PG8_STAGE(PG8_SB(1, 0), b3, voffB); PG8_STAGE(PG8_SB(1, 1), b3 + hstep, voffB); PG8_STAGE(PG8_SA(1, 0), a3, voffA);
            PG8_WAIT_V(8); PG8_WAIT_L(0); PG8_BAR; PG8_MMA(1, 0, At, B0); PG8_MMA(1, 1, At, B1); PG8_BAR; PG8_SCHED;
            } else {
            PG8_LDB(B0, 0, 0); PG8_SCHED; PG8_LDA(At, 0, 0); PG8_STAGE(PG8_SA(1, 1), a1 + hstep, voffA);
            PG8_WAIT_L(8); PG8_BAR; PG8_WAIT_L(0); PG8_MMA(0, 0, At, B0); PG8_BAR; PG8_SCHED;
            PG8_LDB(B1, 0, 1); PG8_STAGE(PG8_SB(0, 0), b2, voffB);
            PG8_BAR; PG8_WAIT_L(0); PG8_MMA(0, 1, At, B1); PG8_BAR;
            PG8_LDA(At, 0, 1); PG8_STAGE(PG8_SA(0, 0), a2, voffA);
            PG8_BAR; PG8_WAIT_L(0); PG8_MMA(1, 0, At, B0); PG8_BAR; PG8_SCHED;
            PG8_STAGE(PG8_SB(0, 1), b2 + hstep, voffB);
            PG8_WAIT_V(6); PG8_BAR; PG8_MMA(1, 1, At, B1); PG8_BAR;
            PG8_LDB(B0, 1, 0); PG8_SCHED; PG8_LDA(At, 1, 0); PG8_STAGE(PG8_SA(0, 1), a2 + hstep, voffA);
            PG8_WAIT_L(8); PG8_BAR; PG8_WAIT_L(0); PG8_MMA(0, 0, At, B0); PG8_BAR; PG8_SCHED;
            PG8_LDB(B1, 1, 1); PG8_STAGE(PG8_SB(1, 0), b3, voffB);
            PG8_BAR; PG8_WAIT_L(0); PG8_MMA(0, 1, At, B1); PG8_BAR;
            PG8_LDA(At, 1, 1); PG8_STAGE(PG8_SA(1, 0), a3, voffA);
            PG8_BAR; PG8_WAIT_L(0); PG8_MMA(1, 0, At, B0); PG8_BAR; PG8_SCHED;
            PG8_STAGE(PG8_SB(1, 1), b3 + hstep, voffB);
            PG8_WAIT_V(6); PG8_BAR; PG8_MMA(1, 1, At, B1); PG8_BAR;
            }
        }
        if constexpr (ALIGN_EPI) { if (wr == 0) PG8_BAR; }
        if constexpr (!Epi::AFTER_DRAIN) { E(acc, cur, wr, wc, fr, fq); S.done(cur); }
        if (!has_next) break;
#pragma unroll
        for (int a = 0; a < 2; ++a)
#pragma unroll
            for (int b = 0; b < 2; ++b)
#pragma unroll
                for (int m = 0; m < 4; ++m)
#pragma unroll
                    for (int n = 0; n < 2; ++n) acc[a][b][m][n] = (f32x4){0.f, 0.f, 0.f, 0.f};
        cur = nxt; cA = nA; cB = nB; ++ui;
        if constexpr (ALIGN_EPI) { if (wr == 1) PG8_BAR; }
    }
    PG8_WAIT_V(0);
    if constexpr (!ALIGN_EPI) { if (wr == 0) PG8_BAR; }
    PG8_BAR;
    if constexpr (Epi::AFTER_DRAIN) { E.fused(acc, cur, wr, wc, fr, fq, lds, wid, lane); S.done(cur); }
#undef PG8_SA
#undef PG8_SB
#undef PG8_STAGE
#undef PG8_LDA
#undef PG8_LDB
#undef PG8_MMA
#undef PG8_WAIT_V
#undef PG8_WAIT_L
#undef PG8_BAR
#undef PG8_SCHED
}
}

typedef f32x4 AccT[2][2][4][2];

struct EpiF32 {
    static constexpr bool PERM = false, AFTER_DRAIN = false;
    float* O; int ldc;
    __device__ __forceinline__ void operator()(const AccT& acc, const pg8::Unit& u, int wr, int wc, int fr, int fq) const {
        asm volatile("" : "+v"(fr), "+v"(fq));
        const int row0 = u.pm * 256 + wr * 64 + fr, col0 = u.pn * 256 + wc * 32 + 4 * fq;
#pragma unroll
        for (int ai = 0; ai < 2; ++ai)
#pragma unroll
            for (int m = 0; m < 4; ++m) { float* rowp = O + (size_t)(row0 + ai * 128 + m * 16) * ldc + col0;
#pragma unroll
                for (int bj = 0; bj < 2; ++bj)
#pragma unroll
                    for (int n = 0; n < 2; ++n) *(f32x4*)(rowp + bj * 128 + n * 16) = acc[ai][bj][m][n]; }
    }
};
struct EpiPart {
    static constexpr bool PERM = false, AFTER_DRAIN = false;
    float* P;
    __device__ __forceinline__ void operator()(const AccT& acc, const pg8::Unit& u, int wr, int wc, int fr, int fq) const {
        asm volatile("" : "+v"(fr), "+v"(fq));
        const int row0 = u.pm * 256 + wr * 64 + fr, col0 = u.pn * 256 + wc * 32 + 4 * fq;
        float* O = P + (size_t)u.pk * MS * DM;
#pragma unroll
        for (int ai = 0; ai < 2; ++ai)
#pragma unroll
            for (int m = 0; m < 4; ++m) { float* rowp = O + (size_t)(row0 + ai * 128 + m * 16) * DM + col0;
#pragma unroll
                for (int bj = 0; bj < 2; ++bj)
#pragma unroll
                    for (int n = 0; n < 2; ++n) *(f32x4*)(rowp + bj * 128 + n * 16) = acc[ai][bj][m][n]; }
    }
};
struct EpiResid {
    static constexpr bool PERM = false, AFTER_DRAIN = false;
    const float* xp; float* out; const float* gate;
    __device__ __forceinline__ void operator()(const AccT& acc, const pg8::Unit& u, int wr, int wc, int fr, int fq) const {
        asm volatile("" : "+v"(fr), "+v"(fq));
        const int row0 = u.pm * 256 + wr * 64 + fr, col0 = u.pn * 256 + wc * 32 + 4 * fq;
        const float* gp = gate + (size_t)(u.pm >> 4) * 6144 + col0;
        f32x4 gv[2][2];
#pragma unroll
        for (int bj = 0; bj < 2; ++bj)
#pragma unroll
            for (int n = 0; n < 2; ++n) gv[bj][n] = *(const f32x4*)(gp + bj * 128 + n * 16);
#pragma unroll
        for (int ai = 0; ai < 2; ++ai) {
            f32x4 xv[4][2][2];
#pragma unroll
            for (int m = 0; m < 4; ++m) { const float* xr = xp + (size_t)(row0 + ai * 128 + m * 16) * DM + col0;
#pragma unroll
                for (int bj = 0; bj < 2; ++bj)
#pragma unroll
                    for (int n = 0; n < 2; ++n) xv[m][bj][n] = *(const f32x4*)(xr + bj * 128 + n * 16); }
#pragma unroll
            for (int m = 0; m < 4; ++m) { float* op = out + (size_t)(row0 + ai * 128 + m * 16) * DM + col0;
#pragma unroll
                for (int bj = 0; bj < 2; ++bj)
#pragma unroll
                    for (int n = 0; n < 2; ++n) *(f32x4*)(op + bj * 128 + n * 16) = xv[m][bj][n] + gv[bj][n] * acc[ai][bj][m][n]; }
        }
    }
};
template <bool IN32, bool OUT32> struct EpiResidB {
    static constexpr bool PERM = true, AFTER_DRAIN = false;
    const void* xin; void* xout; const float* gate;
    __device__ __forceinline__ void operator()(const AccT& acc, const pg8::Unit& u, int wr, int wc, int fr, int fq) const {
        asm volatile("" : "+v"(fr), "+v"(fq));
        const int row0 = u.pm * 256 + wr * 64 + fr, col0 = u.pn * 256 + wc * 32 + 8 * fq;
        const float* gp = gate + (size_t)(u.pm >> 4) * 6144 + col0;
        f32x4 gv[2][2];
#pragma unroll
        for (int bj = 0; bj < 2; ++bj) { gv[bj][0] = *(const f32x4*)(gp + bj * 128); gv[bj][1] = *(const f32x4*)(gp + bj * 128 + 4); }
#pragma unroll
        for (int ai = 0; ai < 2; ++ai) {
            f32x4 xa[4][2][2];
#pragma unroll
            for (int m = 0; m < 4; ++m) { const size_t ro = (size_t)(row0 + ai * 128 + m * 16) * DM + col0;
#pragma unroll
                for (int bj = 0; bj < 2; ++bj) {
                    if (IN32) { const float* xr = (const float*)xin + ro + bj * 128; xa[m][bj][0] = *(const f32x4*)xr; xa[m][bj][1] = *(const f32x4*)(xr + 4); }
                    else { const u32x4 w = *(const u32x4*)((const bf16_t*)xin + ro + bj * 128);
                        xa[m][bj][0] = (f32x4){bflo(w.x), bfhi(w.x), bflo(w.y), bfhi(w.y)}; xa[m][bj][1] = (f32x4){bflo(w.z), bfhi(w.z), bflo(w.w), bfhi(w.w)}; } } }
#pragma unroll
            for (int m = 0; m < 4; ++m) { const size_t ro = (size_t)(row0 + ai * 128 + m * 16) * DM + col0;
#pragma unroll
                for (int bj = 0; bj < 2; ++bj) { const f32x4 x0 = xa[m][bj][0] + gv[bj][0] * acc[ai][bj][m][0], x1 = xa[m][bj][1] + gv[bj][1] * acc[ai][bj][m][1];
                    if (OUT32) { float* op = (float*)xout + ro + bj * 128; *(f32x4*)op = x0; *(f32x4*)(op + 4) = x1; }
                    else { u32x4 w; w.x = cvt_pk_bf16(x0[0], x0[1]); w.y = cvt_pk_bf16(x0[2], x0[3]); w.z = cvt_pk_bf16(x1[0], x1[1]); w.w = cvt_pk_bf16(x1[2], x1[3]);
                        *(u32x4*)((bf16_t*)xout + ro + bj * 128) = w; } } }
        }
    }
};
template <int ACT> struct EpiBf16 {
    static constexpr bool PERM = true, AFTER_DRAIN = false;
    bf16_t* O; int ldc;
    __device__ __forceinline__ void operator()(const AccT& acc, const pg8::Unit& u, int wr, int wc, int fr, int fq) const {
        asm volatile("" : "+v"(fr), "+v"(fq));
        const int row0 = u.pm * 256 + wr * 64 + fr, col0 = u.pn * 256 + wc * 32 + 8 * fq;
#pragma unroll
        for (int ai = 0; ai < 2; ++ai)
#pragma unroll
            for (int m = 0; m < 4; ++m) { bf16_t* rowp = O + (size_t)(row0 + ai * 128 + m * 16) * ldc + col0;
#pragma unroll
                for (int bj = 0; bj < 2; ++bj) { f32x4 v0 = acc[ai][bj][m][0], v1 = acc[ai][bj][m][1];
                    if (ACT == 1) {
#pragma unroll
                        for (int j = 0; j < 4; ++j) { const float a = fmaxf(v0[j], 0.f), b = fmaxf(v1[j], 0.f); v0[j] = a * a; v1[j] = b * b; } }
                    if (ACT == 2) {
#pragma unroll
                        for (int j = 0; j < 4; ++j) { v0[j] = gelu_tanh(v0[j]); v1[j] = gelu_tanh(v1[j]); } }
                    u32x4 w; w.x = cvt_pk_bf16(v0[0], v0[1]); w.y = cvt_pk_bf16(v0[2], v0[3]); w.z = cvt_pk_bf16(v1[0], v1[1]); w.w = cvt_pk_bf16(v1[2], v1[3]);
                    *(u32x4*)(rowp + bj * 128) = w; } }
    }
};
struct EpiVT {
    static constexpr bool PERM = true, AFTER_DRAIN = false;
    bf16_t* VT; float* SSV;
    __device__ __forceinline__ void operator()(const AccT& acc, const pg8::Unit& u, int wr, int wc, int fr, int fq) const {
        asm volatile("" : "+v"(fr), "+v"(fq));
        const int row0 = u.pm * 256 + wr * 64 + fr, col0 = u.pn * 256 + wc * 32 + 8 * fq;
        float s[2][2][4];
#pragma unroll
        for (int bj = 0; bj < 2; ++bj)
#pragma unroll
            for (int n = 0; n < 2; ++n)
#pragma unroll
                for (int j = 0; j < 4; ++j) s[bj][n][j] = 0.f;
#pragma unroll
        for (int ai = 0; ai < 2; ++ai)
#pragma unroll
            for (int m = 0; m < 4; ++m) { bf16_t* rowp = VT + (size_t)(row0 + ai * 128 + m * 16) * VTP + col0;
#pragma unroll
                for (int bj = 0; bj < 2; ++bj) { f32x4 v0 = acc[ai][bj][m][0], v1 = acc[ai][bj][m][1];
#pragma unroll
                    for (int j = 0; j < 4; ++j) { v0[j] = gelu_tanh(v0[j]); v1[j] = gelu_tanh(v1[j]); s[bj][0][j] += v0[j] * v0[j]; s[bj][1][j] += v1[j] * v1[j]; }
                    u32x4 w; w.x = cvt_pk_bf16(v0[0], v0[1]); w.y = cvt_pk_bf16(v0[2], v0[3]); w.z = cvt_pk_bf16(v1[0], v1[1]); w.w = cvt_pk_bf16(v1[2], v1[3]);
                    *(u32x4*)(rowp + bj * 128) = w; } }
        float* sp = SSV + (size_t)(u.pm * 2 + wr) * VTP + col0;
#pragma unroll
        for (int bj = 0; bj < 2; ++bj)
#pragma unroll
            for (int n = 0; n < 2; ++n) { f32x4 t;
#pragma unroll
                for (int j = 0; j < 4; ++j) { float x = s[bj][n][j]; x += swz_xor<1>(x); x += swz_xor<2>(x); x += swz_xor<4>(x); x += swz_xor<8>(x); t[j] = x; }
                if (fr == 0) *(f32x4*)(sp + bj * 128 + n * 4) = t; }
    }
};
__device__ __forceinline__ void head_ss(const AccT& acc, LAS float* red, int wr, int wc, int fr, int fq) {
    LAS float* rw = red + (wr * 64 + fr) * 8 + wc;
#pragma unroll
    for (int ai = 0; ai < 2; ++ai)
#pragma unroll
        for (int m = 0; m < 4; ++m)
#pragma unroll
            for (int bj = 0; bj < 2; ++bj) { const f32x4 a = acc[ai][bj][m][0], b = acc[ai][bj][m][1];
                float s = (a[0] * a[0] + a[1] * a[1]) + (a[2] * a[2] + a[3] * a[3]) + (b[0] * b[0] + b[1] * b[1]) + (b[2] * b[2] + b[3] * b[3]);
                s += swz_xor<16>(s); s = sum_x32(s);
                if (fq == 0) rw[(ai * 128 + m * 16) * 8 + bj * 4] = s; }
    asm volatile("s_waitcnt lgkmcnt(0)" ::: "memory"); __builtin_amdgcn_s_barrier(); asm volatile("" ::: "memory");
}
__device__ __forceinline__ float head_rs(const LAS float* red, int rowl, int bj) {
    const f32x4 t = *(const LAS f32x4*)(red + rowl * 8 + bj * 4);
    return __builtin_amdgcn_rsqf(((t[0] + t[1]) + (t[2] + t[3])) * (1.f / 128.f) + EPS);
}
__device__ __forceinline__ void head_done() { asm volatile("s_waitcnt lgkmcnt(0)" ::: "memory"); __builtin_amdgcn_s_barrier(); asm volatile("" ::: "memory"); }
struct EpiKN {
    static constexpr bool PERM = true, AFTER_DRAIN = false;
    bf16_t* KN; float* RS; const float* g; LAS float* red; int pm_off;
    __device__ __forceinline__ void operator()(const AccT& acc, const pg8::Unit& u, int wr, int wc, int fr, int fq) const {
        asm volatile("" : "+v"(fr), "+v"(fq));
        head_ss(acc, red, wr, wc, fr, fq);
        const int pmg = u.pm + pm_off; const int row0 = pmg * 256 + wr * 64 + fr, d0 = wc * 32 + 8 * fq;
        const float* gl = g + d0; asm volatile("" : "+v"(gl)); const f32x4 g0 = *(const f32x4*)gl, g1 = *(const f32x4*)(gl + 4);
#pragma unroll
        for (int ai = 0; ai < 2; ++ai)
#pragma unroll
            for (int m = 0; m < 4; ++m) { const int r = row0 + ai * 128 + m * 16;
#pragma unroll
                for (int bj = 0; bj < 2; ++bj) { const float s = head_rs(red + (wr * 64 + fr) * 8, ai * 128 + m * 16, bj); const int h = 2 * u.pn + bj;
                    if (wc == 0 && fq == 0) RS[(size_t)r * 8 + h] = s;
                    if (pmg < MT / 256) { const f32x4 v0 = acc[ai][bj][m][0] * s * g0, v1 = acc[ai][bj][m][1] * s * g1;
                        u32x4 w; w.x = cvt_pk_bf16(v0[0], v0[1]); w.y = cvt_pk_bf16(v0[2], v0[3]); w.z = cvt_pk_bf16(v1[0], v1[1]); w.w = cvt_pk_bf16(v1[2], v1[3]);
                        *(u32x4*)(KN + (size_t)r * 1024 + h * 128 + d0) = w; } } }
        head_done();
    }
};
struct EpiQ {
    static constexpr bool PERM = true, AFTER_DRAIN = false;
    bf16_t* Q; const float* gqn; const float* gqr; LAS float* red;
    __device__ __forceinline__ void operator()(const AccT& acc, const pg8::Unit& u, int wr, int wc, int fr, int fq) const {
        asm volatile("" : "+v"(fr), "+v"(fq));
        const int row0 = u.pm * 256 + wr * 64 + fr;
        if (u.pn < 4) {
            head_ss(acc, red, wr, wc, fr, fq);
            const int d0 = wc * 32 + 8 * fq;
            const float* gl = gqn + d0; asm volatile("" : "+v"(gl)); const f32x4 g0 = *(const f32x4*)gl, g1 = *(const f32x4*)(gl + 4);
#pragma unroll
            for (int ai = 0; ai < 2; ++ai)
#pragma unroll
                for (int m = 0; m < 4; ++m) { const int r = row0 + ai * 128 + m * 16;
#pragma unroll
                    for (int bj = 0; bj < 2; ++bj) { const float s = head_rs(red + (wr * 64 + fr) * 8, ai * 128 + m * 16, bj); const int h = 2 * u.pn + bj;
                        const f32x4 v0 = acc[ai][bj][m][0] * s * g0, v1 = acc[ai][bj][m][1] * s * g1;
                        u32x4 w; w.x = cvt_pk_bf16(v0[0], v0[1]); w.y = cvt_pk_bf16(v0[2], v0[3]); w.z = cvt_pk_bf16(v1[0], v1[1]); w.w = cvt_pk_bf16(v1[2], v1[3]);
                        *(u32x4*)(Q + (size_t)r * 1536 + h * 192 + d0) = w; } }
            head_done();
        } else {
            const int h = (u.pn - 4) * 4 + wc, i0c = 8 * fq;
            float gqa[8], gqb[8]; { const float* gl = gqr + i0c; asm volatile("" : "+v"(gl));
#pragma unroll
                for (int t = 0; t < 8; ++t) { gqa[t] = gl[t]; gqb[t] = gl[32 + t]; } }
#pragma unroll
            for (int ai = 0; ai < 2; ++ai)
#pragma unroll
                for (int m = 0; m < 4; ++m) { const int r = row0 + ai * 128 + m * 16; int i0 = i0c; asm volatile("" : "+v"(i0));
                    float ss = 0.f;
#pragma unroll
                    for (int n = 0; n < 2; ++n)
#pragma unroll
                        for (int j = 0; j < 4; ++j) { const float a = acc[ai][0][m][n][j], b = acc[ai][1][m][n][j]; ss += a * a + b * b; }
                    ss += swz_xor<16>(ss); ss = sum_x32(ss);
                    const float s = __builtin_amdgcn_rsqf(ss * (1.f / 64.f) + EPS); const float pos = (float)row_pos(r);
                    unsigned w1[4], w2[4];
#pragma unroll
                    for (int tp = 0; tp < 4; ++tp) { float oa[2], ob[2];
#pragma unroll
                        for (int e = 0; e < 2; ++e) { const int t = 2 * tp + e; float sn, cs; sincos_rev(pos * rope_inv(i0 + t), sn, cs);
                            const float y1 = acc[ai][0][m][t >> 2][t & 3] * s * gqa[t], y2 = acc[ai][1][m][t >> 2][t & 3] * s * gqb[t];
                            oa[e] = y1 * cs - y2 * sn; ob[e] = y2 * cs + y1 * sn; }
                        w1[tp] = cvt_pk_bf16(oa[0], oa[1]); w2[tp] = cvt_pk_bf16(ob[0], ob[1]); }
                    bf16_t* qp = Q + (size_t)r * 1536 + h * 192 + 128 + i0;
                    *(u32x4*)qp = (u32x4){w1[0], w1[1], w1[2], w1[3]}; *(u32x4*)(qp + 32) = (u32x4){w2[0], w2[1], w2[2], w2[3]};
                    asm volatile("" ::: "memory"); }
        }
    }
};

struct Args { const float* in[28]; float* out; unsigned char* ws; int ph_lo, ph_hi; };
struct Frame {
    LAS unsigned char* lds;
    int G;
    const float* const* in; float* out; unsigned char* ws;
};
#define LOCAL_IDS() int tid_l_ = threadIdx.x; asm volatile("" : "+v"(tid_l_)); const int tid = tid_l_, lane = tid & 63, wave = __builtin_amdgcn_readfirstlane(tid >> 6); (void)tid; (void)lane; (void)wave
#define LDS_WAIT() asm volatile("s_waitcnt lgkmcnt(0)" ::: "memory")

__device__ __forceinline__ void transpose_block(const float* W, int K, int N, bf16_t* WT, int k0, int n0, int drow, LAS float* scr, int lane) {
#pragma unroll 8
    for (int i = 0; i < 32; ++i) { const int kk = 2 * i + (lane >> 5); scr[kk * 33 + (lane & 31)] = W[(size_t)(k0 + kk) * N + n0 + (lane & 31)]; }
    LDS_WAIT(); asm volatile("" ::: "memory");
    const int c = lane & 7;
#pragma unroll
    for (int j = 0; j < 4; ++j) { const int n = (lane >> 3) + 8 * j; const LAS float* s = scr + (8 * c) * 33 + n;
        u32x4 o; o.x = cvt_pk_bf16(s[0 * 33], s[1 * 33]); o.y = cvt_pk_bf16(s[2 * 33], s[3 * 33]); o.z = cvt_pk_bf16(s[4 * 33], s[5 * 33]); o.w = cvt_pk_bf16(s[6 * 33], s[7 * 33]);
        *(u32x4*)(WT + (size_t)(drow + n) * K + k0 + 8 * c) = o; }
    LDS_WAIT(); asm volatile("" ::: "memory");
}
__device__ __forceinline__ void transpose_item(const float* W, int K, int N, bf16_t* WT, int item, bool qperm, LAS float* scr, int lane) {
    const int nblk = N / 32, kb = item / nblk, nb = item % nblk, n0 = 32 * nb;
    int drow = n0;
    if (qperm) { const int h = n0 / 192, e = n0 % 192; drow = (e < 128) ? h * 128 + e : 1024 + (h >> 2) * 256 + 128 * ((e - 128) >> 5) + 32 * (h & 3); }
    transpose_block(W, K, N, WT, 64 * kb, n0, drow, scr, lane);
}
__device__ __forceinline__ void ada_item(Frame& F, int item) {
    LOCAL_IDS();
    const int layer = item / 96, col0 = (item % 96) * 64, w = wave;
    LAS float* slab = (LAS float*)F.lds + w * 2560;
    const float* W = F.in[6] + (size_t)layer * 1024 * 6144;
    float acc[40];
#pragma unroll
    for (int b = 0; b < 40; ++b) acc[b] = 0.f;
    for (int hh = 0; hh < 2; ++hh) {
        const int kbase = 128 * w + 64 * hh;
#pragma unroll 8
        for (int b = 0; b < 40; ++b) { const float c = (b < NB_P ? F.in[4] + b * DM : F.in[5] + (b - NB_P) * DM)[kbase + lane];
            slab[lane * 40 + b] = c * __builtin_amdgcn_rcpf(1.f + __expf(-c)); }
        LDS_WAIT(); asm volatile("" ::: "memory");
        for (int kk = 0; kk < 64; ++kk) { const float wv = W[(size_t)(kbase + kk) * 6144 + col0 + lane];
#pragma unroll
            for (int b4 = 0; b4 < 10; ++b4) { const f32x4 s = *(const LAS f32x4*)(slab + kk * 40 + 4 * b4);
                acc[4 * b4 + 0] += s[0] * wv; acc[4 * b4 + 1] += s[1] * wv; acc[4 * b4 + 2] += s[2] * wv; acc[4 * b4 + 3] += s[3] * wv; } }
        LDS_WAIT(); asm volatile("" ::: "memory");
    }
    __syncthreads();
    LAS float* red = (LAS float*)F.lds;
#pragma unroll
    for (int b = 0; b < 40; ++b) red[(w * 40 + b) * 64 + lane] = acc[b];
    __syncthreads();
    float* MODF = (float*)(F.ws + WS_MODF) + (size_t)layer * 40 * 6144;
    const float* bias = F.in[7] + (size_t)layer * 6144;
    for (int o = tid; o < 2560; o += 512) { const int b = o >> 6, l = o & 63; float s = bias[col0 + l];
#pragma unroll
        for (int ww = 0; ww < 8; ++ww) s += red[(ww * 40 + b) * 64 + l];
        MODF[(size_t)b * 6144 + col0 + l] = s; }
    __syncthreads();
}
__device__ __forceinline__ void cvt8(const float* src, bf16_t* dst) {
    const f32x4 a = *(const f32x4*)src, b = *(const f32x4*)(src + 4);
    u32x4 w; w.x = cvt_pk_bf16(a[0], a[1]); w.y = cvt_pk_bf16(a[2], a[3]); w.z = cvt_pk_bf16(b[0], b[1]); w.w = cvt_pk_bf16(b[2], b[3]);
    *(u32x4*)dst = w;
}
__device__ __forceinline__ void p0_phase(Frame& F) {
    LOCAL_IDS();
    for (int it = blockIdx.x; it < 192; it += F.G) ada_item(F, it);
    LAS float* scr = (LAS float*)(F.lds + wave * 8704);
    const int gw = blockIdx.x * 8 + wave, NGW = F.G * 8;
    unsigned char* ws = F.ws;
    constexpr int I_WIN = 16 * 22, I_WQ = 6 * 48, I_WUK = 4 * 32, I_WO = 16 * 32, I_W1 = 16 * 128, I_W2 = 64 * 32, I_CWIN = 16 * 64;
    constexpr int NITEMS = I_WIN + I_WQ + 2 * I_WUK + I_WO + 2 * I_W1 + 2 * I_W2 + I_CWIN + I_WO;
    for (int it = gw; it < NITEMS; it += NGW) {
        int r = it;
        if (r < I_WIN) { transpose_item(F.in[12], 1024, 704, (bf16_t*)(ws + WS_WIN), r, false, scr, lane); continue; } r -= I_WIN;
        if (r < I_WQ) { transpose_item(F.in[15], 384, 1536, (bf16_t*)(ws + WS_WQ), r, true, scr, lane); continue; } r -= I_WQ;
        if (r < I_WUK) { transpose_item(F.in[16], 256, 1024, (bf16_t*)(ws + WS_WUK), r, false, scr, lane); continue; } r -= I_WUK;
        if (r < I_WUK) { transpose_item(F.in[17], 256, 1024, (bf16_t*)(ws + WS_WUV), r, false, scr, lane); continue; } r -= I_WUK;
        if (r < I_WO) { transpose_item(F.in[22], 1024, 1024, (bf16_t*)(ws + WS_WO), r, false, scr, lane); continue; } r -= I_WO;
        if (r < 2 * I_W1) { const int l = r / I_W1; transpose_item(F.in[10] + (size_t)l * 1024 * 4096, 1024, 4096, (bf16_t*)(ws + WS_W1) + (size_t)l * 4096 * 1024, r % I_W1, false, scr, lane); continue; } r -= 2 * I_W1;
        if (r < 2 * I_W2) { const int l = r / I_W2; transpose_item(F.in[11] + (size_t)l * 1024 * 4096, 4096, 1024, (bf16_t*)(ws + WS_W2) + (size_t)l * 4096 * 1024, r % I_W2, false, scr, lane); continue; } r -= 2 * I_W2;
        if (r < I_CWIN) { transpose_item(F.in[23], 1024, 2048, (bf16_t*)(ws + WS_CWIN), r, false, scr, lane); continue; } r -= I_CWIN;
        transpose_item(F.in[27], 1024, 1024, (bf16_t*)(ws + WS_CWO), r, false, scr, lane);
    }
    const long gt = (long)blockIdx.x * 512 + tid, NT = (long)F.G * 512;
    { const float* src = F.in[2]; bf16_t* dst = (bf16_t*)(ws + WS_CKV) + (size_t)MT * 256;
      for (long i = gt; i < (long)NCACHE * 256 / 8; i += NT) cvt8(src + i * 8, dst + i * 8); }
    { const float* src = F.in[3]; bf16_t* dst = (bf16_t*)(ws + WS_KPE);
      for (long i = gt; i < (long)NCACHE * 64 / 8; i += NT) cvt8(src + i * 8, dst + i * 8); }
    { const float* src = F.in[16]; const float* gk = F.in[20]; bf16_t* dst = (bf16_t*)(ws + WS_WUKN);
      for (long i = gt; i < 256 * 1024 / 8; i += NT) { const int d = (int)(i * 8) & 127;
          const f32x4 a = *(const f32x4*)(src + i * 8) * *(const f32x4*)(gk + d), b = *(const f32x4*)(src + i * 8 + 4) * *(const f32x4*)(gk + d + 4);
          u32x4 w; w.x = cvt_pk_bf16(a[0], a[1]); w.y = cvt_pk_bf16(a[2], a[3]); w.z = cvt_pk_bf16(b[0], b[1]); w.w = cvt_pk_bf16(b[2], b[3]);
          *(u32x4*)(dst + i * 8) = w; } }
}

__device__ __forceinline__ void xb_load(const bf16_t* p, f32x4& v) { const u32x2 w = *(const u32x2*)p; v = (f32x4){bflo(w.x), bfhi(w.x), bflo(w.y), bfhi(w.y)}; }
__device__ __forceinline__ void tail_row(Frame& F, int row, int lane, const float* tgate, const float* tbase, f32x4 (&v)[4], bool to_out) {
    const float* P = (const float*)(F.ws + WS_PBUF) + (size_t)(row - MP) * DM;
    bf16_t* XB = (bf16_t*)(F.ws + WS_V);
    const float* gp = tgate + (size_t)row_seq(row) * 6144;
#pragma unroll
    for (int j = 0; j < 4; ++j) { const int c = 4 * lane + 256 * j; f32x4 s = *(const f32x4*)(P + c);
#pragma unroll
        for (int k = 1; k < KSPL; ++k) s += *(const f32x4*)(P + (size_t)k * MS * DM + c);
        f32x4 base; if (tbase) base = *(const f32x4*)(tbase + (size_t)(row - MP) * DM + c); else xb_load(XB + (size_t)row * DM + c, base);
        v[j] = base + *(const f32x4*)(gp + c) * s;
        if (to_out) *(f32x4*)(F.out + (size_t)row * DM + c) = v[j];
        else { u32x2 w; w.x = cvt_pk_bf16(v[j][0], v[j][1]); w.y = cvt_pk_bf16(v[j][2], v[j][3]); *(u32x2*)(XB + (size_t)row * DM + c) = w; } }
}
template <int SRC> __device__ __forceinline__ void modnorm_phase(Frame& F, int layer, int which, const float* tgate, const float* tbase) {
    LOCAL_IDS();
    const int gw = blockIdx.x * 8 + wave, NGW = F.G * 8;
    const float* g = (which ? F.in[9] : F.in[8]) + layer * DM;
    const float* MODF = (const float*)(F.ws + WS_MODF) + (size_t)layer * 40 * 6144;
    bf16_t* H = (bf16_t*)(F.ws + WS_H);
    for (int row = gw; row < MT; row += NGW) {
        const float* xr = SRC == 0 ? (row < MP ? F.in[0] + (size_t)row * DM : F.in[1] + (size_t)(row - MP) * DM) : F.out + (size_t)row * DM;
        const float* md = MODF + (size_t)row_seq(row) * 6144 + which * 3072;
        f32x4 v[4]; float ss = 0.f;
        if (tgate != nullptr && row >= MP) tail_row(F, row, lane, tgate, tbase, v, false);
        else {
#pragma unroll
            for (int j = 0; j < 4; ++j) { if (SRC == 0) v[j] = *(const f32x4*)(xr + 4 * lane + 256 * j); else xb_load((const bf16_t*)(F.ws + WS_V) + (size_t)row * DM + 4 * lane + 256 * j, v[j]); } }
#pragma unroll
        for (int j = 0; j < 4; ++j) ss += (v[j][0] * v[j][0] + v[j][1] * v[j][1]) + (v[j][2] * v[j][2] + v[j][3] * v[j][3]);
        const float rs = __builtin_amdgcn_rsqf(wave_sum(ss) * (1.f / DM) + EPS);
#pragma unroll
        for (int j = 0; j < 4; ++j) { const int c = 4 * lane + 256 * j;
            const f32x4 gg = *(const f32x4*)(g + c), sh = *(const f32x4*)(md + c), sc = *(const f32x4*)(md + 1024 + c);
            const f32x4 o = v[j] * rs * gg * (sc + 1.f) + sh;
            u32x2 w; w.x = cvt_pk_bf16(o[0], o[1]); w.y = cvt_pk_bf16(o[2], o[3]);
            *(u32x2*)(H + (size_t)row * DM + c) = w; }
    }
}
__device__ __forceinline__ void final_tail_phase(Frame& F, const float* tgate) {
    LOCAL_IDS();
    const int gw = blockIdx.x * 8 + wave, NGW = F.G * 8;
    for (int row = MP + gw; row < MT; row += NGW) { f32x4 v[4]; tail_row(F, row, lane, tgate, nullptr, v, true); }
}

__device__ __forceinline__ void latent_phase(Frame& F) {
    LOCAL_IDS();
    const int gw = blockIdx.x * 8 + wave, NGW = F.G * 8;
    const bf16_t* A0 = (const bf16_t*)(F.ws + WS_A0);
    bf16_t* CQ = (bf16_t*)(F.ws + WS_CQ); bf16_t* CKV = (bf16_t*)(F.ws + WS_CKV); bf16_t* KR = (bf16_t*)(F.ws + WS_KR);
    const float* gqa = F.in[13]; const float* gkva = F.in[14]; const float* gkr = F.in[21];
    const float inv = rope_inv(lane & 31);
    for (int row = gw; row < MT; row += NGW) {
        const bf16_t* a = A0 + (size_t)row * 768;
        f32x2 q[3]; float s1 = 0.f;
#pragma unroll
        for (int j = 0; j < 3; ++j) { const unsigned w = *(const unsigned*)(a + 2 * lane + 128 * j); q[j] = (f32x2){bflo(w), bfhi(w)}; s1 += q[j][0] * q[j][0] + q[j][1] * q[j][1]; }
        f32x4 kv; { const u32x2 w = *(const u32x2*)(a + 384 + 4 * lane); kv = (f32x4){bflo(w.x), bfhi(w.x), bflo(w.y), bfhi(w.y)}; }
        float s2 = (kv[0] * kv[0] + kv[1] * kv[1]) + (kv[2] * kv[2] + kv[3] * kv[3]);
        const float kr = bf2f(a[640 + lane]); float s3 = kr * kr;
        s1 = wave_sum(s1); s2 = wave_sum(s2); s3 = wave_sum(s3);
        const float r1 = __builtin_amdgcn_rsqf(s1 * (1.f / 384.f) + EPS), r2 = __builtin_amdgcn_rsqf(s2 * (1.f / 256.f) + EPS), r3 = __builtin_amdgcn_rsqf(s3 * (1.f / 64.f) + EPS);
#pragma unroll
        for (int j = 0; j < 3; ++j) { const int c = 2 * lane + 128 * j; const f32x2 gg = *(const f32x2*)(gqa + c);
            *(unsigned*)(CQ + (size_t)row * 384 + c) = cvt_pk_bf16(q[j][0] * r1 * gg[0], q[j][1] * r1 * gg[1]); }
        { const f32x4 gg = *(const f32x4*)(gkva + 4 * lane); const f32x4 o = kv * r2 * gg;
          float* op = row < MP ? F.out + OUT_CKVP + (size_t)row * 256 : F.out + OUT_CKVS + (size_t)(row - MP) * 256;
          *(f32x4*)(op + 4 * lane) = o;
          u32x2 w; w.x = cvt_pk_bf16(o[0], o[1]); w.y = cvt_pk_bf16(o[2], o[3]);
          *(u32x2*)(CKV + (size_t)row * 256 + 4 * lane) = w; }
        { const float y = kr * r3 * gkr[lane]; const auto yy = __builtin_amdgcn_permlane32_swap(__float_as_uint(y), __float_as_uint(y), false, false); const float yo = __uint_as_float(lane < 32 ? yy[1] : yy[0]);
          float sn, cs; sincos_rev((float)row_pos(row) * inv, sn, cs);
          const float o = lane < 32 ? y * cs - yo * sn : y * cs + yo * sn;
          float* op = row < MP ? F.out + OUT_KPEP + (size_t)row * 64 : F.out + OUT_KPES + (size_t)(row - MP) * 64;
          op[lane] = o; KR[(size_t)row * 64 + lane] = f2bf(o); }
    }
}

namespace att {
#define SBAR() __builtin_amdgcn_sched_barrier(0)
constexpr float THR = 8.f;
__device__ __forceinline__ int crow(int r, int hi) { return (r & 3) + 8 * (r >> 2) + 4 * hi; }
__device__ __forceinline__ void partialSM(f32x16& p0, f32x16& p1, float& m_reg, float& mn, float& alpha) {
    constexpr float C = SM_SCALE * 1.4426950408889634f;
    float pmax = p0[0];
#pragma unroll
    for (int r = 1; r < 16; ++r) pmax = fmaxf(pmax, p0[r]);
#pragma unroll
    for (int r = 0; r < 16; ++r) pmax = fmaxf(pmax, p1[r]);
    { auto rr = __builtin_amdgcn_permlane32_swap(__float_as_uint(pmax), __float_as_uint(pmax), false, false);
      pmax = fmaxf(__uint_as_float(rr[0]), __uint_as_float(rr[1])); }
    if (__builtin_expect(__all(pmax - m_reg <= THR / SM_SCALE), 1)) { mn = m_reg; alpha = 1.f; }
    else { mn = fmaxf(m_reg, pmax); alpha = __builtin_amdgcn_exp2f((m_reg - mn) * C); m_reg = mn; }
    const float mnC = -mn * C;
#pragma unroll
    for (int r = 0; r < 16; ++r) p0[r] = fmaf(p0[r], C, mnC);
#pragma unroll
    for (int r = 0; r < 16; ++r) p1[r] = fmaf(p1[r], C, mnC);
#pragma unroll
    for (int r = 0; r < 16; ++r) p0[r] = __builtin_amdgcn_exp2f(p0[r]);
}
__device__ __forceinline__ void finishSM(f32x16& p0, f32x16& p1, float alpha, float& l_reg, bf16x8& pa0, bf16x8& pa1, bf16x8& pa2, bf16x8& pa3) {
#pragma unroll
    for (int r = 0; r < 16; ++r) p1[r] = __builtin_amdgcn_exp2f(p1[r]);
    float ps = 0;
#pragma unroll
    for (int r = 0; r < 16; ++r) ps += p0[r];
#pragma unroll
    for (int r = 0; r < 16; ++r) ps += p1[r];
    { auto rr = __builtin_amdgcn_permlane32_swap(__float_as_uint(ps), __float_as_uint(ps), false, false);
      ps = __uint_as_float(rr[0]) + __uint_as_float(rr[1]); }
    l_reg = l_reg * alpha + ps;
#define PK4(P, BASE, OUT) do { unsigned a0 = cvt_pk_bf16(P[BASE + 0], P[BASE + 1]), a1 = cvt_pk_bf16(P[BASE + 2], P[BASE + 3]);   \
    unsigned b0 = cvt_pk_bf16(P[BASE + 4], P[BASE + 5]), b1 = cvt_pk_bf16(P[BASE + 6], P[BASE + 7]);                              \
    auto r0 = __builtin_amdgcn_permlane32_swap(a0, b0, false, false); auto r1 = __builtin_amdgcn_permlane32_swap(a1, b1, false, false); \
    u32x4 w = {r0[0], r1[0], r0[1], r1[1]}; OUT = *reinterpret_cast<bf16x8*>(&w); } while (0)
    PK4(p0, 0, pa0); PK4(p0, 8, pa1); PK4(p1, 0, pa2); PK4(p1, 8, pa3);
#undef PK4
}
__device__ __forceinline__ int v_st(int k, int c) { const int kk = (k & ~0xC) | ((k & 4) << 1) | ((k & 8) >> 1); return ((kk >> 3) * 4 + (c >> 5)) * 512 + ((kk & 7) * 32 + (c & 31)) * 2; }
__device__ __forceinline__ int v_rd_base(int lane) { return ((lane & 3) << 3) | (((lane >> 2) & 3) << 6) | (((lane >> 4) & 1) << 5) | (((lane >> 5) & 1) << 8); }
constexpr int v_rd_off(int d0, int ks, int half) { return d0 * 512 + ks * 4096 + half * 2048; }
template <int OFF> __device__ __forceinline__ s16x4 tr_read(int vb) {
    s16x4 r; asm volatile("ds_read_b64_tr_b16 %0, %1 offset:%2" : "=&v"(r) : "v"(vb), "i"(OFF) : "memory"); return r;
}
template <int D0> __device__ __forceinline__ void pv_one(f32x16& od, int vb, bf16x8 pa0, bf16x8 pa1, bf16x8 pa2, bf16x8 pa3) {
    const s16x4 l0 = tr_read<v_rd_off(D0, 0, 0)>(vb), h0 = tr_read<v_rd_off(D0, 0, 1)>(vb), l1 = tr_read<v_rd_off(D0, 1, 0)>(vb), h1 = tr_read<v_rd_off(D0, 1, 1)>(vb);
    const s16x4 l2 = tr_read<v_rd_off(D0, 2, 0)>(vb), h2 = tr_read<v_rd_off(D0, 2, 1)>(vb), l3 = tr_read<v_rd_off(D0, 3, 0)>(vb), h3 = tr_read<v_rd_off(D0, 3, 1)>(vb);
    asm volatile("s_waitcnt lgkmcnt(0)" ::: "memory"); SBAR();
#define PK(L, H) (bf16x8){L[0], L[1], L[2], L[3], H[0], H[1], H[2], H[3]}
    od = __builtin_amdgcn_mfma_f32_32x32x16_bf16(pa0, PK(l0, h0), od, 0, 0, 0);
    od = __builtin_amdgcn_mfma_f32_32x32x16_bf16(pa1, PK(l1, h1), od, 0, 0, 0);
    od = __builtin_amdgcn_mfma_f32_32x32x16_bf16(pa2, PK(l2, h2), od, 0, 0, 0);
    od = __builtin_amdgcn_mfma_f32_32x32x16_bf16(pa3, PK(l3, h3), od, 0, 0, 0);
#undef PK
}
__device__ __forceinline__ void pv_d0(f32x16* o, int vb, bf16x8 pa0, bf16x8 pa1, bf16x8 pa2, bf16x8 pa3) {
    pv_one<0>(o[0], vb, pa0, pa1, pa2, pa3); pv_one<1>(o[1], vb, pa0, pa1, pa2, pa3); pv_one<2>(o[2], vb, pa0, pa1, pa2, pa3); pv_one<3>(o[3], vb, pa0, pa1, pa2, pa3);
}

constexpr int P_SHM_V = 64 * 128 * 2, P_SHM_K = 64 * 192 * 2;
#define KSWZ192(row, colB) ((row) * 384 + ((colB) ^ (((row) & 7) << 4)))
__device__ __forceinline__ void qkt192(f32x16& p0, f32x16& p1, const LAS char* Ks, const int (&ka)[4], const bf16x8* qr, const LAS char* QRl, int hi, bool vis) {
    if (vis) {
        p0 = f32x16{}; p1 = f32x16{};
#pragma unroll
        for (int d0 = 0; d0 < 12; ++d0) {
            const bf16x8 b0 = *reinterpret_cast<const LAS bf16x8*>(Ks + ka[d0 & 3] + (d0 >> 2) * 128);
            const bf16x8 b1 = *reinterpret_cast<const LAS bf16x8*>(Ks + ka[d0 & 3] + (d0 >> 2) * 128 + 32 * 384);
            const bf16x8 qf = d0 < 8 ? qr[d0 < 8 ? d0 : 0] : *reinterpret_cast<const LAS bf16x8*>(QRl + ((d0 - 8) * 16 + hi * 8) * 2);
            p0 = __builtin_amdgcn_mfma_f32_32x32x16_bf16(b0, qf, p0, 0, 0, 0);
            p1 = __builtin_amdgcn_mfma_f32_32x32x16_bf16(b1, qf, p1, 0, 0, 0); }
    } else {
#pragma unroll
        for (int r = 0; r < 16; ++r) { p0[r] = -1e30f; p1[r] = -1e30f; }
    }
}
__device__ __forceinline__ void prompt_unit(int b, int h, int qb, const bf16_t* __restrict__ Q, const bf16_t* __restrict__ KN, const bf16_t* __restrict__ KR,
                                            const bf16_t* __restrict__ V, bf16_t* __restrict__ O, LAS char* lds) {
    int tid_l_ = threadIdx.x; asm volatile("" : "+v"(tid_l_));
    const int tid = tid_l_, wid = tid >> 6, lane = tid & 63, r32 = lane & 31, hi = lane >> 5;
    LAS char* V_lds = lds; LAS char* K_lds = lds + 2 * P_SHM_V;
    LAS float* wsc = (LAS float*)(lds + 2 * P_SHM_V + 2 * P_SHM_K) + wid * 64; LAS float* li_l = wsc; LAS float* al_l = wsc + 32;
    float m_reg = -1e30f, l_reg = 0; f32x16 o[4] = {}; bf16x8 qr[8];
    LAS char* QRl = lds + 2 * P_SHM_V + 2 * P_SHM_K + 2048 + wid * 4608 + r32 * 144;
    const size_t rowbase = (size_t)b * SEQ;
    const bf16_t* Qw = Q + (rowbase + qb * 256 + wid * 32 + r32) * 1536 + h * 192 + hi * 8;
#pragma unroll
    for (int d0 = 0; d0 < 8; ++d0) qr[d0] = *reinterpret_cast<const bf16x8*>(Qw + d0 * 16);
#pragma unroll
    for (int d0 = 8; d0 < 12; ++d0) *reinterpret_cast<LAS bf16x8*>(QRl + ((d0 - 8) * 16 + hi * 8) * 2) = *reinterpret_cast<const bf16x8*>(Qw + d0 * 16);
    int ka[4];
#pragma unroll
    for (int k = 0; k < 4; ++k) ka[k] = r32 * 384 + ((k * 32 + hi * 16) ^ ((r32 & 7) << 4));
    const int cw = 4 * qb + (wid >> 1);
    const int sr = tid >> 4, sc = (tid & 15) * 8, vst0 = v_st(sr, sc), vst1 = v_st(32 + sr, sc), krr = tid >> 3, krc = (tid & 7) * 8;
    const int vb0 = (int)(uintptr_t)V_lds + v_rd_base(lane);
    const bf16_t* Vh = V + rowbase * 1024 + h * 128; const bf16_t* Kh = KN + rowbase * 1024 + h * 128; const bf16_t* Rh = KR + rowbase * 64;
    struct { bf16x8 vs0, vs1, ks0, ks1, kr; } sr_[1];
#define SLOAD(i, k0) do { sr_[i].vs0 = *reinterpret_cast<const bf16x8*>(&Vh[(size_t)((k0) + sr) * 1024 + sc]); sr_[i].vs1 = *reinterpret_cast<const bf16x8*>(&Vh[(size_t)((k0) + 32 + sr) * 1024 + sc]); \
    sr_[i].ks0 = *reinterpret_cast<const bf16x8*>(&Kh[(size_t)((k0) + sr) * 1024 + sc]); sr_[i].ks1 = *reinterpret_cast<const bf16x8*>(&Kh[(size_t)((k0) + 32 + sr) * 1024 + sc]); \
    sr_[i].kr = *reinterpret_cast<const bf16x8*>(&Rh[(size_t)((k0) + krr) * 64 + krc]); } while (0)
#define SWRITE(bb, i) do { *(LAS bf16x8*)(V_lds + (bb) * P_SHM_V + vst0) = sr_[i].vs0; *(LAS bf16x8*)(V_lds + (bb) * P_SHM_V + vst1) = sr_[i].vs1; const int kc = sc * 2; \
    *(LAS bf16x8*)(K_lds + (bb) * P_SHM_K + KSWZ192(sr, kc)) = sr_[i].ks0; *(LAS bf16x8*)(K_lds + (bb) * P_SHM_K + KSWZ192(32 + sr, kc)) = sr_[i].ks1; \
    *(LAS bf16x8*)(K_lds + (bb) * P_SHM_K + KSWZ192(krr, 256 + krc * 2)) = sr_[i].kr; } while (0)
#define SWAIT() asm volatile("s_waitcnt vmcnt(0)" ::: "memory")
#define RESC(a) do { if (__any((a) < 1.f)) { if (hi == 0) al_l[r32] = (a); asm volatile("s_waitcnt lgkmcnt(0)" ::: "memory"); \
    _Pragma("unroll") for (int d = 0; d < 4; ++d) _Pragma("unroll") for (int r = 0; r < 16; ++r) o[d][r] *= al_l[crow(r, hi)]; } } while (0)
    f32x16 pA0, pA1, pB0, pB1; float mnA, mnB, alA, alB; bf16x8 pa0, pa1, pa2, pa3; const int NT = 4 * qb + 4;
    constexpr int SE = 0, SO = 0;
    SLOAD(SE, 0); asm volatile("s_waitcnt vmcnt(0)" ::: "memory"); SWRITE(0, SE); __syncthreads();
    qkt192(pA0, pA1, K_lds, ka, qr, QRl, hi, true); partialSM(pA0, pA1, m_reg, mnA, alA);
    SLOAD(SO, 64);
    SWAIT(); SWRITE(1, SO); __syncthreads();
    for (int j = 1; j + 1 < NT; j += 2) {
        SBAR(); qkt192(pB0, pB1, K_lds + P_SHM_K, ka, qr, QRl, hi, j <= cw);
        finishSM(pA0, pA1, alA, l_reg, pa0, pa1, pa2, pa3); SBAR();
        SLOAD(SO, (j + 1) * 64); SBAR();
        if (j - 1 <= cw) pv_d0(o, vb0, pa0, pa1, pa2, pa3);
        partialSM(pB0, pB1, m_reg, mnB, alB);
        __syncthreads(); SWAIT(); SWRITE(0, SE);
        RESC(alB); __syncthreads();
        SBAR(); qkt192(pA0, pA1, K_lds, ka, qr, QRl, hi, j + 1 <= cw);
        finishSM(pB0, pB1, alB, l_reg, pa0, pa1, pa2, pa3); SBAR();
        SLOAD(SE, (j + 2) * 64); SBAR();
        if (j <= cw) pv_d0(o, vb0 + P_SHM_V, pa0, pa1, pa2, pa3);
        partialSM(pA0, pA1, m_reg, mnA, alA);
        __syncthreads(); SWAIT(); SWRITE(1, SO);
        RESC(alA); __syncthreads();
    }
    SBAR(); qkt192(pB0, pB1, K_lds + P_SHM_K, ka, qr, QRl, hi, NT - 1 <= cw);
    finishSM(pA0, pA1, alA, l_reg, pa0, pa1, pa2, pa3); SBAR();
    if (NT - 2 <= cw) pv_d0(o, vb0, pa0, pa1, pa2, pa3);
    partialSM(pB0, pB1, m_reg, mnB, alB);
    __syncthreads(); RESC(alB);
    finishSM(pB0, pB1, alB, l_reg, pa0, pa1, pa2, pa3); SBAR();
    if (NT - 1 <= cw) pv_d0(o, vb0 + P_SHM_V, pa0, pa1, pa2, pa3);
    if (hi == 0) li_l[r32] = l_reg; asm volatile("s_waitcnt lgkmcnt(0)" ::: "memory");
    float rli[16];
#pragma unroll
    for (int r = 0; r < 16; ++r) rli[r] = __builtin_amdgcn_rcpf(li_l[crow(r, hi)]);
    bf16_t* Ow = O + (rowbase + qb * 256 + wid * 32) * 1024 + h * 128;
#pragma unroll
    for (int r = 0; r < 16; ++r) { const int orow = crow(r, hi);
#pragma unroll
        for (int d0 = 0; d0 < 4; ++d0) Ow[(size_t)orow * 1024 + d0 * 32 + r32] = f2bf(o[d0][r] * rli[r]); }
    __syncthreads();
#undef SLOAD
#undef SWRITE
#undef SWAIT
#undef RESC
}

constexpr int S_QP = 264;
constexpr int S_OFF_Q = 0, S_OFF_K = 8 * 16 * S_QP * 2  , S_OFF_V = S_OFF_K + 64 * 640  , S_OFF_RS = S_OFF_V + 32768, S_OFF_SC = S_OFF_RS + 2048  , S_END = S_OFF_SC + 2048;
static_assert(S_END <= LDS_MISC, "sample LDS map");
#define KSWZ320(row, colB) ((row) * 640 + ((colB) ^ (((row) & 7) << 4)))
__device__ __forceinline__ void sample_unit(int sb, int sp, const bf16_t* __restrict__ Q, const bf16_t* __restrict__ WUKN, const bf16_t* __restrict__ CKV, const bf16_t* __restrict__ KPE,
                                            const bf16_t* __restrict__ KR, const float* __restrict__ RS, float* __restrict__ PART, float* __restrict__ ML, LAS char* lds) {
    int tid_l_ = threadIdx.x; asm volatile("" : "+v"(tid_l_));
    const int tid = tid_l_, h = tid >> 6, lane = tid & 63, r32 = lane & 31, hi = lane >> 5, q16 = r32 & 15;
    LAS char* Q_lds = lds + S_OFF_Q + h * (16 * S_QP * 2); LAS char* K_lds = lds + S_OFF_K; LAS char* V_lds = lds + S_OFF_V;
    LAS float* rs_lds = (LAS float*)(lds + S_OFF_RS); LAS float* al_l = (LAS float*)(lds + S_OFF_SC) + h * 64;
    const size_t qrow = (size_t)MP + sb * 16 + q16;
    {
        bf16x8 qa[8];
#pragma unroll
        for (int ks = 0; ks < 8; ++ks) qa[ks] = *reinterpret_cast<const bf16x8*>(Q + qrow * 1536 + h * 192 + ks * 16 + hi * 8);
        LAS char* qw = Q_lds + ((4 * hi) * S_QP + r32) * 2;
        const bf16_t* wp = WUKN + (size_t)r32 * 1024 + h * 128 + hi * 8;
#pragma unroll 1
        for (int nb = 0; nb < 8; ++nb) {
            f32x16 acc = {};
#pragma unroll
            for (int ks = 0; ks < 8; ++ks) { const bf16x8 wb = *reinterpret_cast<const bf16x8*>(wp + ks * 16);
                acc = __builtin_amdgcn_mfma_f32_32x32x16_bf16(qa[ks], wb, acc, 0, 0, 0); }
#pragma unroll
            for (int r = 0; r < 8; ++r) *(LAS bf16_t*)(qw + (((r & 3) + 8 * (r >> 2)) * S_QP) * 2) = f2bf(acc[r]);
            qw += 64; wp += 32 * 1024;
        }
    }
    __syncthreads();
    const int hp = h & 3, vh = h >> 2, hl = 2 * hp + (r32 >> 4);
    bf16x8 qrp[4];
#pragma unroll
    for (int d0 = 0; d0 < 4; ++d0) qrp[d0] = *reinterpret_cast<const bf16x8*>(Q + qrow * 1536 + hl * 192 + 128 + d0 * 16 + hi * 8);
    float m_reg = -1e30f, l_reg = 0; f32x16 o[4] = {};
    const int vb0 = (int)(uintptr_t)V_lds + vh * 16384 + v_rd_base(lane);
    const int ntile = (sp == NSPLIT - 1) ? 17 : 16;
    const int krr = tid >> 3, krc = (tid & 7) * 8;
    const int skey = tid >> 5, cc = (tid & 31) * 8;
    LAS char* kst = K_lds + skey * 640 + ((cc * 2) ^ ((skey & 7) << 4));
    LAS char* vst = V_lds + (cc >> 7) * 16384 + v_st(skey, cc & 127);
    LAS char* krst = K_lds + krr * 640 + ((512 + krc * 2) ^ ((krr & 7) << 4));
    int ka[4];
#pragma unroll
    for (int k = 0; k < 4; ++k) ka[k] = r32 * 640 + ((k * 32 + hi * 16) ^ ((r32 & 7) << 4));
    const LAS char* qfp = lds + S_OFF_Q + hl * (16 * S_QP * 2) + (q16 * S_QP + hi * 8) * 2;
    const LAS float* rsp = rs_lds + (4 * hi) * 8 + hl;
    bf16x8 c[4], kr; float rsv;
#define S_LOAD(T) do { const bool nw_ = ((T) == 16); \
        const size_t crow0 = nw_ ? (size_t)MP + sb * 16 : (size_t)MT + (size_t)sb * PAST + sp * 1024 + (T) * 64; \
        const bf16_t* rsrc = nw_ ? KR + ((size_t)MP + sb * 16) * 64 : KPE + ((size_t)sb * PAST + sp * 1024 + (T) * 64) * 64; \
        _Pragma("unroll") for (int i = 0; i < 4; ++i) { const int key = skey + 16 * i; \
            c[i] = (!nw_ || key < 16) ? *reinterpret_cast<const bf16x8*>(CKV + (crow0 + key) * 256 + cc) : bf16x8{}; } \
        kr = (!nw_ || krr < 16) ? *reinterpret_cast<const bf16x8*>(rsrc + (size_t)krr * 64 + krc) : bf16x8{}; \
        rsv = (!nw_ || krr < 16) ? RS[(crow0 + krr) * 8 + (tid & 7)] : 0.f; } while (0)
    S_LOAD(0);
#pragma unroll 1
    for (int t = 0; t < ntile; ++t) {
        const bool isnew = (t == 16);
        __syncthreads();
#pragma unroll
        for (int i = 0; i < 4; ++i) { *(LAS bf16x8*)(kst + i * 16 * 640) = c[i];
            *(LAS bf16x8*)(vst + i * 4096) = c[i]; }
        *(LAS bf16x8*)krst = kr;
        rs_lds[krr * 8 + (tid & 7)] = rsv;
        __syncthreads();
        if (t + 1 < ntile) S_LOAD(t + 1);
        SBAR();
        f32x16 p0 = {}, p1 = {};
#pragma unroll
        for (int d0 = 0; d0 < 16; ++d0) { if ((d0 & 3) == 0) SBAR();
            const bf16x8 b0 = *reinterpret_cast<const LAS bf16x8*>(K_lds + ka[d0 & 3] + (d0 >> 2) * 128);
            const bf16x8 b1 = *reinterpret_cast<const LAS bf16x8*>(K_lds + ka[d0 & 3] + (d0 >> 2) * 128 + 32 * 640);
            const bf16x8 qf = *reinterpret_cast<const LAS bf16x8*>(qfp + d0 * 32);
            p0 = __builtin_amdgcn_mfma_f32_32x32x16_bf16(b0, qf, p0, 0, 0, 0);
            p1 = __builtin_amdgcn_mfma_f32_32x32x16_bf16(b1, qf, p1, 0, 0, 0); }
        SBAR();
#pragma unroll
        for (int r = 0; r < 16; ++r) { p0[r] *= rsp[((r & 3) + 8 * (r >> 2)) * 8]; p1[r] *= rsp[(32 + (r & 3) + 8 * (r >> 2)) * 8]; }
#pragma unroll
        for (int d0 = 0; d0 < 4; ++d0) {
            const bf16x8 b0 = *reinterpret_cast<const LAS bf16x8*>(K_lds + ka[d0] + 512);
            const bf16x8 b1 = *reinterpret_cast<const LAS bf16x8*>(K_lds + ka[d0] + 512 + 32 * 640);
            p0 = __builtin_amdgcn_mfma_f32_32x32x16_bf16(b0, qrp[d0], p0, 0, 0, 0);
            p1 = __builtin_amdgcn_mfma_f32_32x32x16_bf16(b1, qrp[d0], p1, 0, 0, 0); }
        if (isnew) {
#pragma unroll
            for (int r = 0; r < 16; ++r) { if (r >= 8) p0[r] = -1e30f; p1[r] = -1e30f; }
        }
        float mn, al; bf16x8 pa0, pa1, pa2, pa3;
        partialSM(p0, p1, m_reg, mn, al);
        finishSM(p0, p1, al, l_reg, pa0, pa1, pa2, pa3);
        if (__any(al < 1.f)) { if (hi == 0) al_l[r32] = al; asm volatile("s_waitcnt lgkmcnt(0)" ::: "memory");
#pragma unroll
            for (int d = 0; d < 4; ++d)
#pragma unroll
                for (int r = 0; r < 16; ++r) o[d][r] *= al_l[crow(r, hi)]; }
        pv_d0(o, vb0, pa0, pa1, pa2, pa3);
    }
    const size_t ubase = ((size_t)sb * NSPLIT + sp) * 8;
    if (vh == 0 && lane < 32) { const size_t pb = (ubase + hl) * 16 + q16; ML[pb * 2] = m_reg; ML[pb * 2 + 1] = l_reg; }
#pragma unroll
    for (int r = 0; r < 16; ++r) { const int row = crow(r, hi); const size_t pb = (ubase + 2 * hp + (row >> 4)) * 16 + (row & 15);
#pragma unroll
        for (int d = 0; d < 4; ++d) PART[pb * 256 + vh * 128 + d * 32 + r32] = o[d][r]; }
    __syncthreads();
#undef S_LOAD
}
}

__device__ __forceinline__ void attention_phase(Frame& F, unsigned* ctr, bool ctr_is_second = false) {
    LOCAL_IDS();
    volatile LAS unsigned* misc = (volatile LAS unsigned*)(F.lds + LDS_MISC);
    const bf16_t* Q = (const bf16_t*)(F.ws + WS_A0); const bf16_t* KN = (const bf16_t*)(F.ws + WS_KN); const bf16_t* KR = (const bf16_t*)(F.ws + WS_KR);
    const bf16_t* V = (const bf16_t*)(F.ws + WS_V); bf16_t* O = (bf16_t*)(F.ws + WS_H);
    constexpr int NSU = NB_S * NSPLIT, NPU = NB_P * NH * 16;
    for (;;) {
        __syncthreads();
        if (tid == 0) misc[0] = atomicAdd(ctr, 1u);
        __syncthreads();
        const int unit = (int)misc[0];
#ifdef REP_SAMPLE_ONLY
        if (unit >= (ctr_is_second ? NSU : NSU + NPU)) break;
#else
        if (unit >= NSU + NPU) break;
#endif
        if (unit < NSU) {
#ifndef NO_SAMPLE
            att::sample_unit(unit >> 2, unit & 3, Q, (const bf16_t*)(F.ws + WS_WUKN), (const bf16_t*)(F.ws + WS_CKV), (const bf16_t*)(F.ws + WS_KPE), KR,
                             (const float*)(F.ws + WS_RS), (float*)(F.ws + WS_PART), (float*)(F.ws + WS_ML), (LAS char*)F.lds);
#endif
        } else {
#ifndef NO_PROMPT
#ifdef ORDER_BH
            const int pu = unit - NSU, qb = 15 - (pu & 15), bh = pu >> 4;
#else
            const int pu = unit - NSU, qb = 15 - pu / 64, bh = pu % 64;
#endif
            att::prompt_unit(bh >> 3, bh & 7, qb, Q, KN, KR, V, O, (LAS char*)F.lds);
#endif
        }
    }
}

__device__ __forceinline__ void combine_phase(Frame& F) {
    LOCAL_IDS();
    const int gw = blockIdx.x * 8 + wave, NGW = F.G * 8;
    LAS float* ol = (LAS float*)(F.lds + wave * 16384);
    const float* PART = (const float*)(F.ws + WS_PART); const float* ML = (const float*)(F.ws + WS_ML); const float* wuv = F.in[17];
    bf16_t* O = (bf16_t*)(F.ws + WS_H);
    constexpr float C = SM_SCALE * 1.4426950408889634f;
    for (int item = gw; item < NB_S * NH; item += NGW) {
        const int sb = item >> 3, h = item & 7;
        for (int q = 0; q < 16; ++q) {
            float m[NSPLIT], l[NSPLIT], mx = -1e30f;
#pragma unroll
            for (int s = 0; s < NSPLIT; ++s) { const size_t pb = ((((size_t)sb * NSPLIT + s) * 8 + h) * 16 + q); m[s] = ML[pb * 2]; l[s] = ML[pb * 2 + 1]; mx = fmaxf(mx, m[s]); }
            float L = 0.f; f32x4 acc = {0.f, 0.f, 0.f, 0.f};
#pragma unroll
            for (int s = 0; s < NSPLIT; ++s) { const size_t pb = ((((size_t)sb * NSPLIT + s) * 8 + h) * 16 + q); const float f = __builtin_amdgcn_exp2f((m[s] - mx) * C);
                L += f * l[s]; acc += *(const f32x4*)(PART + pb * 256 + 4 * lane) * f; }
#ifdef E1_TEST
            *(LAS f32x4*)(ol + q * 256 + 4 * lane) = (f32x4){0.001f * (q + lane), 0.002f, 0.003f * sb, 0.004f * h};
#else
            *(LAS f32x4*)(ol + q * 256 + 4 * lane) = acc * (1.f / L);
#endif
        }
        LDS_WAIT(); asm volatile("" ::: "memory");
        float a0[16], a1[16];
#pragma unroll
        for (int q = 0; q < 16; ++q) { a0[q] = 0.f; a1[q] = 0.f; }
        for (int l4 = 0; l4 < 64; ++l4) {
            float w0[4], w1[4];
#pragma unroll
            for (int t = 0; t < 4; ++t) { w0[t] = wuv[(size_t)(4 * l4 + t) * 1024 + h * 128 + lane]; w1[t] = wuv[(size_t)(4 * l4 + t) * 1024 + h * 128 + 64 + lane]; }
#pragma unroll
            for (int q = 0; q < 16; ++q) { const f32x4 x = *(const LAS f32x4*)(ol + q * 256 + 4 * l4);
                a0[q] += x[0] * w0[0] + x[1] * w0[1] + x[2] * w0[2] + x[3] * w0[3]; a1[q] += x[0] * w1[0] + x[1] * w1[1] + x[2] * w1[2] + x[3] * w1[3]; }
        }
#pragma unroll
        for (int q = 0; q < 16; ++q) { bf16_t* op = O + ((size_t)MP + sb * 16 + q) * 1024 + h * 128; op[lane] = f2bf(a0[q]); op[64 + lane] = f2bf(a1[q]); }
        LDS_WAIT(); asm volatile("" ::: "memory");
    }
}

__device__ __forceinline__ void sgu_phase(Frame& F) {
    LOCAL_IDS();
    const int wid = wave, r32 = lane & 31, hi = lane >> 5;
    LAS float* rsv_l = (LAS float*)F.lds;
    const bf16_t* VT = (const bf16_t*)(F.ws + WS_VT); const bf16_t* U = (const bf16_t*)(F.ws + WS_U); bf16_t* Gt = (bf16_t*)(F.ws + WS_G);
    const float* SSV = (const float*)(F.ws + WS_SSV); const float* ws_ = F.in[25]; const float* bs = F.in[26]; const float* gv = F.in[24];
    const int mb = wid & 3, nb0 = (wid >> 2) * 2;
    for (int unit = blockIdx.x; unit < 288 * 8; unit += F.G) {
        const int ch = unit >> 3, g = unit & 7; const bool smp = ch >= 256;
        const int tok0 = smp ? MP + (ch - 256) * 16 : ch * 128, ntok = smp ? 16 : 128;
        const bool active = !smp || mb == 0;
        const int ksteps = smp ? 1 : (mb < 2 ? 4 : 8);
        float ssp[8];
        if (tid < 128) {
#pragma unroll
            for (int p = 0; p < 8; ++p) ssp[p] = (tid < ntok) ? SSV[(size_t)p * VTP + tok0 + tid] : 0.f; }
        bf16x8 b0[8], b1[8]; bf16_t uv0[16], uv1[16];
        const int c0 = g * 128 + nb0 * 32 + r32;
        const float* wrow = ws_ + (size_t)g * 16384 + (size_t)(32 * mb + r32) * 128 + hi * 8;
        if (active) {
            const bf16_t* v0p = VT + (size_t)c0 * VTP + tok0 + hi * 8; const bf16_t* v1p = v0p + (size_t)32 * VTP;
#pragma unroll
            for (int ks = 0; ks < 8; ++ks) if (ks < ksteps) {
                b0[ks] = *reinterpret_cast<const bf16x8*>(v0p + ks * 16); b1[ks] = *reinterpret_cast<const bf16x8*>(v1p + ks * 16); }
        }
        if (tid < 128) { float s = ((ssp[0] + ssp[1]) + (ssp[2] + ssp[3])) + ((ssp[4] + ssp[5]) + (ssp[6] + ssp[7]));
            rsv_l[tid] = (tid < ntok) ? __builtin_amdgcn_rsqf(s * (1.f / 1024.f) + EPS) : 0.f; }
        __syncthreads();
        if (active) {
#pragma unroll
            for (int r = 0; r < 16; ++r) { const int i = 32 * mb + att::crow(r, hi);
                if (i < ntok) { const size_t tok = (size_t)tok0 + i; uv0[r] = U[tok * 1024 + c0]; uv1[r] = U[tok * 1024 + c0 + 32]; } }
            f32x16 acc0 = {}, acc1 = {};
#pragma unroll
            for (int ks = 0; ks < 8; ++ks) if (ks < ksteps) { const int j0 = ks * 16 + hi * 8;
                const f32x4 ra = *(const LAS f32x4*)(rsv_l + j0), rb = *(const LAS f32x4*)(rsv_l + j0 + 4);
                const f32x4 xa = *(const f32x4*)(wrow + ks * 16) * ra, xb = *(const f32x4*)(wrow + ks * 16 + 4) * rb;
                u32x4 aw; aw.x = cvt_pk_bf16(xa[0], xa[1]); aw.y = cvt_pk_bf16(xa[2], xa[3]); aw.z = cvt_pk_bf16(xb[0], xb[1]); aw.w = cvt_pk_bf16(xb[2], xb[3]);
                const bf16x8 af = *reinterpret_cast<bf16x8*>(&aw);
                acc0 = __builtin_amdgcn_mfma_f32_32x32x16_bf16(af, b0[ks], acc0, 0, 0, 0);
                acc1 = __builtin_amdgcn_mfma_f32_32x32x16_bf16(af, b1[ks], acc1, 0, 0, 0); }
            const float g0 = gv[c0], g1 = gv[c0 + 32];
#pragma unroll
            for (int r = 0; r < 16; ++r) { const int i = 32 * mb + att::crow(r, hi);
                if (i < ntok) { const size_t tok = (size_t)tok0 + i; const float bias = bs[g * 128 + i];
                    Gt[tok * 1024 + c0] = f2bf(bf2f(uv0[r]) * (acc0[r] * g0 + bias));
                    Gt[tok * 1024 + c0 + 32] = f2bf(bf2f(uv1[r]) * (acc1[r] * g1 + bias)); } }
        }
        if (smp) {
            for (int idx = tid; idx < 2048; idx += 512) { const int t = idx >> 7, c = g * 128 + (idx & 127);
                F.out[OUT_VS + (size_t)((ch - 256) * 16 + t) * 1024 + c] = bf2f(VT[(size_t)c * VTP + tok0 + t]) * rsv_l[t] * gv[c]; }
        }
        __syncthreads();
    }
}

#define XB_TMO      128
#define XB_XCNT(j)  (256  + 64 * (j))
#define XB_XSUB(j)  (1280 + 64 * (j))
#define XB_XGEN(j)  (2304 + 64 * (j))
#define XB_TOP      3328
#define XB_TOPGEN   3392
#define XCD_BAR_WORDS 3456
#define XB_SPIN_CAP (1u << 18)

__device__ __forceinline__ unsigned xb_ld(unsigned* p)              { return __hip_atomic_load(p, __ATOMIC_RELAXED, __HIP_MEMORY_SCOPE_AGENT); }
__device__ __forceinline__ unsigned xb_add(unsigned* p, unsigned v) { return __hip_atomic_fetch_add(p, v, __ATOMIC_RELAXED, __HIP_MEMORY_SCOPE_AGENT); }
__device__ __forceinline__ unsigned xb_xcc_id() { return (unsigned)__builtin_amdgcn_s_getreg((3 << 11) | 20) & 0xFu; }
#define XB_SPIN(cond, bar) do { unsigned _sp = 0; while (cond) { __builtin_amdgcn_s_sleep(1); \
    if ((++_sp & 255u) == 0u) { if (xb_ld(&(bar)[XB_TMO])) break; if (_sp > XB_SPIN_CAP) { atomicAdd(&(bar)[XB_TMO], 1u); break; } } } } while (0)

struct XcdBarrier {
    unsigned* bar; unsigned x;
    volatile LAS unsigned* st;
};

__device__ __forceinline__ XcdBarrier xcd_barrier_post(unsigned* bar, volatile LAS unsigned* st) {
    XcdBarrier b; b.bar = bar; b.x = xb_xcc_id(); b.st = st;
    if (threadIdx.x == 0) (void)xb_add(&bar[XB_XCNT(b.x)], 1u);
    return b;
}
__device__ __forceinline__ void xcd_barrier_complete(unsigned* bar, unsigned x, unsigned& nloc, unsigned& nx) {
    const unsigned G = gridDim.x * gridDim.y * gridDim.z;
    unsigned sum, cnt, mine, sp = 0u;
    for (;;) {
        sum = 0u; cnt = 0u; mine = 0u;
#pragma unroll
        for (unsigned j = 0; j < 16; ++j) { const unsigned c = xb_ld(&bar[XB_XCNT(j)]); sum += c; cnt += (c > 0u) ? 1u : 0u; mine = (j == x) ? c : mine; }
        if (sum == G) break;
        __builtin_amdgcn_s_sleep(1);
        if ((++sp & 255u) == 0u) { if (xb_ld(&bar[XB_TMO])) break; if (sp > XB_SPIN_CAP) { atomicAdd(&bar[XB_TMO], 1u); break; } }
    }
    nloc = mine > 0u ? mine : 1u; nx = cnt > 0u ? cnt : 1u;
}

__device__ __forceinline__ void xcd_barrier(const XcdBarrier& b) {
    asm volatile("s_waitcnt vmcnt(0)" ::: "memory");
    __syncthreads();
    if (threadIdx.x == 0) {
        unsigned* bar = b.bar;
        __builtin_amdgcn_s_waitcnt(0);
        unsigned nloc = b.st[0], nx = b.st[1];
        if (nloc == 0u) { xcd_barrier_complete(bar, b.x, nloc, nx); b.st[0] = nloc; b.st[1] = nx; }
        const unsigned old = xb_add(&bar[XB_XSUB(b.x)], 1u);
        const unsigned gen = old / nloc;
        if (old + 1u == (gen + 1u) * nloc) {
            __builtin_amdgcn_fence(__ATOMIC_RELEASE, "agent");
            asm volatile("s_waitcnt vmcnt(0)" ::: "memory");
            const unsigned og = xb_add(&bar[XB_TOP], 1u);
            const unsigned tg = og / nx;
            if (og + 1u == (tg + 1u) * nx) xb_add(&bar[XB_TOPGEN], 1u);
            else XB_SPIN(xb_ld(&bar[XB_TOPGEN]) == tg, bar);
            __builtin_amdgcn_fence(__ATOMIC_ACQUIRE, "agent");
            xb_add(&bar[XB_XGEN(b.x)], 1u);
            asm volatile("s_waitcnt vmcnt(0)" ::: "memory");
        } else {
            XB_SPIN(xb_ld(&bar[XB_XGEN(b.x)]) == gen, bar);
            __builtin_amdgcn_fence(__ATOMIC_ACQUIRE, "agent");
            asm volatile("s_waitcnt vmcnt(0)" ::: "memory");
        }
    }
    __syncthreads();
}

typedef EpiResidB<true, false> RB_TF; typedef EpiResidB<false, false> RB_FF; typedef EpiResidB<false, true> RB_FT;
constexpr int N_PHASES = 19;
__global__ void __launch_bounds__(512, 2) fwd_megakernel(Args args) {
    extern __shared__ __attribute__((aligned(16))) unsigned char lds_raw[];
    cg::grid_group grid = cg::this_grid();
    Frame F;
    F.lds = (LAS unsigned char*)lds_raw;
    F.G = gridDim.x;
    F.in = args.in; F.out = args.out; F.ws = args.ws;
    unsigned char* ws = args.ws;
    const int lo = args.ph_lo, hi = args.ph_hi;
    { volatile LAS unsigned* st = (volatile LAS unsigned*)(F.lds + LDS_MISC + 16); if (threadIdx.x < 2) st[threadIdx.x] = 0u; __syncthreads(); }
    XcdBarrier xbar = xcd_barrier_post((unsigned*)(ws + WS_CTL + 4096), (volatile LAS unsigned*)(F.lds + LDS_MISC + 16));
    LAS float* red = (LAS float*)(F.lds + LDS_RED);
    const float* MODF = (const float*)(ws + WS_MODF);
#ifndef PHASE_MASK
#define PHASE_MASK 0xFFFFFFFFu
#endif
#define PH(k) ((((PHASE_MASK) >> (k)) & 1u) && lo <= (k) && (k) < hi)
#ifndef REPEAT_MASK
#define REPEAT_MASK 0u
#endif
#define REP(k) for (int rep_ = 0; rep_ < 1 + (int)(((REPEAT_MASK) >> (k)) & 1u); ++rep_)
#define SEAM(k) do { if (PH(k) && PH((k) + 1)) { if ((k) == 0) { \
        asm volatile("s_waitcnt vmcnt(0) lgkmcnt(0)" ::: "memory"); __syncthreads(); \
        if (threadIdx.x == 0) { __builtin_amdgcn_fence(__ATOMIC_RELEASE, "agent"); asm volatile("s_waitcnt vmcnt(0)" ::: "memory"); } \
        grid.sync(); \
        if (threadIdx.x == 0) { __builtin_amdgcn_fence(__ATOMIC_ACQUIRE, "agent"); asm volatile("s_waitcnt vmcnt(0)" ::: "memory"); } \
        __syncthreads(); } else xcd_barrier(xbar); } } while (0)
#define GEMM(EPI, A_, B_, M_, N_, K_, E_) do { int k_ = (K_); asm volatile("" : "+s"(k_)); pg8::Gemm g_{(const bf16_t*)(A_), (const bf16_t*)(B_), (M_), (N_), k_, k_}; pg8::StaticOrder S_; S_.init((M_), (N_), F.G, (int)((blockIdx.x + gemm_rot_) % F.G)); \
        pg8::gemm_phase<EPI, pg8::StaticOrder, true, true>(F.lds, g_, S_, (E_)); } while (0)

#define GEMM_TAIL(A_, B_, KFULL_) do { int k_ = (KFULL_) / KSPL; asm volatile("" : "+s"(k_)); pg8::Gemm g_{(const bf16_t*)(A_), (const bf16_t*)(B_), MS, 1024, k_, (KFULL_)}; pg8::TailOrder S_; S_.init(MS, 1024, KSPL, F.G, (int)blockIdx.x); \
        EpiPart E_{(float*)(ws + WS_PBUF)}; pg8::gemm_phase<EpiPart, pg8::TailOrder, true, true>(F.lds, g_, S_, E_); } while (0)
    int gemm_rot_ = 0;
    if (PH(0)) REP(0) p0_phase(F);
    SEAM(0);
    if (PH(1)) REP(1) modnorm_phase<0>(F, 0, 0, nullptr, nullptr);
    SEAM(1);
    if (PH(2)) REP(2) { EpiBf16<0> E{(bf16_t*)(ws + WS_A0), 768}; GEMM(EpiBf16<0>, ws + WS_H, ws + WS_WIN, MT, 768, 1024, E);
        if (blockIdx.x >= 134) { EpiKN E2{(bf16_t*)(ws + WS_KN), (float*)(ws + WS_RS), F.in[20], red, MKN / 256 - 92}; int k_ = 256; asm volatile("" : "+s"(k_));
            pg8::Gemm g_{(const bf16_t*)(ws + WS_CKV) + (size_t)(MKN / 256 - 92) * 256 * 256, (const bf16_t*)(ws + WS_WUK), 92 * 256, 1024, k_, k_}; pg8::StaticOrder S_; S_.init(92 * 256, 1024, 122, (int)blockIdx.x - 134);
            pg8::gemm_phase<EpiKN, pg8::StaticOrder, true, true>(F.lds, g_, S_, E2); } }
    SEAM(2);
    if (PH(3)) REP(3) latent_phase(F);
    SEAM(3);
    if (PH(4)) REP(4) {
#if !defined(P4_ONLY) || P4_ONLY == 1
        { EpiKN E{(bf16_t*)(ws + WS_KN), (float*)(ws + WS_RS), F.in[20], red, 0}; GEMM(EpiKN, ws + WS_CKV, ws + WS_WUK, MKN - 92 * 256, 1024, 256, E); }
#endif
#if !defined(P4_ONLY) || P4_ONLY == 2
        gemm_rot_ = 96;
        { EpiQ E{(bf16_t*)(ws + WS_A0), F.in[18], F.in[19], red}; GEMM(EpiQ, ws + WS_CQ, ws + WS_WQ, MT, 1536, 384, E); }
#endif
#if !defined(P4_ONLY) || P4_ONLY == 3
        gemm_rot_ = 56;
        { EpiBf16<0> E{(bf16_t*)(ws + WS_V), 1024}; GEMM(EpiBf16<0>, ws + WS_CKV, ws + WS_WUV, MT, 1024, 256, E); }
        gemm_rot_ = 0;
#endif
    }
    SEAM(4);
    if (PH(5)) REP(5) attention_phase(F, (unsigned*)(ws + WS_CTL) + rep_, rep_ != 0);
    SEAM(5);
    if (PH(6)) REP(6) combine_phase(F);
    SEAM(6);
    if (PH(7)) REP(7) { EpiResidB<true, false> E{F.in[0], ws + WS_V, MODF + 2048}; GEMM(RB_TF, ws + WS_H, ws + WS_WO, MP, 1024, 1024, E); GEMM_TAIL(ws + WS_H + (size_t)MP * 1024 * 2, ws + WS_WO, 1024); }
    SEAM(7);
    if (PH(8)) REP(8) modnorm_phase<1>(F, 0, 1, MODF + 2048, F.in[1]);
    SEAM(8);
    if (PH(9)) REP(9) { EpiBf16<1> E{(bf16_t*)(ws + WS_HF), 4096}; GEMM(EpiBf16<1>, ws + WS_H, ws + WS_W1, MT, 4096, 1024, E); }
    SEAM(9);
    if (PH(10)) REP(10) { EpiResidB<false, false> E{ws + WS_V, ws + WS_V, MODF + 5120}; GEMM(RB_FF, ws + WS_HF, ws + WS_W2, MP, 1024, 4096, E); GEMM_TAIL(ws + WS_HF + (size_t)MP * 4096 * 2, ws + WS_W2, 4096); }
#ifdef DUP_W2
    if (PH(10)) { EpiBf16<0> E{(bf16_t*)(ws + WS_H), 1024}; GEMM(EpiBf16<0>, ws + WS_HF, ws + WS_W2, MP, 1024, 4096, E); }
#endif
#ifdef EXTRA_SYNCS
    for (int es_ = 0; es_ < EXTRA_SYNCS; ++es_) SEAM(10);
#endif
    SEAM(10);
    if (PH(11)) REP(11) modnorm_phase<1>(F, 1, 0, MODF + 5120, nullptr);
    SEAM(11);
    if (PH(12)) REP(12) {
        { EpiBf16<2> E{(bf16_t*)(ws + WS_U), 1024}; GEMM(EpiBf16<2>, ws + WS_H, ws + WS_CWIN, MT, 1024, 1024, E); }
        gemm_rot_ = 128;
        { EpiVT E{(bf16_t*)(ws + WS_VT), (float*)(ws + WS_SSV)}; GEMM(EpiVT, ws + WS_CWIN + (size_t)1024 * 1024 * 2, ws + WS_H, 1024, MT, 1024, E); }
        gemm_rot_ = 0;
    }
    SEAM(12);
    if (PH(13)) REP(13) sgu_phase(F);
    SEAM(13);
    if (PH(14)) REP(14) { EpiResidB<false, false> E{ws + WS_V, ws + WS_V, MODF + 40 * 6144 + 2048}; GEMM(RB_FF, ws + WS_G, ws + WS_CWO, MP, 1024, 1024, E); GEMM_TAIL(ws + WS_G + (size_t)MP * 1024 * 2, ws + WS_CWO, 1024); }
    SEAM(14);
    if (PH(15)) REP(15) modnorm_phase<1>(F, 1, 1, MODF + 40 * 6144 + 2048, nullptr);
    SEAM(15);
    if (PH(16)) REP(16) { EpiBf16<1> E{(bf16_t*)(ws + WS_HF), 4096}; GEMM(EpiBf16<1>, ws + WS_H, ws + WS_W1 + (size_t)4096 * 1024 * 2, MT, 4096, 1024, E); }
    SEAM(16);
    if (PH(17)) REP(17) { EpiResidB<false, true> E{ws + WS_V, F.out, MODF + 40 * 6144 + 5120}; GEMM(RB_FT, ws + WS_HF, ws + WS_W2 + (size_t)4096 * 1024 * 2, MP, 1024, 4096, E); GEMM_TAIL(ws + WS_HF + (size_t)MP * 4096 * 2, ws + WS_W2 + (size_t)4096 * 1024 * 2, 4096); }
    SEAM(17);
    if (PH(18)) REP(18) final_tail_phase(F, MODF + 40 * 6144 + 5120);
#undef PH
#undef SEAM
#undef GEMM
#undef GEMM_TAIL
}

#ifndef MK_N_LAUNCHES
#define MK_N_LAUNCHES 1
#endif
extern "C" void kernel_launch(void* const* d_in, const int* in_sizes, int n_in, void* d_out, int out_size, void* d_ws, size_t ws_size, hipStream_t stream) {
    static int grid = 0;
    if (grid == 0) {
        if (n_in != 28 || (size_t)out_size != OUT_END || ws_size < WS_END) { fprintf(stderr, "kernel_launch: unexpected shapes: n_in %d out %d ws %zu\n", n_in, out_size, ws_size); grid = -1; return; }
        int dev = 0, cus = 0, per_cu = 0;
        hipGetDevice(&dev); hipDeviceGetAttribute(&cus, hipDeviceAttributeMultiprocessorCount, dev);
        if (hipFuncSetAttribute((const void*)fwd_megakernel, hipFuncAttributeMaxDynamicSharedMemorySize, LDS_BYTES) != hipSuccess) { fprintf(stderr, "kernel_launch: hipFuncSetAttribute failed\n"); grid = -1; return; }
        if (hipOccupancyMaxActiveBlocksPerMultiprocessor(&per_cu, (const void*)fwd_megakernel, 512, LDS_BYTES) != hipSuccess || per_cu < 1) { fprintf(stderr, "kernel_launch: occupancy query says %d\n", per_cu); per_cu = 1; }
        (void)hipGetLastError();
        grid = cus;
        fprintf(stderr, "kernel_launch: grid %d (per_cu %d)\n", grid, per_cu);
    }
    if (grid < 0) return;
    (void)hipMemsetAsync((char*)d_ws + WS_CTL, 0, CTL_BYTES, stream);
    Args a{};
    for (int i = 0; i < 28; ++i) a.in[i] = (const float*)d_in[i];
    a.out = (float*)d_out; a.ws = (unsigned char*)d_ws;
#if MK_N_LAUNCHES == 1
#ifndef PH_HI_TEST
#define PH_HI_TEST N_PHASES
#endif
    a.ph_lo = 0; a.ph_hi = PH_HI_TEST;
    void* params[] = {&a};
    hipError_t e = hipLaunchCooperativeKernel((const void*)fwd_megakernel, dim3(grid), dim3(512), params, LDS_BYTES, stream);
    if (e != hipSuccess) fprintf(stderr, "kernel_launch: cooperative launch failed: %s (grid %d)\n", hipGetErrorString(e), grid);
#else
    for (int p = 0; p < N_PHASES; ++p) { a.ph_lo = p; a.ph_hi = p + 1; hipLaunchKernelGGL(fwd_megakernel, dim3(grid), dim3(512), LDS_BYTES, stream, a); }
#endif
}
```

```cpp
#include <hip/hip_runtime.h>
#include <hip/hip_cooperative_groups.h>
#include <cstdio>
#include <cstdint>
namespace cg = cooperative_groups;

#define LAS __attribute__((address_space(3)))
typedef unsigned short bf16_t;
typedef short bf16x8 __attribute__((ext_vector_type(8)));
typedef short s16x4 __attribute__((ext_vector_type(4)));
typedef float f32x4 __attribute__((ext_vector_type(4)));
typedef float f32x2 __attribute__((ext_vector_type(2)));
typedef float f32x16 __attribute__((ext_vector_type(16)));
typedef unsigned u32x4 __attribute__((ext_vector_type(4)));
typedef unsigned u32x2 __attribute__((ext_vector_type(2)));

constexpr int DM = 1024, NB_P = 8, SEQ = 4096, NB_S = 32, DSEQ = 16, PAST = 4096;
constexpr int MP = NB_P * SEQ;
constexpr int MS = NB_S * DSEQ;
constexpr int MT = MP + MS;
constexpr int NSEQ = NB_P + NB_S;
constexpr int NH = 8, DNOPE = 128, DROPE = 64, DV = 128, QLORA = 384, KVLORA = 256, DFF = 4096;
constexpr int NCACHE = NB_S * PAST;
constexpr int MKN = MT + NCACHE;
constexpr int VTP = 33536;
constexpr float EPS = 1e-6f;
constexpr float SM_SCALE = 0.07216878364870322f;
constexpr int NSPLIT = 4;
constexpr size_t OUT_Y = 0, OUT_CKVP = (size_t)MT * DM, OUT_KPEP = OUT_CKVP + (size_t)MP * 256, OUT_CKVS = OUT_KPEP + (size_t)MP * 64,
                 OUT_KPES = OUT_CKVS + (size_t)MS * 256, OUT_VS = OUT_KPES + (size_t)MS * 64, OUT_END = OUT_VS + (size_t)MS * DM;
constexpr size_t MiB = 1u << 20;
constexpr size_t WS_CTL = 0, CTL_BYTES = 32768;
constexpr size_t WS_WIN = 1 * MiB;
constexpr size_t WS_WQ = WS_WIN + 768 * 1024 * 2;
constexpr size_t WS_WUK = WS_WQ + 1536 * 384 * 2;
constexpr size_t WS_WUV = WS_WUK + 1024 * 256 * 2;
constexpr size_t WS_WUKN = WS_WUV + 1024 * 256 * 2;
constexpr size_t WS_WO = WS_WUKN + 1024 * 256 * 2;
constexpr size_t WS_W1 = WS_WO + 1024 * 1024 * 2;
constexpr size_t WS_W2 = WS_W1 + 2ull * 4096 * 1024 * 2;
constexpr size_t WS_CWIN = WS_W2 + 2ull * 4096 * 1024 * 2;
constexpr size_t WS_CWO = WS_CWIN + 2048 * 1024 * 2;
constexpr size_t WS_WEND = WS_CWO + 1024 * 1024 * 2;
static_assert(WS_WEND <= 46 * MiB, "weights");
constexpr size_t WS_MODF = 46 * MiB;
constexpr size_t WS_SSV = 48 * MiB;
constexpr size_t WS_PBUF = 50 * MiB;
constexpr int KSPL = 8;
constexpr size_t WS_PART = 50 * MiB;
constexpr size_t WS_ML = 66 * MiB;
constexpr size_t WS_H = 67 * MiB;
constexpr size_t WS_A0 = 132 * MiB;
constexpr size_t WS_CQ = 230 * MiB;
constexpr size_t WS_CKV = 255 * MiB;
constexpr size_t WS_KR = 336 * MiB;
constexpr size_t WS_KPE = 341 * MiB;
constexpr size_t WS_RS = 357 * MiB;
constexpr size_t WS_KN = 363 * MiB;
constexpr size_t WS_V = 428 * MiB;
constexpr size_t WS_END = 493 * MiB;
constexpr size_t WS_HF = 132 * MiB;
constexpr size_t WS_U = 132 * MiB;
constexpr size_t WS_VT = 197 * MiB;
constexpr size_t WS_G = 263 * MiB;
static_assert(WS_CKV + (size_t)MKN * 256 * 2 <= WS_KR && WS_RS + (size_t)MKN * 32 <= WS_KN && WS_V + (size_t)MT * 2048 <= WS_END, "ws map");
static_assert(WS_VT + (size_t)1024 * VTP * 2 <= WS_G && WS_HF + (size_t)MT * 8192 <= WS_END, "ws map 2");
constexpr int LDS_BYTES = 147456;
constexpr int LDS_RED = 131072;
constexpr int LDS_MISC = 147392;

typedef __bf16 bf16x2_t __attribute__((ext_vector_type(2)));
__device__ __forceinline__ unsigned cvt_pk_bf16(float lo, float hi) { const f32x2 v = {lo, hi}; const bf16x2_t b = __builtin_convertvector(v, bf16x2_t); return __builtin_bit_cast(unsigned, b); }
__device__ __forceinline__ float bf2f(bf16_t b) { return __uint_as_float(((unsigned)b) << 16); }
__device__ __forceinline__ float bflo(unsigned w) { return __uint_as_float(w << 16); }
__device__ __forceinline__ float bfhi(unsigned w) { return __uint_as_float(w & 0xffff0000u); }
__device__ __forceinline__ bf16_t f2bf(float f) { return (bf16_t)(cvt_pk_bf16(f, 0.f) & 0xffffu); }
template <int X> __device__ __forceinline__ float swz_xor(float v) { return __int_as_float(__builtin_amdgcn_ds_swizzle(__float_as_int(v), (X << 10) | 0x1f)); }
__device__ __forceinline__ float sum_x32(float v) { auto rr = __builtin_amdgcn_permlane32_swap(__float_as_uint(v), __float_as_uint(v), false, false); return __uint_as_float(rr[0]) + __uint_as_float(rr[1]); }
__device__ __forceinline__ float wave_sum(float v) { v += swz_xor<1>(v); v += swz_xor<2>(v); v += swz_xor<4>(v); v += swz_xor<8>(v); v += swz_xor<16>(v); return sum_x32(v); }
__device__ __forceinline__ float gelu_tanh(float x) {
    const float u = 0.7978845608028654f * (x + 0.044715f * x * x * x);
    return x * __builtin_amdgcn_rcpf(1.f + __builtin_amdgcn_exp2f(-2.885390081777927f * u));
}
__device__ __forceinline__ void sincos_rev(float ang, float& s, float& c) {
    float rev = ang * 0.15915494309189535f; rev -= floorf(rev);
    s = __builtin_amdgcn_sinf(rev); c = __builtin_amdgcn_cosf(rev);
}
__device__ __forceinline__ float rope_inv(int i) { return __builtin_amdgcn_exp2f(-(float)i * (13.287712379549449f / 32.f)); }
__device__ __forceinline__ int row_pos(int r) { return r < MP ? (r & (SEQ - 1)) : PAST + ((r - MP) & (DSEQ - 1)); }
__device__ __forceinline__ int row_seq(int r) { return r < MP ? (r >> 12) : NB_P + ((r - MP) >> 4); }

namespace pg8 {
#define PG8_LAS __attribute__((address_space(3)))
constexpr int BM = 256, BK = 64, HALF = 128, HTB = HALF * BK * 2  , STAGE_BYTES = 8 * HTB, NXCD = 8, WGM = 8;
__host__ __device__ __forceinline__ int lds_byte(int r, int c) { const int st = (r >> 4) * 2 + (c >> 5), rr = r & 15, cc = c & 31, ob = rr * 64 + cc * 2; return st * 1024 + (ob ^ (((ob >> 9) & 1) << 5)); }
__host__ __device__ __forceinline__ void stage_rc(int b, int& R, int& C) { const int st = b / 1024, sb = b % 1024, swz = sb ^ (((sb >> 9) & 1) << 5); R = (st >> 1) * 16 + swz / 64; C = (st & 1) * 32 + (swz % 64) / 2; }
__host__ __device__ __forceinline__ int perm32(int rho) { const int n = rho >> 4, i = rho & 15; return 8 * (i >> 2) + 4 * n + (i & 3); }
struct Unit { int pm, pn, pk; };
struct Gemm { const bf16_t* A; const bf16_t* Bt; int M, N, K, ld; };
struct StaticOrder {
    int nM, nN, nwg, G, c, rev;
    __host__ __device__ void init(int M, int N, int G_, int c_) { nM = M / BM; nN = N / BM; nwg = nM * nN; G = G_; c = c_; rev = 0; }
    __host__ __device__ bool next(int i, Unit& u) const {
        const long L = (long)i * G + c; if (L >= nwg) return false;
        int wgid = (int)L; { const int q = nwg / NXCD, r = nwg % NXCD, xcd = wgid % NXCD, off = wgid / NXCD; wgid = (xcd < r ? xcd * (q + 1) : r * (q + 1) + (xcd - r) * q) + off; }
        const int nig = WGM * nN, gid = wgid / nig, fm = gid * WGM, gsz = (nM - fm) < WGM ? (nM - fm) : WGM;
        u.pm = fm + ((wgid % nig) % gsz); u.pn = (wgid % nig) / gsz; u.pk = 0; if (rev) u.pm = nM - 1 - u.pm; return true;
    }
    __device__ __forceinline__ void a_ready(const Unit&) const {}
    __device__ __forceinline__ void done(const Unit&) const {}
};
struct TailOrder {
    int nM, nN, KS, G, c;
    __host__ __device__ void init(int M, int N, int KS_, int G_, int c_) { nM = M / BM; nN = N / BM; KS = KS_; G = G_; c = c_; }
    __host__ __device__ bool next(int i, Unit& u) const {
        const long L = (long)i * G + c; if (L >= (long)nM * nN * KS) return false;
        const int t = (int)L % (nM * nN); u.pk = (int)L / (nM * nN); u.pm = t % nM; u.pn = t / nM; return true;
    }
    __device__ __forceinline__ void a_ready(const Unit&) const {}
    __device__ __forceinline__ void done(const Unit&) const {}
};
template <class Epi, class Sched, bool ALIGN_EPI = false, bool SP2 = false>
__device__ __forceinline__ void gemm_phase(PG8_LAS unsigned char* lds, const Gemm g, const Sched& S, const Epi& E) {
    int tid_l = threadIdx.x; asm volatile("" : "+v"(tid_l));
    const int tid = tid_l, wid = __builtin_amdgcn_readfirstlane(tid >> 6), lane = tid & 63, wr = wid >> 2, wc = wid & 3, fr = lane & 15, fq = lane >> 4;
    const int K = g.K, nt = K / BK, ld = g.ld;
    unsigned voffA[2], voffB[2];
#pragma unroll
    for (int i = 0; i < 2; ++i) { int R, C; stage_rc(tid * 16 + i * 8192, R, C); const int Rb = Epi::PERM ? ((R & ~31) + perm32(R & 31)) : R;
        voffA[i] = (unsigned)(R * ld + C) * 2u; voffB[i] = (unsigned)(Rb * ld + C) * 2u; }
    const size_t kstep = (size_t)(BK * 2);
    const size_t hstep = (size_t)HALF * ld * 2;
    const size_t tstep = 2 * hstep;
    const unsigned ldsw = (unsigned)wid * 1024u;
    const int aoff = lds_byte(wr * 64 + fr, fq * 8), boff = lds_byte(wc * 32 + fr, fq * 8);
#define PG8_SA(b, h) (((b) * 2 + (h)) * HTB)
#define PG8_SB(b, h) ((4 + (b) * 2 + (h)) * HTB)
#define PG8_STAGE(bufoff, gbase, voff) do { _Pragma("unroll") for (int _i = 0; _i < 2; ++_i) \
        __builtin_amdgcn_global_load_lds((const unsigned*)((const char*)(gbase) + (voff)[_i]), (PG8_LAS unsigned*)(lds + (bufoff) + ldsw + _i * 8192), 16, 0, 0); } while (0)
#define PG8_LDA(dst, b, h) do { _Pragma("unroll") for (int m = 0; m < 4; ++m) _Pragma("unroll") for (int k = 0; k < 2; ++k) dst[m][k] = *(const PG8_LAS bf16x8*)(lds + PG8_SA(b, h) + aoff + m * 2048 + k * 1024); } while (0)
#define PG8_LDB(dst, b, h) do { _Pragma("unroll") for (int n = 0; n < 2; ++n) _Pragma("unroll") for (int k = 0; k < 2; ++k) dst[n][k] = *(const PG8_LAS bf16x8*)(lds + PG8_SB(b, h) + boff + n * 2048 + k * 1024); } while (0)
#define PG8_MMA(ai, bj, At, Bt) do { __builtin_amdgcn_s_setprio(1); _Pragma("unroll") for (int m = 0; m < 4; ++m) _Pragma("unroll") for (int n = 0; n < 2; ++n) _Pragma("unroll") for (int k = 0; k < 2; ++k) \
        acc[ai][bj][m][n] = __builtin_amdgcn_mfma_f32_16x16x32_bf16(Bt[n][k], At[m][k], acc[ai][bj][m][n], 0, 0, 0); __builtin_amdgcn_s_setprio(0); } while (0)
#define PG8_WAIT_V(n) asm volatile("s_waitcnt vmcnt(" #n ")" ::: "memory")
#define PG8_WAIT_L(n) asm volatile("s_waitcnt lgkmcnt(" #n ")" ::: "memory")
#define PG8_BAR __builtin_amdgcn_s_barrier()
#define PG8_SCHED __builtin_amdgcn_sched_barrier(0)
    Unit cur, nxt; int ui = 0;
    if (!S.next(0, cur)) return;
    f32x4 acc[2][2][4][2];
#pragma unroll
    for (int a = 0; a < 2; ++a)
#pragma unroll
        for (int b = 0; b < 2; ++b)
#pragma unroll
            for (int m = 0; m < 4; ++m)
#pragma unroll
                for (int n = 0; n < 2; ++n) acc[a][b][m][n] = (f32x4){0.f, 0.f, 0.f, 0.f};
    bf16x8 At[4][2], B0[2][2], B1[2][2];
    const char* cA = (const char*)g.A + (size_t)cur.pm * tstep + (size_t)cur.pk * K * 2; const char* cB = (const char*)g.Bt + (size_t)cur.pn * tstep + (size_t)cur.pk * K * 2;
    S.a_ready(cur);
    if constexpr (SP2) {
        PG8_STAGE(PG8_SB(0, 0), cB, voffB); PG8_STAGE(PG8_SB(0, 1), cB + hstep, voffB); PG8_STAGE(PG8_SA(0, 0), cA, voffA); PG8_STAGE(PG8_SA(0, 1), cA + hstep, voffA);
        if (wr == 1) PG8_BAR;
        PG8_WAIT_V(2); PG8_BAR;
        PG8_STAGE(PG8_SB(1, 0), cB + kstep, voffB); PG8_STAGE(PG8_SA(1, 0), cA + kstep, voffA); PG8_STAGE(PG8_SB(1, 1), cB + hstep + kstep, voffB);
        PG8_WAIT_V(6); PG8_BAR;
    } else {
        PG8_STAGE(PG8_SB(0, 0), cB, voffB); PG8_STAGE(PG8_SA(0, 0), cA, voffA); PG8_STAGE(PG8_SB(0, 1), cB + hstep, voffB); PG8_STAGE(PG8_SA(0, 1), cA + hstep, voffA);
        if (wr == 1) PG8_BAR;
        PG8_WAIT_V(4); PG8_BAR;
        PG8_STAGE(PG8_SB(1, 0), cB + kstep, voffB); PG8_STAGE(PG8_SA(1, 0), cA + kstep, voffA); PG8_STAGE(PG8_SB(1, 1), cB + hstep + kstep, voffB);
        PG8_WAIT_V(6); PG8_BAR;
    }
    for (;;) {
        const bool has_next = S.next(ui + 1, nxt);
        const char* nA = has_next ? (const char*)g.A + (size_t)nxt.pm * tstep + (size_t)nxt.pk * K * 2 : cA; const char* nB = has_next ? (const char*)g.Bt + (size_t)nxt.pn * tstep + (size_t)nxt.pk * K * 2 : cB;
        for (int t = 0; t < nt; t += 2) {
            const bool last = (t == nt - 2);
            const char* a1 = cA + (size_t)(t + 1) * kstep;
            const char* a2 = last ? nA : cA + (size_t)(t + 2) * kstep; const char* b2 = last ? nB : cB + (size_t)(t + 2) * kstep;
            const char* a3 = a2 + kstep; const char* b3 = b2 + kstep;
            if (last && has_next) S.a_ready(nxt);
            if constexpr (SP2) {
            PG8_LDB(B0, 0, 0); PG8_LDB(B1, 0, 1); PG8_SCHED; PG8_LDA(At, 0, 0); PG8_STAGE(PG8_SA(1, 1), a1 + hstep, voffA);
            PG8_WAIT_V(8); PG8_WAIT_L(0); PG8_BAR; PG8_MMA(0, 0, At, B0); PG8_MMA(0, 1, At, B1); PG8_BAR; PG8_SCHED;
            PG8_LDA(At, 0, 1); PG8_STAGE(PG8_SB(0, 0), b2, voffB); PG8_STAGE(PG8_SB(0, 1), b2 + hstep, voffB); PG8_STAGE(PG8_SA(0, 0), a2, voffA);
            PG8_WAIT_V(8); PG8_WAIT_L(0); PG8_BAR; PG8_MMA(1, 0, At, B0); PG8_MMA(1, 1, At, B1); PG8_BAR; PG8_SCHED;
            PG8_LDB(B0, 1, 0); PG8_LDB(B1, 1, 1); PG8_SCHED; PG8_LDA(At, 1, 0); PG8_STAGE(PG8_SA(0, 1), a2 + hstep, voffA);
            PG8_WAIT_V(8); PG8_WAIT_L(0); PG8_BAR; PG8_MMA(0, 0, At, B0); PG8_MMA(0, 1, At, B1); PG8_BAR; PG8_SCHED;
            PG8_LDA(At, 1, 1); PG8_STAGE(PG8_SB(1, 0), b3, voffB); PG8_STAGE(PG8_SB(1, 1), b3 + hstep, voffB); PG8_STAGE(PG8_SA(1, 0), a3, voffA);
            PG8_WAIT_V(8); PG8_WAIT_L(0); PG8_BAR; PG8_MMA(1, 0, At, B0); PG8_MMA(1, 1, At, B1); PG8_BAR; PG8_SCHED;
            } else {
            PG8_LDB(B0, 0, 0); PG8_SCHED; PG8_LDA(At, 0, 0); PG8_STAGE(PG8_SA(1, 1), a1 + hstep, voffA);
            PG8_WAIT_L(8); PG8_BAR; PG8_WAIT_L(0); PG8_MMA(0, 0, At, B0); PG8_BAR; PG8_SCHED;
            PG8_LDB(B1, 0, 1); PG8_STAGE(PG8_SB(0, 0), b2, voffB);
            PG8_BAR; PG8_WAIT_L(0); PG8_MMA(0, 1, At, B1); PG8_BAR;
            PG8_LDA(At, 0, 1); PG8_STAGE(PG8_SA(0, 0), a2, voffA);
            PG8_BAR; PG8_WAIT_L(0); PG8_MMA(1, 0, At, B0); PG8_BAR; PG8_SCHED;
            PG8_STAGE(PG8_SB(0, 1), b2 + hstep, voffB);
            PG8_WAIT_V(6); PG8_BAR; PG8_MMA(1, 1, At, B1); PG8_BAR;
            PG8_LDB(B0, 1, 0); PG8_SCHED; PG8_LDA(At, 1, 0); PG8_STAGE(PG8_SA(0, 1), a2 + hstep, voffA);
            PG8_WAIT_L(8); PG8_BAR; PG8_WAIT_L(0); PG8_MMA(0, 0, At, B0); PG8_BAR; PG8_SCHED;
            PG8_LDB(B1, 1, 1); PG8_STAGE(PG8_SB(1, 0), b3, voffB);
            PG8_BAR; PG8_WAIT_L(0); PG8_MMA(0, 1, At, B1); PG8_BAR;
            PG8_LDA(At, 1, 1); PG8_STAGE(PG8_SA(1, 0), a3, voffA);
            PG8_BAR; PG8_WAIT_L(0); PG8_MMA(1, 0, At, B0); PG8_BAR; PG8_SCHED;
            PG8_STAGE(PG8_SB(1, 1), b3 + hstep, voffB);
            PG8_WAIT_V(6); PG8_BAR; PG8_MMA(1, 1, At, B1); PG8_BAR;
            }
        }
        if constexpr (ALIGN_EPI) { if (wr == 0) PG8_BAR; }
        if constexpr (!Epi::AFTER_DRAIN) { E(acc, cur, wr, wc, fr, fq); S.done(cur); }
        if (!has_next) break;
#pragma unroll
        for (int a = 0; a < 2; ++a)
#pragma unroll
            for (int b = 0; b < 2; ++b)
#pragma unroll
                for (int m = 0; m < 4; ++m)
#pragma unroll
                    for (int n = 0; n < 2; ++n) acc[a][b][m][n] = (f32x4){0.f, 0.f, 0.f, 0.f};
        cur = nxt; cA = nA; cB = nB; ++ui;
        if constexpr (ALIGN_EPI) { if (wr == 1) PG8_BAR; }
    }
    PG8_WAIT_V(0);
    if constexpr (!ALIGN_EPI) { if (wr == 0) PG8_BAR; }
    PG8_BAR;
    if constexpr (Epi::AFTER_DRAIN) { E.fused(acc, cur, wr, wc, fr, fq, lds, wid, lane); S.done(cur); }
#undef PG8_SA
#undef PG8_SB
#undef PG8_STAGE
#undef PG8_LDA
#undef PG8_LDB
#undef PG8_MMA
#undef PG8_WAIT_V
#undef PG8_WAIT_L
#undef PG8_BAR
#undef PG8_SCHED
}
}

typedef f32x4 AccT[2][2][4][2];

struct EpiF32 {
    static constexpr bool PERM = false, AFTER_DRAIN = false;
    float* O; int ldc;
    __device__ __forceinline__ void operator()(const AccT& acc, const pg8::Unit& u, int wr, int wc, int fr, int fq) const {
        asm volatile("" : "+v"(fr), "+v"(fq));
        const int row0 = u.pm * 256 + wr * 64 + fr, col0 = u.pn * 256 + wc * 32 + 4 * fq;
#pragma unroll
        for (int ai = 0; ai < 2; ++ai)
#pragma unroll
            for (int m = 0; m < 4; ++m) { float* rowp = O + (size_t)(row0 + ai * 128 + m * 16) * ldc + col0;
#pragma unroll
                for (int bj = 0; bj < 2; ++bj)
#pragma unroll
                    for (int n = 0; n < 2; ++n) *(f32x4*)(rowp + bj * 128 + n * 16) = acc[ai][bj][m][n]; }
    }
};
struct EpiPart {
    static constexpr bool PERM = false, AFTER_DRAIN = false;
    float* P;
    __device__ __forceinline__ void operator()(const AccT& acc, const pg8::Unit& u, int wr, int wc, int fr, int fq) const {
        asm volatile("" : "+v"(fr), "+v"(fq));
        const int row0 = u.pm * 256 + wr * 64 + fr, col0 = u.pn * 256 + wc * 32 + 4 * fq;
        float* O = P + (size_t)u.pk * MS * DM;
#pragma unroll
        for (int ai = 0; ai < 2; ++ai)
#pragma unroll
            for (int m = 0; m < 4; ++m) { float* rowp = O + (size_t)(row0 + ai * 128 + m * 16) * DM + col0;
#pragma unroll
                for (int bj = 0; bj < 2; ++bj)
#pragma unroll
                    for (int n = 0; n < 2; ++n) *(f32x4*)(rowp + bj * 128 + n * 16) = acc[ai][bj][m][n]; }
    }
};
struct EpiResid {
    static constexpr bool PERM = false, AFTER_DRAIN = false;
    const float* xp; float* out; const float* gate;
    __device__ __forceinline__ void operator()(const AccT& acc, const pg8::Unit& u, int wr, int wc, int fr, int fq) const {
        asm volatile("" : "+v"(fr), "+v"(fq));
        const int row0 = u.pm * 256 + wr * 64 + fr, col0 = u.pn * 256 + wc * 32 + 4 * fq;
        const float* gp = gate + (size_t)(u.pm >> 4) * 6144 + col0;
        f32x4 gv[2][2];
#pragma unroll
        for (int bj = 0; bj < 2; ++bj)
#pragma unroll
            for (int n = 0; n < 2; ++n) gv[bj][n] = *(const f32x4*)(gp + bj * 128 + n * 16);
#pragma unroll
        for (int ai = 0; ai < 2; ++ai) {
            f32x4 xv[4][2][2];
#pragma unroll
            for (int m = 0; m < 4; ++m) { const float* xr = xp + (size_t)(row0 + ai * 128 + m * 16) * DM + col0;
#pragma unroll
                for (int bj = 0; bj < 2; ++bj)
#pragma unroll
                    for (int n = 0; n < 2; ++n) xv[m][bj][n] = *(const f32x4*)(xr + bj * 128 + n * 16); }
#pragma unroll
            for (int m = 0; m < 4; ++m) { float* op = out + (size_t)(row0 + ai * 128 + m * 16) * DM + col0;
#pragma unroll
                for (int bj = 0; bj < 2; ++bj)
#pragma unroll
                    for (int n = 0; n < 2; ++n) *(f32x4*)(op + bj * 128 + n * 16) = xv[m][bj][n] + gv[bj][n] * acc[ai][bj][m][n]; }
        }
    }
};
template <bool IN32, bool OUT32> struct EpiResidB {
    static constexpr bool PERM = true, AFTER_DRAIN = false;
    const void* xin; void* xout; const float* gate;
    __device__ __forceinline__ void operator()(const AccT& acc, const pg8::Unit& u, int wr, int wc, int fr, int fq) const {
        asm volatile("" : "+v"(fr), "+v"(fq));
        const int row0 = u.pm * 256 + wr * 64 + fr, col0 = u.pn * 256 + wc * 32 + 8 * fq;
        const float* gp = gate + (size_t)(u.pm >> 4) * 6144 + col0;
        f32x4 gv[2][2];
#pragma unroll
        for (int bj = 0; bj < 2; ++bj) { gv[bj][0] = *(const f32x4*)(gp + bj * 128); gv[bj][1] = *(const f32x4*)(gp + bj * 128 + 4); }
#pragma unroll
        for (int ai = 0; ai < 2; ++ai) {
            f32x4 xa[4][2][2];
#pragma unroll
            for (int m = 0; m < 4; ++m) { const size_t ro = (size_t)(row0 + ai * 128 + m * 16) * DM + col0;
#pragma unroll
                for (int bj = 0; bj < 2; ++bj) {
                    if (IN32) { const float* xr = (const float*)xin + ro + bj * 128; xa[m][bj][0] = *(const f32x4*)xr; xa[m][bj][1] = *(const f32x4*)(xr + 4); }
                    else { const u32x4 w = *(const u32x4*)((const bf16_t*)xin + ro + bj * 128);
                        xa[m][bj][0] = (f32x4){bflo(w.x), bfhi(w.x), bflo(w.y), bfhi(w.y)}; xa[m][bj][1] = (f32x4){bflo(w.z), bfhi(w.z), bflo(w.w), bfhi(w.w)}; } } }
#pragma unroll
            for (int m = 0; m < 4; ++m) { const size_t ro = (size_t)(row0 + ai * 128 + m * 16) * DM + col0;
#pragma unroll
                for (int bj = 0; bj < 2; ++bj) { const f32x4 x0 = xa[m][bj][0] + gv[bj][0] * acc[ai][bj][m][0], x1 = xa[m][bj][1] + gv[bj][1] * acc[ai][bj][m][1];
                    if (OUT32) { float* op = (float*)xout + ro + bj * 128; *(f32x4*)op = x0; *(f32x4*)(op + 4) = x1; }
                    else { u32x4 w; w.x = cvt_pk_bf16(x0[0], x0[1]); w.y = cvt_pk_bf16(x0[2], x0[3]); w.z = cvt_pk_bf16(x1[0], x1[1]); w.w = cvt_pk_bf16(x1[2], x1[3]);
                        *(u32x4*)((bf16_t*)xout + ro + bj * 128) = w; } } }
        }
    }
};
template <int ACT> struct EpiBf16 {
    static constexpr bool PERM = true, AFTER_DRAIN = false;
    bf16_t* O; int ldc;
    __device__ __forceinline__ void operator()(const AccT& acc, const pg8::Unit& u, int wr, int wc, int fr, int fq) const {
        asm volatile("" : "+v"(fr), "+v"(fq));
        const int row0 = u.pm * 256 + wr * 64 + fr, col0 = u.pn * 256 + wc * 32 + 8 * fq;
#pragma unroll
        for (int ai = 0; ai < 2; ++ai)
#pragma unroll
            for (int m = 0; m < 4; ++m) { bf16_t* rowp = O + (size_t)(row0 + ai * 128 + m * 16) * ldc + col0;
#pragma unroll
                for (int bj = 0; bj < 2; ++bj) { f32x4 v0 = acc[ai][bj][m][0], v1 = acc[ai][bj][m][1];
                    if (ACT == 1) {
#pragma unroll
                        for (int j = 0; j < 4; ++j) { const float a = fmaxf(v0[j], 0.f), b = fmaxf(v1[j], 0.f); v0[j] = a * a; v1[j] = b * b; } }
                    if (ACT == 2) {
#pragma unroll
                        for (int j = 0; j < 4; ++j) { v0[j] = gelu_tanh(v0[j]); v1[j] = gelu_tanh(v1[j]); } }
                    u32x4 w; w.x = cvt_pk_bf16(v0[0], v0[1]); w.y = cvt_pk_bf16(v0[2], v0[3]); w.z = cvt_pk_bf16(v1[0], v1[1]); w.w = cvt_pk_bf16(v1[2], v1[3]);
                    *(u32x4*)(rowp + bj * 128) = w; } }
    }
};
struct EpiVT {
    static constexpr bool PERM = true, AFTER_DRAIN = false;
    bf16_t* VT; float* SSV;
    __device__ __forceinline__ void operator()(const AccT& acc, const pg8::Unit& u, int wr, int wc, int fr, int fq) const {
        asm volatile("" : "+v"(fr), "+v"(fq));
        const int row0 = u.pm * 256 + wr * 64 + fr, col0 = u.pn * 256 + wc * 32 + 8 * fq;
        float s[2][2][4];
#pragma unroll
        for (int bj = 0; bj < 2; ++bj)
#pragma unroll
            for (int n = 0; n < 2; ++n)
#pragma unroll
                for (int j = 0; j < 4; ++j) s[bj][n][j] = 0.f;
#pragma unroll
        for (int ai = 0; ai < 2; ++ai)
#pragma unroll
            for (int m = 0; m < 4; ++m) { bf16_t* rowp = VT + (size_t)(row0 + ai * 128 + m * 16) * VTP + col0;
#pragma unroll
                for (int bj = 0; bj < 2; ++bj) { f32x4 v0 = acc[ai][bj][m][0], v1 = acc[ai][bj][m][1];
#pragma unroll
                    for (int j = 0; j < 4; ++j) { v0[j] = gelu_tanh(v0[j]); v1[j] = gelu_tanh(v1[j]); s[bj][0][j] += v0[j] * v0[j]; s[bj][1][j] += v1[j] * v1[j]; }
                    u32x4 w; w.x = cvt_pk_bf16(v0[0], v0[1]); w.y = cvt_pk_bf16(v0[2], v0[3]); w.z = cvt_pk_bf16(v1[0], v1[1]); w.w = cvt_pk_bf16(v1[2], v1[3]);
                    *(u32x4*)(rowp + bj * 128) = w; } }
        float* sp = SSV + (size_t)(u.pm * 2 + wr) * VTP + col0;
#pragma unroll
        for (int bj = 0; bj < 2; ++bj)
#pragma unroll
            for (int n = 0; n < 2; ++n) { f32x4 t;
#pragma unroll
                for (int j = 0; j < 4; ++j) { float x = s[bj][n][j]; x += swz_xor<1>(x); x += swz_xor<2>(x); x += swz_xor<4>(x); x += swz_xor<8>(x); t[j] = x; }
                if (fr == 0) *(f32x4*)(sp + bj * 128 + n * 4) = t; }
    }
};
__device__ __forceinline__ void head_ss(const AccT& acc, LAS float* red, int wr, int wc, int fr, int fq) {
    LAS float* rw = red + (wr * 64 + fr) * 8 + wc;
#pragma unroll
    for (int ai = 0; ai < 2; ++ai)
#pragma unroll
        for (int m = 0; m < 4; ++m)
#pragma unroll
            for (int bj = 0; bj < 2; ++bj) { const f32x4 a = acc[ai][bj][m][0], b = acc[ai][bj][m][1];
                float s = (a[0] * a[0] + a[1] * a[1]) + (a[2] * a[2] + a[3] * a[3]) + (b[0] * b[0] + b[1] * b[1]) + (b[2] * b[2] + b[3] * b[3]);
                s += swz_xor<16>(s); s = sum_x32(s);
                if (fq == 0) rw[(ai * 128 + m * 16) * 8 + bj * 4] = s; }
    asm volatile("s_waitcnt lgkmcnt(0)" ::: "memory"); __builtin_amdgcn_s_barrier(); asm volatile("" ::: "memory");
}
__device__ __forceinline__ float head_rs(const LAS float* red, int rowl, int bj) {
    const f32x4 t = *(const LAS f32x4*)(red + rowl * 8 + bj * 4);
    return __builtin_amdgcn_rsqf(((t[0] + t[1]) + (t[2] + t[3])) * (1.f / 128.f) + EPS);
}
__device__ __forceinline__ void head_done() { asm volatile("s_waitcnt lgkmcnt(0)" ::: "memory"); __builtin_amdgcn_s_barrier(); asm volatile("" ::: "memory"); }
struct EpiKN {
    static constexpr bool PERM = true, AFTER_DRAIN = false;
    bf16_t* KN; float* RS; const float* g; LAS float* red; int pm_off;
    __device__ __forceinline__ void operator()(const AccT& acc, const pg8::Unit& u, int wr, int wc, int fr, int fq) const {
        asm volatile("" : "+v"(fr), "+v"(fq));
        head_ss(acc, red, wr, wc, fr, fq);
        const int pmg = u.pm + pm_off; const int row0 = pmg * 256 + wr * 64 + fr, d0 = wc * 32 + 8 * fq;
        const float* gl = g + d0; asm volatile("" : "+v"(gl)); const f32x4 g0 = *(const f32x4*)gl, g1 = *(const f32x4*)(gl + 4);
#pragma unroll
        for (int ai = 0; ai < 2; ++ai)
#pragma unroll
            for (int m = 0; m < 4; ++m) { const int r = row0 + ai * 128 + m * 16;
#pragma unroll
                for (int bj = 0; bj < 2; ++bj) { const float s = head_rs(red + (wr * 64 + fr) * 8, ai * 128 + m * 16, bj); const int h = 2 * u.pn + bj;
                    if (wc == 0 && fq == 0) RS[(size_t)r * 8 + h] = s;
                    if (pmg < MT / 256) { const f32x4 v0 = acc[ai][bj][m][0] * s * g0, v1 = acc[ai][bj][m][1] * s * g1;
                        u32x4 w; w.x = cvt_pk_bf16(v0[0], v0[1]); w.y = cvt_pk_bf16(v0[2], v0[3]); w.z = cvt_pk_bf16(v1[0], v1[1]); w.w = cvt_pk_bf16(v1[2], v1[3]);
                        *(u32x4*)(KN + (size_t)r * 1024 + h * 128 + d0) = w; } } }
        head_done();
    }
};
struct EpiQ {
    static constexpr bool PERM = true, AFTER_DRAIN = false;
    bf16_t* Q; const float* gqn; const float* gqr; LAS float* red;
    __device__ __forceinline__ void operator()(const AccT& acc, const pg8::Unit& u, int wr, int wc, int fr, int fq) const {
        asm volatile("" : "+v"(fr), "+v"(fq));
        const int row0 = u.pm * 256 + wr * 64 + fr;
        if (u.pn < 4) {
            head_ss(acc, red, wr, wc, fr, fq);
            const int d0 = wc * 32 + 8 * fq;
            const float* gl = gqn + d0; asm volatile("" : "+v"(gl)); const f32x4 g0 = *(const f32x4*)gl, g1 = *(const f32x4*)(gl + 4);
#pragma unroll
            for (int ai = 0; ai < 2; ++ai)
#pragma unroll
                for (int m = 0; m < 4; ++m) { const int r = row0 + ai * 128 + m * 16;
#pragma unroll
                    for (int bj = 0; bj < 2; ++bj) { const float s = head_rs(red + (wr * 64 + fr) * 8, ai * 128 + m * 16, bj); const int h = 2 * u.pn + bj;
                        const f32x4 v0 = acc[ai][bj][m][0] * s * g0, v1 = acc[ai][bj][m][1] * s * g1;
                        u32x4 w; w.x = cvt_pk_bf16(v0[0], v0[1]); w.y = cvt_pk_bf16(v0[2], v0[3]); w.z = cvt_pk_bf16(v1[0], v1[1]); w.w = cvt_pk_bf16(v1[2], v1[3]);
                        *(u32x4*)(Q + (size_t)r * 1536 + h * 192 + d0) = w; } }
            head_done();
        } else {
            const int h = (u.pn - 4) * 4 + wc, i0c = 8 * fq;
            float gqa[8], gqb[8]; { const float* gl = gqr + i0c; asm volatile("" : "+v"(gl));
#pragma unroll
                for (int t = 0; t < 8; ++t) { gqa[t] = gl[t]; gqb[t] = gl[32 + t]; } }
#pragma unroll
            for (int ai = 0; ai < 2; ++ai)
#pragma unroll
                for (int m = 0; m < 4; ++m) { const int r = row0 + ai * 128 + m * 16; int i0 = i0c; asm volatile("" : "+v"(i0));
                    float ss = 0.f;
#pragma unroll
                    for (int n = 0; n < 2; ++n)
#pragma unroll
                        for (int j = 0; j < 4; ++j) { const float a = acc[ai][0][m][n][j], b = acc[ai][1][m][n][j]; ss += a * a + b * b; }
                    ss += swz_xor<16>(ss); ss = sum_x32(ss);
                    const float s = __builtin_amdgcn_rsqf(ss * (1.f / 64.f) + EPS); const float pos = (float)row_pos(r);
                    unsigned w1[4], w2[4];
#pragma unroll
                    for (int tp = 0; tp < 4; ++tp) { float oa[2], ob[2];
#pragma unroll
                        for (int e = 0; e < 2; ++e) { const int t = 2 * tp + e; float sn, cs; sincos_rev(pos * rope_inv(i0 + t), sn, cs);
                            const float y1 = acc[ai][0][m][t >> 2][t & 3] * s * gqa[t], y2 = acc[ai][1][m][t >> 2][t & 3] * s * gqb[t];
                            oa[e] = y1 * cs - y2 * sn; ob[e] = y2 * cs + y1 * sn; }
                        w1[tp] = cvt_pk_bf16(oa[0], oa[1]); w2[tp] = cvt_pk_bf16(ob[0], ob[1]); }
                    bf16_t* qp = Q + (size_t)r * 1536 + h * 192 + 128 + i0;
                    *(u32x4*)qp = (u32x4){w1[0], w1[1], w1[2], w1[3]}; *(u32x4*)(qp + 32) = (u32x4){w2[0], w2[1], w2[2], w2[3]};
                    asm volatile("" ::: "memory"); }
        }
    }
};

struct Args { const float* in[28]; float* out; unsigned char* ws; int ph_lo, ph_hi; };
struct Frame {
    LAS unsigned char* lds;
    int G;
    const float* const* in; float* out; unsigned char* ws;
};
#define LOCAL_IDS() int tid_l_ = threadIdx.x; asm volatile("" : "+v"(tid_l_)); const int tid = tid_l_, lane = tid & 63, wave = __builtin_amdgcn_readfirstlane(tid >> 6); (void)tid; (void)lane; (void)wave
#define LDS_WAIT() asm volatile("s_waitcnt lgkmcnt(0)" ::: "memory")

__device__ __forceinline__ void transpose_block(const float* W, int K, int N, bf16_t* WT, int k0, int n0, int drow, LAS float* scr, int lane) {
#pragma unroll 8
    for (int i = 0; i < 32; ++i) { const int kk = 2 * i + (lane >> 5); scr[kk * 33 + (lane & 31)] = W[(size_t)(k0 + kk) * N + n0 + (lane & 31)]; }
    LDS_WAIT(); asm volatile("" ::: "memory");
    const int c = lane & 7;
#pragma unroll
    for (int j = 0; j < 4; ++j) { const int n = (lane >> 3) + 8 * j; const LAS float* s = scr + (8 * c) * 33 + n;
        u32x4 o; o.x = cvt_pk_bf16(s[0 * 33], s[1 * 33]); o.y = cvt_pk_bf16(s[2 * 33], s[3 * 33]); o.z = cvt_pk_bf16(s[4 * 33], s[5 * 33]); o.w = cvt_pk_bf16(s[6 * 33], s[7 * 33]);
        *(u32x4*)(WT + (size_t)(drow + n) * K + k0 + 8 * c) = o; }
    LDS_WAIT(); asm volatile("" ::: "memory");
}
__device__ __forceinline__ void transpose_item(const float* W, int K, int N, bf16_t* WT, int item, bool qperm, LAS float* scr, int lane) {
    const int nblk = N / 32, kb = item / nblk, nb = item % nblk, n0 = 32 * nb;
    int drow = n0;
    if (qperm) { const int h = n0 / 192, e = n0 % 192; drow = (e < 128) ? h * 128 + e : 1024 + (h >> 2) * 256 + 128 * ((e - 128) >> 5) + 32 * (h & 3); }
    transpose_block(W, K, N, WT, 64 * kb, n0, drow, scr, lane);
}
__device__ __forceinline__ void ada_item(Frame& F, int item) {
    LOCAL_IDS();
    const int layer = item / 96, col0 = (item % 96) * 64, w = wave;
    LAS float* slab = (LAS float*)F.lds + w * 2560;
    const float* W = F.in[6] + (size_t)layer * 1024 * 6144;
    float acc[40];
#pragma unroll
    for (int b = 0; b < 40; ++b) acc[b] = 0.f;
    for (int hh = 0; hh < 2; ++hh) {
        const int kbase = 128 * w + 64 * hh;
#pragma unroll 8
        for (int b = 0; b < 40; ++b) { const float c = (b < NB_P ? F.in[4] + b * DM : F.in[5] + (b - NB_P) * DM)[kbase + lane];
            slab[lane * 40 + b] = c * __builtin_amdgcn_rcpf(1.f + __expf(-c)); }
        LDS_WAIT(); asm volatile("" ::: "memory");
        for (int kk = 0; kk < 64; ++kk) { const float wv = W[(size_t)(kbase + kk) * 6144 + col0 + lane];
#pragma unroll
            for (int b4 = 0; b4 < 10; ++b4) { const f32x4 s = *(const LAS f32x4*)(slab + kk * 40 + 4 * b4);
                acc[4 * b4 + 0] += s[0] * wv; acc[4 * b4 + 1] += s[1] * wv; acc[4 * b4 + 2] += s[2] * wv; acc[4 * b4 + 3] += s[3] * wv; } }
        LDS_WAIT(); asm volatile("" ::: "memory");
    }
    __syncthreads();
    LAS float* red = (LAS float*)F.lds;
#pragma unroll
    for (int b = 0; b < 40; ++b) red[(w * 40 + b) * 64 + lane] = acc[b];
    __syncthreads();
    float* MODF = (float*)(F.ws + WS_MODF) + (size_t)layer * 40 * 6144;
    const float* bias = F.in[7] + (size_t)layer * 6144;
    for (int o = tid; o < 2560; o += 512) { const int b = o >> 6, l = o & 63; float s = bias[col0 + l];
#pragma unroll
        for (int ww = 0; ww < 8; ++ww) s += red[(ww * 40 + b) * 64 + l];
        MODF[(size_t)b * 6144 + col0 + l] = s; }
    __syncthreads();
}
__device__ __forceinline__ void cvt8(const float* src, bf16_t* dst) {
    const f32x4 a = *(const f32x4*)src, b = *(const f32x4*)(src + 4);
    u32x4 w; w.x = cvt_pk_bf16(a[0], a[1]); w.y = cvt_pk_bf16(a[2], a[3]); w.z = cvt_pk_bf16(b[0], b[1]); w.w = cvt_pk_bf16(b[2], b[3]);
    *(u32x4*)dst = w;
}
__device__ __forceinline__ void p0_phase(Frame& F) {
    LOCAL_IDS();
    for (int it = blockIdx.x; it < 192; it += F.G) ada_item(F, it);
    LAS float* scr = (LAS float*)(F.lds + wave * 8704);
    const int gw = blockIdx.x * 8 + wave, NGW = F.G * 8;
    unsigned char* ws = F.ws;
    constexpr int I_WIN = 16 * 22, I_WQ = 6 * 48, I_WUK = 4 * 32, I_WO = 16 * 32, I_W1 = 16 * 128, I_W2 = 64 * 32, I_CWIN = 16 * 64;
    constexpr int NITEMS = I_WIN + I_WQ + 2 * I_WUK + I_WO + 2 * I_W1 + 2 * I_W2 + I_CWIN + I_WO;
    for (int it = gw; it < NITEMS; it += NGW) {
        int r = it;
        if (r < I_WIN) { transpose_item(F.in[12], 1024, 704, (bf16_t*)(ws + WS_WIN), r, false, scr, lane); continue; } r -= I_WIN;
        if (r < I_WQ) { transpose_item(F.in[15], 384, 1536, (bf16_t*)(ws + WS_WQ), r, true, scr, lane); continue; } r -= I_WQ;
        if (r < I_WUK) { transpose_item(F.in[16], 256, 1024, (bf16_t*)(ws + WS_WUK), r, false, scr, lane); continue; } r -= I_WUK;
        if (r < I_WUK) { transpose_item(F.in[17], 256, 1024, (bf16_t*)(ws + WS_WUV), r, false, scr, lane); continue; } r -= I_WUK;
        if (r < I_WO) { transpose_item(F.in[22], 1024, 1024, (bf16_t*)(ws + WS_WO), r, false, scr, lane); continue; } r -= I_WO;
        if (r < 2 * I_W1) { const int l = r / I_W1; transpose_item(F.in[10] + (size_t)l * 1024 * 4096, 1024, 4096, (bf16_t*)(ws + WS_W1) + (size_t)l * 4096 * 1024, r % I_W1, false, scr, lane); continue; } r -= 2 * I_W1;
        if (r < 2 * I_W2) { const int l = r / I_W2; transpose_item(F.in[11] + (size_t)l * 1024 * 4096, 4096, 1024, (bf16_t*)(ws + WS_W2) + (size_t)l * 4096 * 1024, r % I_W2, false, scr, lane); continue; } r -= 2 * I_W2;
        if (r < I_CWIN) { transpose_item(F.in[23], 1024, 2048, (bf16_t*)(ws + WS_CWIN), r, false, scr, lane); continue; } r -= I_CWIN;
        transpose_item(F.in[27], 1024, 1024, (bf16_t*)(ws + WS_CWO), r, false, scr, lane);
    }
    const long gt = (long)blockIdx.x * 512 + tid, NT = (long)F.G * 512;
    { const float* src = F.in[2]; bf16_t* dst = (bf16_t*)(ws + WS_CKV) + (size_t)MT * 256;
      for (long i = gt; i < (long)NCACHE * 256 / 8; i += NT) cvt8(src + i * 8, dst + i * 8); }
    { const float* src = F.in[3]; bf16_t* dst = (bf16_t*)(ws + WS_KPE);
      for (long i = gt; i < (long)NCACHE * 64 / 8; i += NT) cvt8(src + i * 8, dst + i * 8); }
    { const float* src = F.in[16]; const float* gk = F.in[20]; bf16_t* dst = (bf16_t*)(ws + WS_WUKN);
      for (long i = gt; i < 256 * 1024 / 8; i += NT) { const int d = (int)(i * 8) & 127;
          const f32x4 a = *(const f32x4*)(src + i * 8) * *(const f32x4*)(gk + d), b = *(const f32x4*)(src + i * 8 + 4) * *(const f32x4*)(gk + d + 4);
          u32x4 w; w.x = cvt_pk_bf16(a[0], a[1]); w.y = cvt_pk_bf16(a[2], a[3]); w.z = cvt_pk_bf16(b[0], b[1]); w.w = cvt_pk_bf16(b[2], b[3]);
          *(u32x4*)(dst + i * 8) = w; } }
}

__device__ __forceinline__ void xb_load(const bf16_t* p, f32x4& v) { const u32x2 w = *(const u32x2*)p; v = (f32x4){bflo(w.x), bfhi(w.x), bflo(w.y), bfhi(w.y)}; }
__device__ __forceinline__ void tail_row(Frame& F, int row, int lane, const float* tgate, const float* tbase, f32x4 (&v)[4], bool to_out) {
    const float* P = (const float*)(F.ws + WS_PBUF) + (size_t)(row - MP) * DM;
    bf16_t* XB = (bf16_t*)(F.ws + WS_V);
    const float* gp = tgate + (size_t)row_seq(row) * 6144;
#pragma unroll
    for (int j = 0; j < 4; ++j) { const int c = 4 * lane + 256 * j; f32x4 s = *(const f32x4*)(P + c);
#pragma unroll
        for (int k = 1; k < KSPL; ++k) s += *(const f32x4*)(P + (size_t)k * MS * DM + c);
        f32x4 base; if (tbase) base = *(const f32x4*)(tbase + (size_t)(row - MP) * DM + c); else xb_load(XB + (size_t)row * DM + c, base);
        v[j] = base + *(const f32x4*)(gp + c) * s;
        if (to_out) *(f32x4*)(F.out + (size_t)row * DM + c) = v[j];
        else { u32x2 w; w.x = cvt_pk_bf16(v[j][0], v[j][1]); w.y = cvt_pk_bf16(v[j][2], v[j][3]); *(u32x2*)(XB + (size_t)row * DM + c) = w; } }
}
template <int SRC> __device__ __forceinline__ void modnorm_phase(Frame& F, int layer, int which, const float* tgate, const float* tbase) {
    LOCAL_IDS();
    const int gw = blockIdx.x * 8 + wave, NGW = F.G * 8;
    const float* g = (which ? F.in[9] : F.in[8]) + layer * DM;
    const float* MODF = (const float*)(F.ws + WS_MODF) + (size_t)layer * 40 * 6144;
    bf16_t* H = (bf16_t*)(F.ws + WS_H);
    for (int row = gw; row < MT; row += NGW) {
        const float* xr = SRC == 0 ? (row < MP ? F.in[0] + (size_t)row * DM : F.in[1] + (size_t)(row - MP) * DM) : F.out + (size_t)row * DM;
        const float* md = MODF + (size_t)row_seq(row) * 6144 + which * 3072;
        f32x4 v[4]; float ss = 0.f;
        if (tgate != nullptr && row >= MP) tail_row(F, row, lane, tgate, tbase, v, false);
        else {
#pragma unroll
            for (int j = 0; j < 4; ++j) { if (SRC == 0) v[j] = *(const f32x4*)(xr + 4 * lane + 256 * j); else xb_load((const bf16_t*)(F.ws + WS_V) + (size_t)row * DM + 4 * lane + 256 * j, v[j]); } }
#pragma unroll
        for (int j = 0; j < 4; ++j) ss += (v[j][0] * v[j][0] + v[j][1] * v[j][1]) + (v[j][2] * v[j][2] + v[j][3] * v[j][3]);
        const float rs = __builtin_amdgcn_rsqf(wave_sum(ss) * (1.f / DM) + EPS);
#pragma unroll
        for (int j = 0; j < 4; ++j) { const int c = 4 * lane + 256 * j;
            const f32x4 gg = *(const f32x4*)(g + c), sh = *(const f32x4*)(md + c), sc = *(const f32x4*)(md + 1024 + c);
            const f32x4 o = v[j] * rs * gg * (sc + 1.f) + sh;
            u32x2 w; w.x = cvt_pk_bf16(o[0], o[1]); w.y = cvt_pk_bf16(o[2], o[3]);
            *(u32x2*)(H + (size_t)row * DM + c) = w; }
    }
}
__device__ __forceinline__ void final_tail_phase(Frame& F, const float* tgate) {
    LOCAL_IDS();
    const int gw = blockIdx.x * 8 + wave, NGW = F.G * 8;
    for (int row = MP + gw; row < MT; row += NGW) { f32x4 v[4]; tail_row(F, row, lane, tgate, nullptr, v, true); }
}

__device__ __forceinline__ void latent_phase(Frame& F) {
    LOCAL_IDS();
    const int gw = blockIdx.x * 8 + wave, NGW = F.G * 8;
    const bf16_t* A0 = (const bf16_t*)(F.ws + WS_A0);
    bf16_t* CQ = (bf16_t*)(F.ws + WS_CQ); bf16_t* CKV = (bf16_t*)(F.ws + WS_CKV); bf16_t* KR = (bf16_t*)(F.ws + WS_KR);
    const float* gqa = F.in[13]; const float* gkva = F.in[14]; const float* gkr = F.in[21];
    const float inv = rope_inv(lane & 31);
    for (int row = gw; row < MT; row += NGW) {
        const bf16_t* a = A0 + (size_t)row * 768;
        f32x2 q[3]; float s1 = 0.f;
#pragma unroll
        for (int j = 0; j < 3; ++j) { const unsigned w = *(const unsigned*)(a + 2 * lane + 128 * j); q[j] = (f32x2){bflo(w), bfhi(w)}; s1 += q[j][0] * q[j][0] + q[j][1] * q[j][1]; }
        f32x4 kv; { const u32x2 w = *(const u32x2*)(a + 384 + 4 * lane); kv = (f32x4){bflo(w.x), bfhi(w.x), bflo(w.y), bfhi(w.y)}; }
        float s2 = (kv[0] * kv[0] + kv[1] * kv[1]) + (kv[2] * kv[2] + kv[3] * kv[3]);
        const float kr = bf2f(a[640 + lane]); float s3 = kr * kr;
        s1 = wave_sum(s1); s2 = wave_sum(s2); s3 = wave_sum(s3);
        const float r1 = __builtin_amdgcn_rsqf(s1 * (1.f / 384.f) + EPS), r2 = __builtin_amdgcn_rsqf(s2 * (1.f / 256.f) + EPS), r3 = __builtin_amdgcn_rsqf(s3 * (1.f / 64.f) + EPS);
#pragma unroll
        for (int j = 0; j < 3; ++j) { const int c = 2 * lane + 128 * j; const f32x2 gg = *(const f32x2*)(gqa + c);
            *(unsigned*)(CQ + (size_t)row * 384 + c) = cvt_pk_bf16(q[j][0] * r1 * gg[0], q[j][1] * r1 * gg[1]); }
        { const f32x4 gg = *(const f32x4*)(gkva + 4 * lane); const f32x4 o = kv * r2 * gg;
          float* op = row < MP ? F.out + OUT_CKVP + (size_t)row * 256 : F.out + OUT_CKVS + (size_t)(row - MP) * 256;
          *(f32x4*)(op + 4 * lane) = o;
          u32x2 w; w.x = cvt_pk_bf16(o[0], o[1]); w.y = cvt_pk_bf16(o[2], o[3]);
          *(u32x2*)(CKV + (size_t)row * 256 + 4 * lane) = w; }
        { const float y = kr * r3 * gkr[lane]; const auto yy = __builtin_amdgcn_permlane32_swap(__float_as_uint(y), __float_as_uint(y), false, false); const float yo = __uint_as_float(lane < 32 ? yy[1] : yy[0]);
          float sn, cs; sincos_rev((float)row_pos(row) * inv, sn, cs);
          const float o = lane < 32 ? y * cs - yo * sn : y * cs + yo * sn;
          float* op = row < MP ? F.out + OUT_KPEP + (size_t)row * 64 : F.out + OUT_KPES + (size_t)(row - MP) * 64;
          op[lane] = o; KR[(size_t)row * 64 + lane] = f2bf(o); }
    }
}

namespace att {
#define SBAR() __builtin_amdgcn_sched_barrier(0)
constexpr float THR = 8.f;
__device__ __forceinline__ int crow(int r, int hi) { return (r & 3) + 8 * (r >> 2) + 4 * hi; }
__device__ __forceinline__ void partialSM(f32x16& p0, f32x16& p1, float& m_reg, float& mn, float& alpha) {
    constexpr float C = SM_SCALE * 1.4426950408889634f;
    float pmax = p0[0];
#pragma unroll
    for (int r = 1; r < 16; ++r) pmax = fmaxf(pmax, p0[r]);
#pragma unroll
    for (int r = 0; r < 16; ++r) pmax = fmaxf(pmax, p1[r]);
    { auto rr = __builtin_amdgcn_permlane32_swap(__float_as_uint(pmax), __float_as_uint(pmax), false, false);
      pmax = fmaxf(__uint_as_float(rr[0]), __uint_as_float(rr[1])); }
    if (__builtin_expect(__all(pmax - m_reg <= THR / SM_SCALE), 1)) { mn = m_reg; alpha = 1.f; }
    else { mn = fmaxf(m_reg, pmax); alpha = __builtin_amdgcn_exp2f((m_reg - mn) * C); m_reg = mn; }
    const float mnC = -mn * C;
#pragma unroll
    for (int r = 0; r < 16; ++r) p0[r] = fmaf(p0[r], C, mnC);
#pragma unroll
    for (int r = 0; r < 16; ++r) p1[r] = fmaf(p1[r], C, mnC);
#pragma unroll
    for (int r = 0; r < 16; ++r) p0[r] = __builtin_amdgcn_exp2f(p0[r]);
}
__device__ __forceinline__ void finishSM(f32x16& p0, f32x16& p1, float alpha, float& l_reg, bf16x8& pa0, bf16x8& pa1, bf16x8& pa2, bf16x8& pa3) {
#pragma unroll
    for (int r = 0; r < 16; ++r) p1[r] = __builtin_amdgcn_exp2f(p1[r]);
    float ps = 0;
#pragma unroll
    for (int r = 0; r < 16; ++r) ps += p0[r];
#pragma unroll
    for (int r = 0; r < 16; ++r) ps += p1[r];
    { auto rr = __builtin_amdgcn_permlane32_swap(__float_as_uint(ps), __float_as_uint(ps), false, false);
      ps = __uint_as_float(rr[0]) + __uint_as_float(rr[1]); }
    l_reg = l_reg * alpha + ps;
#define PK4(P, BASE, OUT) do { unsigned a0 = cvt_pk_bf16(P[BASE + 0], P[BASE + 1]), a1 = cvt_pk_bf16(P[BASE + 2], P[BASE + 3]);   \
    unsigned b0 = cvt_pk_bf16(P[BASE + 4], P[BASE + 5]), b1 = cvt_pk_bf16(P[BASE + 6], P[BASE + 7]);                              \
    auto r0 = __builtin_amdgcn_permlane32_swap(a0, b0, false, false); auto r1 = __builtin_amdgcn_permlane32_swap(a1, b1, false, false); \
    u32x4 w = {r0[0], r1[0], r0[1], r1[1]}; OUT = *reinterpret_cast<bf16x8*>(&w); } while (0)
    PK4(p0, 0, pa0); PK4(p0, 8, pa1); PK4(p1, 0, pa2); PK4(p1, 8, pa3);
#undef PK4
}
__device__ __forceinline__ int v_st(int k, int c) { const int kk = (k & ~0xC) | ((k & 4) << 1) | ((k & 8) >> 1); return ((kk >> 3) * 4 + (c >> 5)) * 512 + ((kk & 7) * 32 + (c & 31)) * 2; }
__device__ __forceinline__ int v_rd_base(int lane) { return ((lane & 3) << 3) | (((lane >> 2) & 3) << 6) | (((lane >> 4) & 1) << 5) | (((lane >> 5) & 1) << 8); }
constexpr int v_rd_off(int d0, int ks, int half) { return d0 * 512 + ks * 4096 + half * 2048; }
template <int OFF> __device__ __forceinline__ s16x4 tr_read(int vb) {
    s16x4 r; asm volatile("ds_read_b64_tr_b16 %0, %1 offset:%2" : "=&v"(r) : "v"(vb), "i"(OFF) : "memory"); return r;
}
template <int D0> __device__ __forceinline__ void pv_one(f32x16& od, int vb, bf16x8 pa0, bf16x8 pa1, bf16x8 pa2, bf16x8 pa3) {
    const s16x4 l0 = tr_read<v_rd_off(D0, 0, 0)>(vb), h0 = tr_read<v_rd_off(D0, 0, 1)>(vb), l1 = tr_read<v_rd_off(D0, 1, 0)>(vb), h1 = tr_read<v_rd_off(D0, 1, 1)>(vb);
    const s16x4 l2 = tr_read<v_rd_off(D0, 2, 0)>(vb), h2 = tr_read<v_rd_off(D0, 2, 1)>(vb), l3 = tr_read<v_rd_off(D0, 3, 0)>(vb), h3 = tr_read<v_rd_off(D0, 3, 1)>(vb);
    asm volatile("s_waitcnt lgkmcnt(0)" ::: "memory"); SBAR();
#define PK(L, H) (bf16x8){L[0], L[1], L[2], L[3], H[0], H[1], H[2], H[3]}
    od = __builtin_amdgcn_mfma_f32_32x32x16_bf16(pa0, PK(l0, h0), od, 0, 0, 0);
    od = __builtin_amdgcn_mfma_f32_32x32x16_bf16(pa1, PK(l1, h1), od, 0, 0, 0);
    od = __builtin_amdgcn_mfma_f32_32x32x16_bf16(pa2, PK(l2, h2), od, 0, 0, 0);
    od = __builtin_amdgcn_mfma_f32_32x32x16_bf16(pa3, PK(l3, h3), od, 0, 0, 0);
#undef PK
}
__device__ __forceinline__ void pv_d0(f32x16* o, int vb, bf16x8 pa0, bf16x8 pa1, bf16x8 pa2, bf16x8 pa3) {
    pv_one<0>(o[0], vb, pa0, pa1, pa2, pa3); pv_one<1>(o[1], vb, pa0, pa1, pa2, pa3); pv_one<2>(o[2], vb, pa0, pa1, pa2, pa3); pv_one<3>(o[3], vb, pa0, pa1, pa2, pa3);
}

constexpr int P_SHM_V = 64 * 128 * 2, P_SHM_K = 64 * 192 * 2;
#define KSWZ192(row, colB) ((row) * 384 + ((colB) ^ (((row) & 7) << 4)))
__device__ __forceinline__ void qkt192(f32x16& p0, f32x16& p1, const LAS char* Ks, const int (&ka)[4], const bf16x8* qr, const LAS char* QRl, int hi, bool vis) {
    if (vis) {
        p0 = f32x16{}; p1 = f32x16{};
#pragma unroll
        for (int d0 = 0; d0 < 12; ++d0) {
            const bf16x8 b0 = *reinterpret_cast<const LAS bf16x8*>(Ks + ka[d0 & 3] + (d0 >> 2) * 128);
            const bf16x8 b1 = *reinterpret_cast<const LAS bf16x8*>(Ks + ka[d0 & 3] + (d0 >> 2) * 128 + 32 * 384);
            const bf16x8 qf = d0 < 8 ? qr[d0 < 8 ? d0 : 0] : *reinterpret_cast<const LAS bf16x8*>(QRl + ((d0 - 8) * 16 + hi * 8) * 2);
            p0 = __builtin_amdgcn_mfma_f32_32x32x16_bf16(b0, qf, p0, 0, 0, 0);
            p1 = __builtin_amdgcn_mfma_f32_32x32x16_bf16(b1, qf, p1, 0, 0, 0); }
    } else {
#pragma unroll
        for (int r = 0; r < 16; ++r) { p0[r] = -1e30f; p1[r] = -1e30f; }
    }
}
__device__ __forceinline__ void prompt_unit(int b, int h, int qb, const bf16_t* __restrict__ Q, const bf16_t* __restrict__ KN, const bf16_t* __restrict__ KR,
                                            const bf16_t* __restrict__ V, bf16_t* __restrict__ O, LAS char* lds) {
    int tid_l_ = threadIdx.x; asm volatile("" : "+v"(tid_l_));
    const int tid = tid_l_, wid = tid >> 6, lane = tid & 63, r32 = lane & 31, hi = lane >> 5;
    LAS char* V_lds = lds; LAS char* K_lds = lds + 2 * P_SHM_V;
    LAS float* wsc = (LAS float*)(lds + 2 * P_SHM_V + 2 * P_SHM_K) + wid * 64; LAS float* li_l = wsc; LAS float* al_l = wsc + 32;
    float m_reg = -1e30f, l_reg = 0; f32x16 o[4] = {}; bf16x8 qr[8];
    LAS char* QRl = lds + 2 * P_SHM_V + 2 * P_SHM_K + 2048 + wid * 4608 + r32 * 144;
    const size_t rowbase = (size_t)b * SEQ;
    const bf16_t* Qw = Q + (rowbase + qb * 256 + wid * 32 + r32) * 1536 + h * 192 + hi * 8;
#pragma unroll
    for (int d0 = 0; d0 < 8; ++d0) qr[d0] = *reinterpret_cast<const bf16x8*>(Qw + d0 * 16);
#pragma unroll
    for (int d0 = 8; d0 < 12; ++d0) *reinterpret_cast<LAS bf16x8*>(QRl + ((d0 - 8) * 16 + hi * 8) * 2) = *reinterpret_cast<const bf16x8*>(Qw + d0 * 16);
    int ka[4];
#pragma unroll
    for (int k = 0; k < 4; ++k) ka[k] = r32 * 384 + ((k * 32 + hi * 16) ^ ((r32 & 7) << 4));
    const int cw = 4 * qb + (wid >> 1);
    const int sr = tid >> 4, sc = (tid & 15) * 8, vst0 = v_st(sr, sc), vst1 = v_st(32 + sr, sc), krr = tid >> 3, krc = (tid & 7) * 8;
    const int vb0 = (int)(uintptr_t)V_lds + v_rd_base(lane);
    const bf16_t* Vh = V + rowbase * 1024 + h * 128; const bf16_t* Kh = KN + rowbase * 1024 + h * 128; const bf16_t* Rh = KR + rowbase * 64;
    struct { bf16x8 vs0, vs1, ks0, ks1, kr; } sr_[1];
#define SLOAD(i, k0) do { sr_[i].vs0 = *reinterpret_cast<const bf16x8*>(&Vh[(size_t)((k0) + sr) * 1024 + sc]); sr_[i].vs1 = *reinterpret_cast<const bf16x8*>(&Vh[(size_t)((k0) + 32 + sr) * 1024 + sc]); \
    sr_[i].ks0 = *reinterpret_cast<const bf16x8*>(&Kh[(size_t)((k0) + sr) * 1024 + sc]); sr_[i].ks1 = *reinterpret_cast<const bf16x8*>(&Kh[(size_t)((k0) + 32 + sr) * 1024 + sc]); \
    sr_[i].kr = *reinterpret_cast<const bf16x8*>(&Rh[(size_t)((k0) + krr) * 64 + krc]); } while (0)
#define SWRITE(bb, i) do { *(LAS bf16x8*)(V_lds + (bb) * P_SHM_V + vst0) = sr_[i].vs0; *(LAS bf16x8*)(V_lds + (bb) * P_SHM_V + vst1) = sr_[i].vs1; const int kc = sc * 2; \
    *(LAS bf16x8*)(K_lds + (bb) * P_SHM_K + KSWZ192(sr, kc)) = sr_[i].ks0; *(LAS bf16x8*)(K_lds + (bb) * P_SHM_K + KSWZ192(32 + sr, kc)) = sr_[i].ks1; \
    *(LAS bf16x8*)(K_lds + (bb) * P_SHM_K + KSWZ192(krr, 256 + krc * 2)) = sr_[i].kr; } while (0)
#define SWAIT() asm volatile("s_waitcnt vmcnt(0)" ::: "memory")
#define RESC(a) do { if (__any((a) < 1.f)) { if (hi == 0) al_l[r32] = (a); asm volatile("s_waitcnt lgkmcnt(0)" ::: "memory"); \
    _Pragma("unroll") for (int d = 0; d < 4; ++d) _Pragma("unroll") for (int r = 0; r < 16; ++r) o[d][r] *= al_l[crow(r, hi)]; } } while (0)
    f32x16 pA0, pA1, pB0, pB1; float mnA, mnB, alA, alB; bf16x8 pa0, pa1, pa2, pa3; const int NT = 4 * qb + 4;
    constexpr int SE = 0, SO = 0;
    SLOAD(SE, 0); asm volatile("s_waitcnt vmcnt(0)" ::: "memory"); SWRITE(0, SE); __syncthreads();
    qkt192(pA0, pA1, K_lds, ka, qr, QRl, hi, true); partialSM(pA0, pA1, m_reg, mnA, alA);
    SLOAD(SO, 64);
    SWAIT(); SWRITE(1, SO); __syncthreads();
    for (int j = 1; j + 1 < NT; j += 2) {
        SBAR(); qkt192(pB0, pB1, K_lds + P_SHM_K, ka, qr, QRl, hi, j <= cw);
        finishSM(pA0, pA1, alA, l_reg, pa0, pa1, pa2, pa3); SBAR();
        SLOAD(SO, (j + 1) * 64); SBAR();
        if (j - 1 <= cw) pv_d0(o, vb0, pa0, pa1, pa2, pa3);
        partialSM(pB0, pB1, m_reg, mnB, alB);
        __syncthreads(); SWAIT(); SWRITE(0, SE);
        RESC(alB); __syncthreads();
        SBAR(); qkt192(pA0, pA1, K_lds, ka, qr, QRl, hi, j + 1 <= cw);
        finishSM(pB0, pB1, alB, l_reg, pa0, pa1, pa2, pa3); SBAR();
        SLOAD(SE, (j + 2) * 64); SBAR();
        if (j <= cw) pv_d0(o, vb0 + P_SHM_V, pa0, pa1, pa2, pa3);
        partialSM(pA0, pA1, m_reg, mnA, alA);
        __syncthreads(); SWAIT(); SWRITE(1, SO);
        RESC(alA); __syncthreads();
    }
    SBAR(); qkt192(pB0, pB1, K_lds + P_SHM_K, ka, qr, QRl, hi, NT - 1 <= cw);
    finishSM(pA0, pA1, alA, l_reg, pa0, pa1, pa2, pa3); SBAR();
    if (NT - 2 <= cw) pv_d0(o, vb0, pa0, pa1, pa2, pa3);
    partialSM(pB0, pB1, m_reg, mnB, alB);
    __syncthreads(); RESC(alB);
    finishSM(pB0, pB1, alB, l_reg, pa0, pa1, pa2, pa3); SBAR();
    if (NT - 1 <= cw) pv_d0(o, vb0 + P_SHM_V, pa0, pa1, pa2, pa3);
    if (hi == 0) li_l[r32] = l_reg; asm volatile("s_waitcnt lgkmcnt(0)" ::: "memory");
    float rli[16];
#pragma unroll
    for (int r = 0; r < 16; ++r) rli[r] = __builtin_amdgcn_rcpf(li_l[crow(r, hi)]);
    bf16_t* Ow = O + (rowbase + qb * 256 + wid * 32) * 1024 + h * 128;
#pragma unroll
    for (int r = 0; r < 16; ++r) { const int orow = crow(r, hi);
#pragma unroll
        for (int d0 = 0; d0 < 4; ++d0) Ow[(size_t)orow * 1024 + d0 * 32 + r32] = f2bf(o[d0][r] * rli[r]); }
    __syncthreads();
#undef SLOAD
#undef SWRITE
#undef SWAIT
#undef RESC
}

constexpr int S_QP = 264;
constexpr int S_OFF_Q = 0, S_OFF_K = 8 * 16 * S_QP * 2  , S_OFF_V = S_OFF_K + 64 * 640  , S_OFF_RS = S_OFF_V + 32768, S_OFF_SC = S_OFF_RS + 2048  , S_END = S_OFF_SC + 2048;
static_assert(S_END <= LDS_MISC, "sample LDS map");
#define KSWZ320(row, colB) ((row) * 640 + ((colB) ^ (((row) & 7) << 4)))
__device__ __forceinline__ void sample_unit(int sb, int sp, const bf16_t* __restrict__ Q, const bf16_t* __restrict__ WUKN, const bf16_t* __restrict__ CKV, const bf16_t* __restrict__ KPE,
                                            const bf16_t* __restrict__ KR, const float* __restrict__ RS, float* __restrict__ PART, float* __restrict__ ML, LAS char* lds) {
    int tid_l_ = threadIdx.x; asm volatile("" : "+v"(tid_l_));
    const int tid = tid_l_, h = tid >> 6, lane = tid & 63, r32 = lane & 31, hi = lane >> 5, q16 = r32 & 15;
    LAS char* Q_lds = lds + S_OFF_Q + h * (16 * S_QP * 2); LAS char* K_lds = lds + S_OFF_K; LAS char* V_lds = lds + S_OFF_V;
    LAS float* rs_lds = (LAS float*)(lds + S_OFF_RS); LAS float* al_l = (LAS float*)(lds + S_OFF_SC) + h * 64;
    const size_t qrow = (size_t)MP + sb * 16 + q16;
    {
        bf16x8 qa[8];
#pragma unroll
        for (int ks = 0; ks < 8; ++ks) qa[ks] = *reinterpret_cast<const bf16x8*>(Q + qrow * 1536 + h * 192 + ks * 16 + hi * 8);
        LAS char* qw = Q_lds + ((4 * hi) * S_QP + r32) * 2;
        const bf16_t* wp = WUKN + (size_t)r32 * 1024 + h * 128 + hi * 8;
#pragma unroll 1
        for (int nb = 0; nb < 8; ++nb) {
            f32x16 acc = {};
#pragma unroll
            for (int ks = 0; ks < 8; ++ks) { const bf16x8 wb = *reinterpret_cast<const bf16x8*>(wp + ks * 16);
                acc = __builtin_amdgcn_mfma_f32_32x32x16_bf16(qa[ks], wb, acc, 0, 0, 0); }
#pragma unroll
            for (int r = 0; r < 8; ++r) *(LAS bf16_t*)(qw + (((r & 3) + 8 * (r >> 2)) * S_QP) * 2) = f2bf(acc[r]);
            qw += 64; wp += 32 * 1024;
        }
    }
    __syncthreads();
    const int hp = h & 3, vh = h >> 2, hl = 2 * hp + (r32 >> 4);
    bf16x8 qrp[4];
#pragma unroll
    for (int d0 = 0; d0 < 4; ++d0) qrp[d0] = *reinterpret_cast<const bf16x8*>(Q + qrow * 1536 + hl * 192 + 128 + d0 * 16 + hi * 8);
    float m_reg = -1e30f, l_reg = 0; f32x16 o[4] = {};
    const int vb0 = (int)(uintptr_t)V_lds + vh * 16384 + v_rd_base(lane);
    const int ntile = (sp == NSPLIT - 1) ? 17 : 16;
    const int krr = tid >> 3, krc = (tid & 7) * 8;
    const int skey = tid >> 5, cc = (tid & 31) * 8;
    LAS char* kst = K_lds + skey * 640 + ((cc * 2) ^ ((skey & 7) << 4));
    LAS char* vst = V_lds + (cc >> 7) * 16384 + v_st(skey, cc & 127);
    LAS char* krst = K_lds + krr * 640 + ((512 + krc * 2) ^ ((krr & 7) << 4));
    int ka[4];
#pragma unroll
    for (int k = 0; k < 4; ++k) ka[k] = r32 * 640 + ((k * 32 + hi * 16) ^ ((r32 & 7) << 4));
    const LAS char* qfp = lds + S_OFF_Q + hl * (16 * S_QP * 2) + (q16 * S_QP + hi * 8) * 2;
    const LAS float* rsp = rs_lds + (4 * hi) * 8 + hl;
    bf16x8 c[4], kr; float rsv;
#define S_LOAD(T) do { const bool nw_ = ((T) == 16); \
        const size_t crow0 = nw_ ? (size_t)MP + sb * 16 : (size_t)MT + (size_t)sb * PAST + sp * 1024 + (T) * 64; \
        const bf16_t* rsrc = nw_ ? KR + ((size_t)MP + sb * 16) * 64 : KPE + ((size_t)sb * PAST + sp * 1024 + (T) * 64) * 64; \
        _Pragma("unroll") for (int i = 0; i < 4; ++i) { const int key = skey + 16 * i; \
            c[i] = (!nw_ || key < 16) ? *reinterpret_cast<const bf16x8*>(CKV + (crow0 + key) * 256 + cc) : bf16x8{}; } \
        kr = (!nw_ || krr < 16) ? *reinterpret_cast<const bf16x8*>(rsrc + (size_t)krr * 64 + krc) : bf16x8{}; \
        rsv = (!nw_ || krr < 16) ? RS[(crow0 + krr) * 8 + (tid & 7)] : 0.f; } while (0)
    S_LOAD(0);
#pragma unroll 1
    for (int t = 0; t < ntile; ++t) {
        const bool isnew = (t == 16);
        __syncthreads();
#pragma unroll
        for (int i = 0; i < 4; ++i) { *(LAS bf16x8*)(kst + i * 16 * 640) = c[i];
            *(LAS bf16x8*)(vst + i * 4096) = c[i]; }
        *(LAS bf16x8*)krst = kr;
        rs_lds[krr * 8 + (tid & 7)] = rsv;
        __syncthreads();
        if (t + 1 < ntile) S_LOAD(t + 1);
        SBAR();
        f32x16 p0 = {}, p1 = {};
#pragma unroll
        for (int d0 = 0; d0 < 16; ++d0) { if ((d0 & 3) == 0) SBAR();
            const bf16x8 b0 = *reinterpret_cast<const LAS bf16x8*>(K_lds + ka[d0 & 3] + (d0 >> 2) * 128);
            const bf16x8 b1 = *reinterpret_cast<const LAS bf16x8*>(K_lds + ka[d0 & 3] + (d0 >> 2) * 128 + 32 * 640);
            const bf16x8 qf = *reinterpret_cast<const LAS bf16x8*>(qfp + d0 * 32);
            p0 = __builtin_amdgcn_mfma_f32_32x32x16_bf16(b0, qf, p0, 0, 0, 0);
            p1 = __builtin_amdgcn_mfma_f32_32x32x16_bf16(b1, qf, p1, 0, 0, 0); }
        SBAR();
#pragma unroll
        for (int r = 0; r < 16; ++r) { p0[r] *= rsp[((r & 3) + 8 * (r >> 2)) * 8]; p1[r] *= rsp[(32 + (r & 3) + 8 * (r >> 2)) * 8]; }
#pragma unroll
        for (int d0 = 0; d0 < 4; ++d0) {
            const bf16x8 b0 = *reinterpret_cast<const LAS bf16x8*>(K_lds + ka[d0] + 512);
            const bf16x8 b1 = *reinterpret_cast<const LAS bf16x8*>(K_lds + ka[d0] + 512 + 32 * 640);
            p0 = __builtin_amdgcn_mfma_f32_32x32x16_bf16(b0, qrp[d0], p0, 0, 0, 0);
            p1 = __builtin_amdgcn_mfma_f32_32x32x16_bf16(b1, qrp[d0], p1, 0, 0, 0); }
        if (isnew) {
#pragma unroll
            for (int r = 0; r < 16; ++r) { if (r >= 8) p0[r] = -1e30f; p1[r] = -1e30f; }
        }
        float mn, al; bf16x8 pa0, pa1, pa2, pa3;
        partialSM(p0, p1, m_reg, mn, al);
        finishSM(p0, p1, al, l_reg, pa0, pa1, pa2, pa3);
        if (__any(al < 1.f)) { if (hi == 0) al_l[r32] = al; asm volatile("s_waitcnt lgkmcnt(0)" ::: "memory");
#pragma unroll
            for (int d = 0; d < 4; ++d)
#pragma unroll
                for (int r = 0; r < 16; ++r) o[d][r] *= al_l[crow(r, hi)]; }
        pv_d0(o, vb0, pa0, pa1, pa2, pa3);
    }
    const size_t ubase = ((size_t)sb * NSPLIT + sp) * 8;
    if (vh == 0 && lane < 32) { const size_t pb = (ubase + hl) * 16 + q16; ML[pb * 2] = m_reg; ML[pb * 2 + 1] = l_reg; }
#pragma unroll
    for (int r = 0; r < 16; ++r) { const int row = crow(r, hi); const size_t pb = (ubase + 2 * hp + (row >> 4)) * 16 + (row & 15);
#pragma unroll
        for (int d = 0; d < 4; ++d) PART[pb * 256 + vh * 128 + d * 32 + r32] = o[d][r]; }
    __syncthreads();
#undef S_LOAD
}
}

__device__ __forceinline__ void attention_phase(Frame& F, unsigned* ctr, bool ctr_is_second = false) {
    LOCAL_IDS();
    volatile LAS unsigned* misc = (volatile LAS unsigned*)(F.lds + LDS_MISC);
    const bf16_t* Q = (const bf16_t*)(F.ws + WS_A0); const bf16_t* KN = (const bf16_t*)(F.ws + WS_KN); const bf16_t* KR = (const bf16_t*)(F.ws + WS_KR);
    const bf16_t* V = (const bf16_t*)(F.ws + WS_V); bf16_t* O = (bf16_t*)(F.ws + WS_H);
    constexpr int NSU = NB_S * NSPLIT, NPU = NB_P * NH * 16;
    for (;;) {
        __syncthreads();
        if (tid == 0) misc[0] = atomicAdd(ctr, 1u);
        __syncthreads();
        const int unit = (int)misc[0];
#ifdef REP_SAMPLE_ONLY
        if (unit >= (ctr_is_second ? NSU : NSU + NPU)) break;
#else
        if (unit >= NSU + NPU) break;
#endif
        if (unit < NSU) {
#ifndef NO_SAMPLE
            att::sample_unit(unit >> 2, unit & 3, Q, (const bf16_t*)(F.ws + WS_WUKN), (const bf16_t*)(F.ws + WS_CKV), (const bf16_t*)(F.ws + WS_KPE), KR,
                             (const float*)(F.ws + WS_RS), (float*)(F.ws + WS_PART), (float*)(F.ws + WS_ML), (LAS char*)F.lds);
#endif
        } else {
#ifndef NO_PROMPT
#ifdef ORDER_BH
            const int pu = unit - NSU, qb = 15 - (pu & 15), bh = pu >> 4;
#else
            const int pu = unit - NSU, qb = 15 - pu / 64, bh = pu % 64;
#endif
            att::prompt_unit(bh >> 3, bh & 7, qb, Q, KN, KR, V, O, (LAS char*)F.lds);
#endif
        }
    }
}

__device__ __forceinline__ void combine_phase(Frame& F) {
    LOCAL_IDS();
    const int gw = blockIdx.x * 8 + wave, NGW = F.G * 8;
    LAS float* ol = (LAS float*)(F.lds + wave * 16384);
    const float* PART = (const float*)(F.ws + WS_PART); const float* ML = (const float*)(F.ws + WS_ML); const float* wuv = F.in[17];
    bf16_t* O = (bf16_t*)(F.ws + WS_H);
    constexpr float C = SM_SCALE * 1.4426950408889634f;
    for (int item = gw; item < NB_S * NH; item += NGW) {
        const int sb = item >> 3, h = item & 7;
        for (int q = 0; q < 16; ++q) {
            float m[NSPLIT], l[NSPLIT], mx = -1e30f;
#pragma unroll
            for (int s = 0; s < NSPLIT; ++s) { const size_t pb = ((((size_t)sb * NSPLIT + s) * 8 + h) * 16 + q); m[s] = ML[pb * 2]; l[s] = ML[pb * 2 + 1]; mx = fmaxf(mx, m[s]); }
            float L = 0.f; f32x4 acc = {0.f, 0.f, 0.f, 0.f};
#pragma unroll
            for (int s = 0; s < NSPLIT; ++s) { const size_t pb = ((((size_t)sb * NSPLIT + s) * 8 + h) * 16 + q); const float f = __builtin_amdgcn_exp2f((m[s] - mx) * C);
                L += f * l[s]; acc += *(const f32x4*)(PART + pb * 256 + 4 * lane) * f; }
#ifdef E1_TEST
            *(LAS f32x4*)(ol + q * 256 + 4 * lane) = (f32x4){0.001f * (q + lane), 0.002f, 0.003f * sb, 0.004f * h};
#else
            *(LAS f32x4*)(ol + q * 256 + 4 * lane) = acc * (1.f / L);
#endif
        }
        LDS_WAIT(); asm volatile("" ::: "memory");
        float a0[16], a1[16];
#pragma unroll
        for (int q = 0; q < 16; ++q) { a0[q] = 0.f; a1[q] = 0.f; }
        for (int l4 = 0; l4 < 64; ++l4) {
            float w0[4], w1[4];
#pragma unroll
            for (int t = 0; t < 4; ++t) { w0[t] = wuv[(size_t)(4 * l4 + t) * 1024 + h * 128 + lane]; w1[t] = wuv[(size_t)(4 * l4 + t) * 1024 + h * 128 + 64 + lane]; }
#pragma unroll
            for (int q = 0; q < 16; ++q) { const f32x4 x = *(const LAS f32x4*)(ol + q * 256 + 4 * l4);
                a0[q] += x[0] * w0[0] + x[1] * w0[1] + x[2] * w0[2] + x[3] * w0[3]; a1[q] += x[0] * w1[0] + x[1] * w1[1] + x[2] * w1[2] + x[3] * w1[3]; }
        }
#pragma unroll
        for (int q = 0; q < 16; ++q) { bf16_t* op = O + ((size_t)MP + sb * 16 + q) * 1024 + h * 128; op[lane] = f2bf(a0[q]); op[64 + lane] = f2bf(a1[q]); }
        LDS_WAIT(); asm volatile("" ::: "memory");
    }
}

__device__ __forceinline__ void sgu_phase(Frame& F) {
    LOCAL_IDS();
    const int wid = wave, r32 = lane & 31, hi = lane >> 5;
    LAS float* rsv_l = (LAS float*)F.lds;
    const bf16_t* VT = (const bf16_t*)(F.ws + WS_VT); const bf16_t* U = (const bf16_t*)(F.ws + WS_U); bf16_t* Gt = (bf16_t*)(F.ws + WS_G);
    const float* SSV = (const float*)(F.ws + WS_SSV); const float* ws_ = F.in[25]; const float* bs = F.in[26]; const float* gv = F.in[24];
    const int mb = wid & 3, nb0 = (wid >> 2) * 2;
    for (int unit = blockIdx.x; unit < 288 * 8; unit += F.G) {
        const int ch = unit >> 3, g = unit & 7; const bool smp = ch >= 256;
        const int tok0 = smp ? MP + (ch - 256) * 16 : ch * 128, ntok = smp ? 16 : 128;
        const bool active = !smp || mb == 0;
        const int ksteps = smp ? 1 : (mb < 2 ? 4 : 8);
        float ssp[8];
        if (tid < 128) {
#pragma unroll
            for (int p = 0; p < 8; ++p) ssp[p] = (tid < ntok) ? SSV[(size_t)p * VTP + tok0 + tid] : 0.f; }
        bf16x8 b0[8], b1[8]; bf16_t uv0[16], uv1[16];
        const int c0 = g * 128 + nb0 * 32 + r32;
        const float* wrow = ws_ + (size_t)g * 16384 + (size_t)(32 * mb + r32) * 128 + hi * 8;
        if (active) {
            const bf16_t* v0p = VT + (size_t)c0 * VTP + tok0 + hi * 8; const bf16_t* v1p = v0p + (size_t)32 * VTP;
#pragma unroll
            for (int ks = 0; ks < 8; ++ks) if (ks < ksteps) {
                b0[ks] = *reinterpret_cast<const bf16x8*>(v0p + ks * 16); b1[ks] = *reinterpret_cast<const bf16x8*>(v1p + ks * 16); }
        }
        if (tid < 128) { float s = ((ssp[0] + ssp[1]) + (ssp[2] + ssp[3])) + ((ssp[4] + ssp[5]) + (ssp[6] + ssp[7]));
            rsv_l[tid] = (tid < ntok) ? __builtin_amdgcn_rsqf(s * (1.f / 1024.f) + EPS) : 0.f; }
        __syncthreads();
        if (active) {
#pragma unroll
            for (int r = 0; r < 16; ++r) { const int i = 32 * mb + att::crow(r, hi);
                if (i < ntok) { const size_t tok = (size_t)tok0 + i; uv0[r] = U[tok * 1024 + c0]; uv1[r] = U[tok * 1024 + c0 + 32]; } }
            f32x16 acc0 = {}, acc1 = {};
#pragma unroll
            for (int ks = 0; ks < 8; ++ks) if (ks < ksteps) { const int j0 = ks * 16 + hi * 8;
                const f32x4 ra = *(const LAS f32x4*)(rsv_l + j0), rb = *(const LAS f32x4*)(rsv_l + j0 + 4);
                const f32x4 xa = *(const f32x4*)(wrow + ks * 16) * ra, xb = *(const f32x4*)(wrow + ks * 16 + 4) * rb;
                u32x4 aw; aw.x = cvt_pk_bf16(xa[0], xa[1]); aw.y = cvt_pk_bf16(xa[2], xa[3]); aw.z = cvt_pk_bf16(xb[0], xb[1]); aw.w = cvt_pk_bf16(xb[2], xb[3]);
                const bf16x8 af = *reinterpret_cast<bf16x8*>(&aw);
                acc0 = __builtin_amdgcn_mfma_f32_32x32x16_bf16(af, b0[ks], acc0, 0, 0, 0);
                acc1 = __builtin_amdgcn_mfma_f32_32x32x16_bf16(af, b1[ks], acc1, 0, 0, 0); }
            const float g0 = gv[c0], g1 = gv[c0 + 32];
#pragma unroll
            for (int r = 0; r < 16; ++r) { const int i = 32 * mb + att::crow(r, hi);
                if (i < ntok) { const size_t tok = (size_t)tok0 + i; const float bias = bs[g * 128 + i];
                    Gt[tok * 1024 + c0] = f2bf(bf2f(uv0[r]) * (acc0[r] * g0 + bias));
                    Gt[tok * 1024 + c0 + 32] = f2bf(bf2f(uv1[r]) * (acc1[r] * g1 + bias)); } }
        }
        if (smp) {
            for (int idx = tid; idx < 2048; idx += 512) { const int t = idx >> 7, c = g * 128 + (idx & 127);
                F.out[OUT_VS + (size_t)((ch - 256) * 16 + t) * 1024 + c] = bf2f(VT[(size_t)c * VTP + tok0 + t]) * rsv_l[t] * gv[c]; }
        }
        __syncthreads();
    }
}

#define XB_TMO      128
#define XB_XCNT(j)  (256  + 64 * (j))
#define XB_XSUB(j)  (1280 + 64 * (j))
#define XB_XGEN(j)  (2304 + 64 * (j))
#define XB_TOP      3328
#define XB_TOPGEN   3392
#define XCD_BAR_WORDS 3456
#define XB_SPIN_CAP (1u << 18)

__device__ __forceinline__ unsigned xb_ld(unsigned* p)              { return __hip_atomic_load(p, __ATOMIC_RELAXED, __HIP_MEMORY_SCOPE_AGENT); }
__device__ __forceinline__ unsigned xb_add(unsigned* p, unsigned v) { return __hip_atomic_fetch_add(p, v, __ATOMIC_RELAXED, __HIP_MEMORY_SCOPE_AGENT); }
__device__ __forceinline__ unsigned xb_xcc_id() { return (unsigned)__builtin_amdgcn_s_getreg((3 << 11) | 20) & 0xFu; }
#define XB_SPIN(cond, bar) do { unsigned _sp = 0; while (cond) { __builtin_amdgcn_s_sleep(1); \
    if ((++_sp & 255u) == 0u) { if (xb_ld(&(bar)[XB_TMO])) break; if (_sp > XB_SPIN_CAP) { atomicAdd(&(bar)[XB_TMO], 1u); break; } } } } while (0)

struct XcdBarrier {
    unsigned* bar; unsigned x;
    volatile LAS unsigned* st;
};

__device__ __forceinline__ XcdBarrier xcd_barrier_post(unsigned* bar, volatile LAS unsigned* st) {
    XcdBarrier b; b.bar = bar; b.x = xb_xcc_id(); b.st = st;
    if (threadIdx.x == 0) (void)xb_add(&bar[XB_XCNT(b.x)], 1u);
    return b;
}
__device__ __forceinline__ void xcd_barrier_complete(unsigned* bar, unsigned x, unsigned& nloc, unsigned& nx) {
    const unsigned G = gridDim.x * gridDim.y * gridDim.z;
    unsigned sum, cnt, mine, sp = 0u;
    for (;;) {
        sum = 0u; cnt = 0u; mine = 0u;
#pragma unroll
        for (unsigned j = 0; j < 16; ++j) { const unsigned c = xb_ld(&bar[XB_XCNT(j)]); sum += c; cnt += (c > 0u) ? 1u : 0u; mine = (j == x) ? c : mine; }
        if (sum == G) break;
        __builtin_amdgcn_s_sleep(1);
        if ((++sp & 255u) == 0u) { if (xb_ld(&bar[XB_TMO])) break; if (sp > XB_SPIN_CAP) { atomicAdd(&bar[XB_TMO], 1u); break; } }
    }
    nloc = mine > 0u ? mine : 1u; nx = cnt > 0u ? cnt : 1u;
}

__device__ __forceinline__ void xcd_barrier(const XcdBarrier& b) {
    asm volatile("s_waitcnt vmcnt(0)" ::: "memory");
    __syncthreads();
    if (threadIdx.x == 0) {
        unsigned* bar = b.bar;
        __builtin_amdgcn_s_waitcnt(0);
        unsigned nloc = b.st[0], nx = b.st[1];
        if (nloc == 0u) { xcd_barrier_complete(bar, b.x, nloc, nx); b.st[0] = nloc; b.st[1] = nx; }
        const unsigned old = xb_add(&bar[XB_XSUB(b.x)], 1u);
        const unsigned gen = old / nloc;
        if (old + 1u == (gen + 1u) * nloc) {
            __builtin_amdgcn_fence(__ATOMIC_RELEASE, "agent");
            asm volatile("s_waitcnt vmcnt(0)" ::: "memory");
            const unsigned og = xb_add(&bar[XB_TOP], 1u);
            const unsigned tg = og / nx;
            if (og + 1u == (tg + 1u) * nx) xb_add(&bar[XB_TOPGEN], 1u);
            else XB_SPIN(xb_ld(&bar[XB_TOPGEN]) == tg, bar);
            __builtin_amdgcn_fence(__ATOMIC_ACQUIRE, "agent");
            xb_add(&bar[XB_XGEN(b.x)], 1u);
            asm volatile("s_waitcnt vmcnt(0)" ::: "memory");
        } else {
            XB_SPIN(xb_ld(&bar[XB_XGEN(b.x)]) == gen, bar);
            __builtin_amdgcn_fence(__ATOMIC_ACQUIRE, "agent");
            asm volatile("s_waitcnt vmcnt(0)" ::: "memory");
        }
    }
    __syncthreads();
}

typedef EpiResidB<true, false> RB_TF; typedef EpiResidB<false, false> RB_FF; typedef EpiResidB<false, true> RB_FT;
constexpr int N_PHASES = 19;
__global__ void __launch_bounds__(512, 2) fwd_megakernel(Args args) {
    extern __shared__ __attribute__((aligned(16))) unsigned char lds_raw[];
    cg::grid_group grid = cg::this_grid();
    Frame F;
    F.lds = (LAS unsigned char*)lds_raw;
    F.G = gridDim.x;
    F.in = args.in; F.out = args.out; F.ws = args.ws;
    unsigned char* ws = args.ws;
    const int lo = args.ph_lo, hi = args.ph_hi;
    { volatile LAS unsigned* st = (volatile LAS unsigned*)(F.lds + LDS_MISC + 16); if (threadIdx.x < 2) st[threadIdx.x] = 0u; __syncthreads(); }
    XcdBarrier xbar = xcd_barrier_post((unsigned*)(ws + WS_CTL + 4096), (volatile LAS unsigned*)(F.lds + LDS_MISC + 16));
    LAS float* red = (LAS float*)(F.lds + LDS_RED);
    const float* MODF = (const float*)(ws + WS_MODF);
#ifndef PHASE_MASK
#define PHASE_MASK 0xFFFFFFFFu
#endif
#define PH(k) ((((PHASE_MASK) >> (k)) & 1u) && lo <= (k) && (k) < hi)
#ifndef REPEAT_MASK
#define REPEAT_MASK 0u
#endif
#define REP(k) for (int rep_ = 0; rep_ < 1 + (int)(((REPEAT_MASK) >> (k)) & 1u); ++rep_)
#define SEAM(k) do { if (PH(k) && PH((k) + 1)) { if ((k) == 0) { \
        asm volatile("s_waitcnt vmcnt(0) lgkmcnt(0)" ::: "memory"); __syncthreads(); \
        if (threadIdx.x == 0) { __builtin_amdgcn_fence(__ATOMIC_RELEASE, "agent"); asm volatile("s_waitcnt vmcnt(0)" ::: "memory"); } \
        grid.sync(); \
        if (threadIdx.x == 0) { __builtin_amdgcn_fence(__ATOMIC_ACQUIRE, "agent"); asm volatile("s_waitcnt vmcnt(0)" ::: "memory"); } \
        __syncthreads(); } else xcd_barrier(xbar); } } while (0)
#define GEMM(EPI, A_, B_, M_, N_, K_, E_) do { int k_ = (K_); asm volatile("" : "+s"(k_)); pg8::Gemm g_{(const bf16_t*)(A_), (const bf16_t*)(B_), (M_), (N_), k_, k_}; pg8::StaticOrder S_; S_.init((M_), (N_), F.G, (int)((blockIdx.x + gemm_rot_) % F.G)); S_.rev = gemm_rev_; \
        pg8::gemm_phase<EPI, pg8::StaticOrder, true, true>(F.lds, g_, S_, (E_)); } while (0)

#define GEMM_TAIL(A_, B_, KFULL_) do { int k_ = (KFULL_) / KSPL; asm volatile("" : "+s"(k_)); pg8::Gemm g_{(const bf16_t*)(A_), (const bf16_t*)(B_), MS, 1024, k_, (KFULL_)}; pg8::TailOrder S_; S_.init(MS, 1024, KSPL, F.G, (int)blockIdx.x); \
        EpiPart E_{(float*)(ws + WS_PBUF)}; pg8::gemm_phase<EpiPart, pg8::TailOrder, true, true>(F.lds, g_, S_, E_); } while (0)
    int gemm_rev_ = 0;
    int gemm_rot_ = 0;
    if (PH(0)) REP(0) p0_phase(F);
    SEAM(0);
    if (PH(1)) REP(1) modnorm_phase<0>(F, 0, 0, nullptr, nullptr);
    SEAM(1);
    if (PH(2)) REP(2) { EpiBf16<0> E{(bf16_t*)(ws + WS_A0), 768}; GEMM(EpiBf16<0>, ws + WS_H, ws + WS_WIN, MT, 768, 1024, E);
        if (blockIdx.x >= 134) { EpiKN E2{(bf16_t*)(ws + WS_KN), (float*)(ws + WS_RS), F.in[20], red, MKN / 256 - 92}; int k_ = 256; asm volatile("" : "+s"(k_));
            pg8::Gemm g_{(const bf16_t*)(ws + WS_CKV) + (size_t)(MKN / 256 - 92) * 256 * 256, (const bf16_t*)(ws + WS_WUK), 92 * 256, 1024, k_, k_}; pg8::StaticOrder S_; S_.init(92 * 256, 1024, 122, (int)blockIdx.x - 134);
            pg8::gemm_phase<EpiKN, pg8::StaticOrder, true, true>(F.lds, g_, S_, E2); } }
    SEAM(2);
    if (PH(3)) REP(3) latent_phase(F);
    SEAM(3);
    if (PH(4)) REP(4) {
#if !defined(P4_ONLY) || P4_ONLY == 1
        { EpiKN E{(bf16_t*)(ws + WS_KN), (float*)(ws + WS_RS), F.in[20], red, 0}; GEMM(EpiKN, ws + WS_CKV, ws + WS_WUK, MKN - 92 * 256, 1024, 256, E); }
#endif
#if !defined(P4_ONLY) || P4_ONLY == 2
        gemm_rot_ = 96;
        { EpiQ E{(bf16_t*)(ws + WS_A0), F.in[18], F.in[19], red}; GEMM(EpiQ, ws + WS_CQ, ws + WS_WQ, MT, 1536, 384, E); }
#endif
#if !defined(P4_ONLY) || P4_ONLY == 3
        gemm_rot_ = 56;
        { EpiBf16<0> E{(bf16_t*)(ws + WS_V), 1024}; GEMM(EpiBf16<0>, ws + WS_CKV, ws + WS_WUV, MT, 1024, 256, E); }
        gemm_rot_ = 0;
#endif
    }
    SEAM(4);
    if (PH(5)) REP(5) attention_phase(F, (unsigned*)(ws + WS_CTL) + rep_, rep_ != 0);
    SEAM(5);
    if (PH(6)) REP(6) combine_phase(F);
    SEAM(6);
    if (PH(7)) REP(7) { EpiResidB<true, false> E{F.in[0], ws + WS_V, MODF + 2048}; GEMM(RB_TF, ws + WS_H, ws + WS_WO, MP, 1024, 1024, E); GEMM_TAIL(ws + WS_H + (size_t)MP * 1024 * 2, ws + WS_WO, 1024); }
    SEAM(7);
    if (PH(8)) REP(8) modnorm_phase<1>(F, 0, 1, MODF + 2048, F.in[1]);
    SEAM(8);
    if (PH(9)) REP(9) { EpiBf16<1> E{(bf16_t*)(ws + WS_HF), 4096}; GEMM(EpiBf16<1>, ws + WS_H, ws + WS_W1, MT, 4096, 1024, E); }
    SEAM(9);
    if (PH(10)) REP(10) { gemm_rev_ = 1; EpiResidB<false, false> E{ws + WS_V, ws + WS_V, MODF + 5120}; GEMM(RB_FF, ws + WS_HF, ws + WS_W2, MP, 1024, 4096, E); gemm_rev_ = 0; GEMM_TAIL(ws + WS_HF + (size_t)MP * 4096 * 2, ws + WS_W2, 4096); }
#ifdef DUP_W2
    if (PH(10)) { EpiBf16<0> E{(bf16_t*)(ws + WS_H), 1024}; GEMM(EpiBf16<0>, ws + WS_HF, ws + WS_W2, MP, 1024, 4096, E); }
#endif
#ifdef EXTRA_SYNCS
    for (int es_ = 0; es_ < EXTRA_SYNCS; ++es_) SEAM(10);
#endif
    SEAM(10);
    if (PH(11)) REP(11) modnorm_phase<1>(F, 1, 0, MODF + 5120, nullptr);
    SEAM(11);
    if (PH(12)) REP(12) {
        { EpiBf16<2> E{(bf16_t*)(ws + WS_U), 1024}; GEMM(EpiBf16<2>, ws + WS_H, ws + WS_CWIN, MT, 1024, 1024, E); }
        gemm_rot_ = 128;
        { EpiVT E{(bf16_t*)(ws + WS_VT), (float*)(ws + WS_SSV)}; GEMM(EpiVT, ws + WS_CWIN + (size_t)1024 * 1024 * 2, ws + WS_H, 1024, MT, 1024, E); }
        gemm_rot_ = 0;
    }
    SEAM(12);
    if (PH(13)) REP(13) sgu_phase(F);
    SEAM(13);
    if (PH(14)) REP(14) { EpiResidB<false, false> E{ws + WS_V, ws + WS_V, MODF + 40 * 6144 + 2048}; GEMM(RB_FF, ws + WS_G, ws + WS_CWO, MP, 1024, 1024, E); GEMM_TAIL(ws + WS_G + (size_t)MP * 1024 * 2, ws + WS_CWO, 1024); }
    SEAM(14);
    if (PH(15)) REP(15) modnorm_phase<1>(F, 1, 1, MODF + 40 * 6144 + 2048, nullptr);
    SEAM(15);
    if (PH(16)) REP(16) { EpiBf16<1> E{(bf16_t*)(ws + WS_HF), 4096}; GEMM(EpiBf16<1>, ws + WS_H, ws + WS_W1 + (size_t)4096 * 1024 * 2, MT, 4096, 1024, E); }
    SEAM(16);
    if (PH(17)) REP(17) { gemm_rev_ = 1; EpiResidB<false, true> E{ws + WS_V, F.out, MODF + 40 * 6144 + 5120}; GEMM(RB_FT, ws + WS_HF, ws + WS_W2 + (size_t)4096 * 1024 * 2, MP, 1024, 4096, E); gemm_rev_ = 0; GEMM_TAIL(ws + WS_HF + (size_t)MP * 4096 * 2, ws + WS_W2 + (size_t)4096 * 1024 * 2, 4096); }
    SEAM(17);
    if (PH(18)) REP(18) final_tail_phase(F, MODF + 40 * 6144 + 5120);
#undef PH
#undef SEAM
#undef GEMM
#undef GEMM_TAIL
}

#ifndef MK_N_LAUNCHES
#define MK_N_LAUNCHES 1
#endif
extern "C" void kernel_launch(void* const* d_in, const int* in_sizes, int n_in, void* d_out, int out_size, void* d_ws, size_t ws_size, hipStream_t stream) {
    static int grid = 0;
    if (grid == 0) {
        if (n_in != 28 || (size_t)out_size != OUT_END || ws_size < WS_END) { fprintf(stderr, "kernel_launch: unexpected shapes: n_in %d out %d ws %zu\n", n_in, out_size, ws_size); grid = -1; return; }
        int dev = 0, cus = 0, per_cu = 0;
        hipGetDevice(&dev); hipDeviceGetAttribute(&cus, hipDeviceAttributeMultiprocessorCount, dev);
        if (hipFuncSetAttribute((const void*)fwd_megakernel, hipFuncAttributeMaxDynamicSharedMemorySize, LDS_BYTES) != hipSuccess) { fprintf(stderr, "kernel_launch: hipFuncSetAttribute failed\n"); grid = -1; return; }
        if (hipOccupancyMaxActiveBlocksPerMultiprocessor(&per_cu, (const void*)fwd_megakernel, 512, LDS_BYTES) != hipSuccess || per_cu < 1) { fprintf(stderr, "kernel_launch: occupancy query says %d\n", per_cu); per_cu = 1; }
        (void)hipGetLastError();
        grid = cus;
        fprintf(stderr, "kernel_launch: grid %d (per_cu %d)\n", grid, per_cu);
    }
    if (grid < 0) return;
    (void)hipMemsetAsync((char*)d_ws + WS_CTL, 0, CTL_BYTES, stream);
    Args a{};
    for (int i = 0; i < 28; ++i) a.in[i] = (const float*)d_in[i];
    a.out = (float*)d_out; a.ws = (unsigned char*)d_ws;
#if MK_N_LAUNCHES == 1
#ifndef PH_HI_TEST
#define PH_HI_TEST N_PHASES
#endif
    a.ph_lo = 0; a.ph_hi = PH_HI_TEST;
    void* params[] = {&a};
    hipError_t e = hipLaunchCooperativeKernel((const void*)fwd_megakernel, dim3(grid), dim3(512), params, LDS_BYTES, stream);
    if (e != hipSuccess) fprintf(stderr, "kernel_launch: cooperative launch failed: %s (grid %d)\n", hipGetErrorString(e), grid);
#else
    for (int p = 0; p < N_PHASES; ++p) { a.ph_lo = p; a.ph_hi = p + 1; hipLaunchKernelGGL(fwd_megakernel, dim3(grid), dim3(512), LDS_BYTES, stream, a); }
#endif
}
```

```cpp
#include <hip/hip_runtime.h>
#include <hip/hip_cooperative_groups.h>
#include <cstdio>
#include <cstdint>
namespace cg = cooperative_groups;

#define LAS __attribute__((address_space(3)))
typedef unsigned short bf16_t;
typedef short bf16x8 __attribute__((ext_vector_type(8)));
typedef short s16x4 __attribute__((ext_vector_type(4)));
typedef float f32x4 __attribute__((ext_vector_type(4)));
typedef float f32x2 __attribute__((ext_vector_type(2)));
typedef float f32x16 __attribute__((ext_vector_type(16)));
typedef unsigned u32x4 __attribute__((ext_vector_type(4)));
typedef unsigned u32x2 __attribute__((ext_vector_type(2)));

constexpr int DM = 1024, NB_P = 8, SEQ = 4096, NB_S = 32, DSEQ = 16, PAST = 4096;
constexpr int MP = NB_P * SEQ;
constexpr int MS = NB_S * DSEQ;
constexpr int MT = MP + MS;
constexpr int NSEQ = NB_P + NB_S;
constexpr int NH = 8, DNOPE = 128, DROPE = 64, DV = 128, QLORA = 384, KVLORA = 256, DFF = 4096;
constexpr int NCACHE = NB_S * PAST;
constexpr int MKN = MT + NCACHE;
constexpr int VTP = 33536;
constexpr float EPS = 1e-6f;
constexpr float SM_SCALE = 0.07216878364870322f;
constexpr int NSPLIT = 4;
constexpr size_t OUT_Y = 0, OUT_CKVP = (size_t)MT * DM, OUT_KPEP = OUT_CKVP + (size_t)MP * 256, OUT_CKVS = OUT_KPEP + (size_t)MP * 64,
                 OUT_KPES = OUT_CKVS + (size_t)MS * 256, OUT_VS = OUT_KPES + (size_t)MS * 64, OUT_END = OUT_VS + (size_t)MS * DM;
constexpr size_t MiB = 1u << 20;
constexpr size_t WS_CTL = 0, CTL_BYTES = 32768;
constexpr size_t WS_WIN = 1 * MiB;
constexpr size_t WS_WQ = WS_WIN + 768 * 1024 * 2;
constexpr size_t WS_WUK = WS_WQ + 1536 * 384 * 2;
constexpr size_t WS_WUV = WS_WUK + 1024 * 256 * 2;
constexpr size_t WS_WUKN = WS_WUV + 1024 * 256 * 2;
constexpr size_t WS_WO = WS_WUKN + 1024 * 256 * 2;
constexpr size_t WS_W1 = WS_WO + 1024 * 1024 * 2;
constexpr size_t WS_W2 = WS_W1 + 2ull * 4096 * 1024 * 2;
constexpr size_t WS_CWIN = WS_W2 + 2ull * 4096 * 1024 * 2;
constexpr size_t WS_CWO = WS_CWIN + 2048 * 1024 * 2;
constexpr size_t WS_WEND = WS_CWO + 1024 * 1024 * 2;
static_assert(WS_WEND <= 46 * MiB, "weights");
constexpr size_t WS_MODF = 46 * MiB;
constexpr size_t WS_SSV = 48 * MiB;
constexpr size_t WS_PBUF = 50 * MiB;
constexpr int KSPL = 8;
constexpr size_t WS_PART = 50 * MiB;
constexpr size_t WS_ML = 66 * MiB;
constexpr size_t WS_H = 67 * MiB;
constexpr size_t WS_A0 = 132 * MiB;
constexpr size_t WS_CQ = 230 * MiB;
constexpr size_t WS_CKV = 255 * MiB;
constexpr size_t WS_KR = 336 * MiB;
constexpr size_t WS_KPE = 341 * MiB;
constexpr size_t WS_RS = 357 * MiB;
constexpr size_t WS_KN = 363 * MiB;
constexpr size_t WS_V = 428 * MiB;
constexpr size_t WS_END = 493 * MiB;
constexpr size_t WS_HF = 132 * MiB;
constexpr size_t WS_U = 132 * MiB;
constexpr size_t WS_VT = 197 * MiB;
constexpr size_t WS_G = 263 * MiB;
static_assert(WS_CKV + (size_t)MKN * 256 * 2 <= WS_KR && WS_RS + (size_t)MKN * 32 <= WS_KN && WS_V + (size_t)MT * 2048 <= WS_END, "ws map");
static_assert(WS_VT + (size_t)1024 * VTP * 2 <= WS_G && WS_HF + (size_t)MT * 8192 <= WS_END, "ws map 2");
constexpr int LDS_BYTES = 147456;
constexpr int LDS_RED = 131072;
constexpr int LDS_MISC = 147392;

typedef __bf16 bf16x2_t __attribute__((ext_vector_type(2)));
__device__ __forceinline__ unsigned cvt_pk_bf16(float lo, float hi) { const f32x2 v = {lo, hi}; const bf16x2_t b = __builtin_convertvector(v, bf16x2_t); return __builtin_bit_cast(unsigned, b); }
__device__ __forceinline__ float bf2f(bf16_t b) { return __uint_as_float(((unsigned)b) << 16); }
__device__ __forceinline__ float bflo(unsigned w) { return __uint_as_float(w << 16); }
__device__ __forceinline__ float bfhi(unsigned w) { return __uint_as_float(w & 0xffff0000u); }
__device__ __forceinline__ bf16_t f2bf(float f) { return (bf16_t)(cvt_pk_bf16(f, 0.f) & 0xffffu); }
template <int X> __device__ __forceinline__ float swz_xor(float v) { return __int_as_float(__builtin_amdgcn_ds_swizzle(__float_as_int(v), (X << 10) | 0x1f)); }
__device__ __forceinline__ float sum_x32(float v) { auto rr = __builtin_amdgcn_permlane32_swap(__float_as_uint(v), __float_as_uint(v), false, false); return __uint_as_float(rr[0]) + __uint_as_float(rr[1]); }
__device__ __forceinline__ float wave_sum(float v) { v += swz_xor<1>(v); v += swz_xor<2>(v); v += swz_xor<4>(v); v += swz_xor<8>(v); v += swz_xor<16>(v); return sum_x32(v); }
__device__ __forceinline__ float gelu_tanh(float x) {
    const float u = 0.7978845608028654f * (x + 0.044715f * x * x * x);
    return x * __builtin_amdgcn_rcpf(1.f + __builtin_amdgcn_exp2f(-2.885390081777927f * u));
}
__device__ __forceinline__ void sincos_rev(float ang, float& s, float& c) {
    float rev = ang * 0.15915494309189535f; rev -= floorf(rev);
    s = __builtin_amdgcn_sinf(rev); c = __builtin_amdgcn_cosf(rev);
}
__device__ __forceinline__ float rope_inv(int i) { return __builtin_amdgcn_exp2f(-(float)i * (13.287712379549449f / 32.f)); }
__device__ __forceinline__ int row_pos(int r) { return r < MP ? (r & (SEQ - 1)) : PAST + ((r - MP) & (DSEQ - 1)); }
__device__ __forceinline__ int row_seq(int r) { return r < MP ? (r >> 12) : NB_P + ((r - MP) >> 4); }

namespace pg8 {
#define PG8_LAS __attribute__((address_space(3)))
constexpr int BM = 256, BK = 64, HALF = 128, HTB = HALF * BK * 2  , STAGE_BYTES = 8 * HTB, NXCD = 8, WGM = 8;
__host__ __device__ __forceinline__ int lds_byte(int r, int c) { const int st = (r >> 4) * 2 + (c >> 5), rr = r & 15, cc = c & 31, ob = rr * 64 + cc * 2; return st * 1024 + (ob ^ (((ob >> 9) & 1) << 5)); }
__host__ __device__ __forceinline__ void stage_rc(int b, int& R, int& C) { const int st = b / 1024, sb = b % 1024, swz = sb ^ (((sb >> 9) & 1) << 5); R = (st >> 1) * 16 + swz / 64; C = (st & 1) * 32 + (swz % 64) / 2; }
__host__ __device__ __forceinline__ int perm32(int rho) { const int n = rho >> 4, i = rho & 15; return 8 * (i >> 2) + 4 * n + (i & 3); }
struct Unit { int pm, pn, pk; };
struct Gemm { const bf16_t* A; const bf16_t* Bt; int M, N, K, ld; };
struct StaticOrder {
    int nM, nN, nwg, G, c, rev;
    __host__ __device__ void init(int M, int N, int G_, int c_) { nM = M / BM; nN = N / BM; nwg = nM * nN; G = G_; c = c_; rev = 0; }
    __host__ __device__ bool next(int i, Unit& u) const {
        const long L = (long)i * G + c; if (L >= nwg) return false;
        int wgid = (int)L; { const int q = nwg / NXCD, r = nwg % NXCD, xcd = wgid % NXCD, off = wgid / NXCD; wgid = (xcd < r ? xcd * (q + 1) : r * (q + 1) + (xcd - r) * q) + off; }
        const int nig = WGM * nN, gid = wgid / nig, fm = gid * WGM, gsz = (nM - fm) < WGM ? (nM - fm) : WGM;
        u.pm = fm + ((wgid % nig) % gsz); u.pn = (wgid % nig) / gsz; u.pk = 0; if (rev) u.pm = nM - 1 - u.pm; return true;
    }
    __device__ __forceinline__ void a_ready(const Unit&) const {}
    __device__ __forceinline__ void done(const Unit&) const {}
};
struct TailOrder {
    int nM, nN, KS, G, c;
    __host__ __device__ void init(int M, int N, int KS_, int G_, int c_) { nM = M / BM; nN = N / BM; KS = KS_; G = G_; c = c_; }
    __host__ __device__ bool next(int i, Unit& u) const {
        const long L = (long)i * G + c; if (L >= (long)nM * nN * KS) return false;
        const int t = (int)L % (nM * nN); u.pk = (int)L / (nM * nN); u.pm = t % nM; u.pn = t / nM; return true;
    }
    __device__ __forceinline__ void a_ready(const Unit&) const {}
    __device__ __forceinline__ void done(const Unit&) const {}
};
template <class Epi, class Sched, bool ALIGN_EPI = false, bool SP2 = false>
__device__ __forceinline__ void gemm_phase(PG8_LAS unsigned char* lds, const Gemm g, const Sched& S, const Epi& E) {
    int tid_l = threadIdx.x; asm volatile("" : "+v"(tid_l));
    const int tid = tid_l, wid = __builtin_amdgcn_readfirstlane(tid >> 6), lane = tid & 63, wr = wid >> 2, wc = wid & 3, fr = lane & 15, fq = lane >> 4;
    const int K = g.K, nt = K / BK, ld = g.ld;
    unsigned voffA[2], voffB[2];
#pragma unroll
    for (int i = 0; i < 2; ++i) { int R, C; stage_rc(tid * 16 + i * 8192, R, C); const int Rb = Epi::PERM ? ((R & ~31) + perm32(R & 31)) : R;
        voffA[i] = (unsigned)(R * ld + C) * 2u; voffB[i] = (unsigned)(Rb * ld + C) * 2u; }
    const size_t kstep = (size_t)(BK * 2);
    const size_t hstep = (size_t)HALF * ld * 2;
    const size_t tstep = 2 * hstep;
    const unsigned ldsw = (unsigned)wid * 1024u;
    const int aoff = lds_byte(wr * 64 + fr, fq * 8), boff = lds_byte(wc * 32 + fr, fq * 8);
#define PG8_SA(b, h) (((b) * 2 + (h)) * HTB)
#define PG8_SB(b, h) ((4 + (b) * 2 + (h)) * HTB)
#define PG8_STAGE(bufoff, gbase, voff) do { _Pragma("unroll") for (int _i = 0; _i < 2; ++_i) \
        __builtin_amdgcn_global_load_lds((const unsigned*)((const char*)(gbase) + (voff)[_i]), (PG8_LAS unsigned*)(lds + (bufoff) + ldsw + _i * 8192), 16, 0, 0); } while (0)
#define PG8_LDA(dst, b, h) do { _Pragma("unroll") for (int m = 0; m < 4; ++m) _Pragma("unroll") for (int k = 0; k < 2; ++k) dst[m][k] = *(const PG8_LAS bf16x8*)(lds + PG8_SA(b, h) + aoff + m * 2048 + k * 1024); } while (0)
#define PG8_LDB(dst, b, h) do { _Pragma("unroll") for (int n = 0; n < 2; ++n) _Pragma("unroll") for (int k = 0; k < 2; ++k) dst[n][k] = *(const PG8_LAS bf16x8*)(lds + PG8_SB(b, h) + boff + n * 2048 + k * 1024); } while (0)
#define PG8_MMA(ai, bj, At, Bt) do { __builtin_amdgcn_s_setprio(1); _Pragma("unroll") for (int m = 0; m < 4; ++m) _Pragma("unroll") for (int n = 0; n < 2; ++n) _Pragma("unroll") for (int k = 0; k < 2; ++k) \
        acc[ai][bj][m][n] = __builtin_amdgcn_mfma_f32_16x16x32_bf16(Bt[n][k], At[m][k], acc[ai][bj][m][n], 0, 0, 0); __builtin_amdgcn_s_setprio(0); } while (0)
#define PG8_WAIT_V(n) asm volatile("s_waitcnt vmcnt(" #n ")" ::: "memory")
#define PG8_WAIT_L(n) asm volatile("s_waitcnt lgkmcnt(" #n ")" ::: "memory")
#define PG8_BAR __builtin_amdgcn_s_barrier()
#define PG8_SCHED __builtin_amdgcn_sched_barrier(0)
    Unit cur, nxt; int ui = 0;
    if (!S.next(0, cur)) return;
    f32x4 acc[2][2][4][2];
#pragma unroll
    for (int a = 0; a < 2; ++a)
#pragma unroll
        for (int b = 0; b < 2; ++b)
#pragma unroll
            for (int m = 0; m < 4; ++m)
#pragma unroll
                for (int n = 0; n < 2; ++n) acc[a][b][m][n] = (f32x4){0.f, 0.f, 0.f, 0.f};
    bf16x8 At[4][2], B0[2][2], B1[2][2];
    const char* cA = (const char*)g.A + (size_t)cur.pm * tstep + (size_t)cur.pk * K * 2; const char* cB = (const char*)g.Bt + (size_t)cur.pn * tstep + (size_t)cur.pk * K * 2;
    S.a_ready(cur);
    if constexpr (SP2) {
        PG8_STAGE(PG8_SB(0, 0), cB, voffB); PG8_STAGE(PG8_SB(0, 1), cB + hstep, voffB); PG8_STAGE(PG8_SA(0, 0), cA, voffA); PG8_STAGE(PG8_SA(0, 1), cA + hstep, voffA);
        if (wr == 1) PG8_BAR;
        PG8_WAIT_V(2); PG8_BAR;
        PG8_STAGE(PG8_SB(1, 0), cB + kstep, voffB); PG8_STAGE(PG8_SA(1, 0), cA + kstep, voffA); PG8_STAGE(PG8_SB(1, 1), cB + hstep + kstep, voffB);
        PG8_WAIT_V(6); PG8_BAR;
    } else {
        PG8_STAGE(PG8_SB(0, 0), cB, voffB); PG8_STAGE(PG8_SA(0, 0), cA, voffA); PG8_STAGE(PG8_SB(0, 1), cB + hstep, voffB); PG8_STAGE(PG8_SA(0, 1), cA + hstep, voffA);
        if (wr == 1) PG8_BAR;
        PG8_WAIT_V(4); PG8_BAR;
        PG8_STAGE(PG8_SB(1, 0), cB + kstep, voffB); PG8_STAGE(PG8_SA(1, 0), cA + kstep, voffA); PG8_STAGE(PG8_SB(1, 1), cB + hstep + kstep, voffB);
        PG8_WAIT_V(6); PG8_BAR;
    }
    for (;;) {
        const bool has_next = S.next(ui + 1, nxt);
        const char* nA = has_next ? (const char*)g.A + (size_t)nxt.pm * tstep + (size_t)nxt.pk * K * 2 : cA; const char* nB = has_next ? (const char*)g.Bt + (size_t)nxt.pn * tstep + (size_t)nxt.pk * K * 2 : cB;
        for (int t = 0; t < nt; t += 2) {
            const bool last = (t == nt - 2);
            const char* a1 = cA + (size_t)(t + 1) * kstep;
            const char* a2 = last ? nA : cA + (size_t)(t + 2) * kstep; const char* b2 = last ? nB : cB + (size_t)(t + 2) * kstep;
            const char* a3 = a2 + kstep; const char* b3 = b2 + kstep;
            if (last && has_next) S.a_ready(nxt);
            if constexpr (SP2) {
            PG8_LDB(B0, 0, 0); PG8_LDB(B1, 0, 1); PG8_SCHED; PG8_LDA(At, 0, 0); PG8_STAGE(PG8_SA(1, 1), a1 + hstep, voffA);
            PG8_WAIT_V(8); PG8_WAIT_L(0); PG8_BAR; PG8_MMA(0, 0, At, B0); PG8_MMA(0, 1, At, B1); PG8_BAR; PG8_SCHED;
            PG8_LDA(At, 0, 1); PG8_STAGE(PG8_SB(0, 0), b2, voffB); PG8_STAGE(PG8_SB(0, 1), b2 + hstep, voffB); PG8_STAGE(PG8_SA(0, 0), a2, voffA);
            PG8_WAIT_V(8); PG8_WAIT_L(0); PG8_BAR; PG8_MMA(1, 0, At, B0); PG8_MMA(1, 1, At, B1); PG8_BAR; PG8_SCHED;
            PG8_LDB(B0, 1, 0); PG8_LDB(B1, 1, 1); PG8_SCHED; PG8_LDA(At, 1, 0); PG8_STAGE(PG8_SA(0, 1), a2 + hstep, voffA);
            PG8_WAIT_V(8); PG8_WAIT_L(0); PG8_BAR; PG8_MMA(0, 0, At, B0); PG8_MMA(0, 1, At, B1); PG8_BAR; PG8_SCHED;
            PG8_LDA(At, 1, 1); PG8_STAGE(PG8_SB(1, 0), b3, voffB); PG8_STAGE(PG8_SB(1, 1), b3 + hstep, voffB); PG8_STAGE(PG8_SA(1, 0), a3, voffA);
            PG8_WAIT_V(8); PG8_WAIT_L(0); PG8_BAR; PG8_MMA(1, 0, At, B0); PG8_MMA(1, 1, At, B1); PG8_BAR; PG8_SCHED;
            } else {
            PG8_LDB(B0, 0, 0); PG8_SCHED; PG8_LDA(At, 0, 0); PG8_STAGE(PG8_SA(1, 1), a1 + hstep, voffA);
            PG8_WAIT_L(8); PG8_BAR; PG8_WAIT_L(0); PG8_MMA(0, 0, At, B0); PG8_BAR; PG8_SCHED;
            PG8_LDB(B1, 0, 1); PG8_STAGE(PG8_SB(0, 0), b2, voffB);
            PG8_BAR; PG8_WAIT_L(0); PG8_MMA(0, 1, At, B1); PG8_BAR;
            PG8_LDA(At, 0, 1); PG8_STAGE(PG8_SA(0, 0), a2, voffA);
            PG8_BAR; PG8_WAIT_L(0); PG8_MMA(1, 0, At, B0); PG8_BAR; PG8_SCHED;
            PG8_STAGE(PG8_SB(0, 1), b2 + hstep, voffB);
            PG8_WAIT_V(6); PG8_BAR; PG8_MMA(1, 1, At, B1); PG8_BAR;
            PG8_LDB(B0, 1, 0); PG8_SCHED; PG8_LDA(At, 1, 0); PG8_STAGE(PG8_SA(0, 1), a2 + hstep, voffA);
            PG8_WAIT_L(8); PG8_BAR; PG8_WAIT_L(0); PG8_MMA(0, 0, At, B0); PG8_BAR; PG8_SCHED;
            PG8_LDB(B1, 1, 1); PG8_STAGE(PG8_SB(1, 0), b3, voffB);
            PG8_BAR; PG8_WAIT_L(0); PG8_MMA(0, 1, At, B1); PG8_BAR;
            PG8_LDA(At, 1, 1); PG8_STAGE(PG8_SA(1, 0), a3, voffA);
            PG8_BAR; PG8_WAIT_L(0); PG8_MMA(1, 0, At, B0); PG8_BAR; PG8_SCHED;
            PG8_STAGE(PG8_SB(1, 1), b3 + hstep, voffB);
            PG8_WAIT_V(6); PG8_BAR; PG8_MMA(1, 1, At, B1); PG8_BAR;
            }
        }
        if constexpr (ALIGN_EPI) { if (wr == 0) PG8_BAR; }
        if constexpr (!Epi::AFTER_DRAIN) { E(acc, cur, wr, wc, fr, fq); S.done(cur); }
        if (!has_next) break;
#pragma unroll
        for (int a = 0; a < 2; ++a)
#pragma unroll
            for (int b = 0; b < 2; ++b)
#pragma unroll
                for (int m = 0; m < 4; ++m)
#pragma unroll
                    for (int n = 0; n < 2; ++n) acc[a][b][m][n] = (f32x4){0.f, 0.f, 0.f, 0.f};
        cur = nxt; cA = nA; cB = nB; ++ui;
        if constexpr (ALIGN_EPI) { if (wr == 1) PG8_BAR; }
    }
    PG8_WAIT_V(0);
    if constexpr (!ALIGN_EPI) { if (wr == 0) PG8_BAR; }
    PG8_BAR;
    if constexpr (Epi::AFTER_DRAIN) { E.fused(acc, cur, wr, wc, fr, fq, lds, wid, lane); S.done(cur); }
#undef PG8_SA
#undef PG8_SB
#undef PG8_STAGE
#undef PG8_LDA
#undef PG8_LDB
#undef PG8_MMA
#undef PG8_WAIT_V
#undef PG8_WAIT_L
#undef PG8_BAR
#undef PG8_SCHED
}
}

typedef f32x4 AccT[2][2][4][2];

struct EpiF32 {
    static constexpr bool PERM = false, AFTER_DRAIN = false;
    float* O; int ldc;
    __device__ __forceinline__ void operator()(const AccT& acc, const pg8::Unit& u, int wr, int wc, int fr, int fq) const {
        asm volatile("" : "+v"(fr), "+v"(fq));
        const int row0 = u.pm * 256 + wr * 64 + fr, col0 = u.pn * 256 + wc * 32 + 4 * fq;
#pragma unroll
        for (int ai = 0; ai < 2; ++ai)
#pragma unroll
            for (int m = 0; m < 4; ++m) { float* rowp = O + (size_t)(row0 + ai * 128 + m * 16) * ldc + col0;
#pragma unroll
                for (int bj = 0; bj < 2; ++bj)
#pragma unroll
                    for (int n = 0; n < 2; ++n) *(f32x4*)(rowp + bj * 128 + n * 16) = acc[ai][bj][m][n]; }
    }
};
struct EpiPart {
    static constexpr bool PERM = false, AFTER_DRAIN = false;
    float* P;
    __device__ __forceinline__ void operator()(const AccT& acc, const pg8::Unit& u, int wr, int wc, int fr, int fq) const {
        asm volatile("" : "+v"(fr), "+v"(fq));
        const int row0 = u.pm * 256 + wr * 64 + fr, col0 = u.pn * 256 + wc * 32 + 4 * fq;
        float* O = P + (size_t)u.pk * MS * DM;
#pragma unroll
        for (int ai = 0; ai < 2; ++ai)
#pragma unroll
            for (int m = 0; m < 4; ++m) { float* rowp = O + (size_t)(row0 + ai * 128 + m * 16) * DM + col0;
#pragma unroll
                for (int bj = 0; bj < 2; ++bj)
#pragma unroll
                    for (int n = 0; n < 2; ++n) *(f32x4*)(rowp + bj * 128 + n * 16) = acc[ai][bj][m][n]; }
    }
};
struct EpiResid {
    static constexpr bool PERM = false, AFTER_DRAIN = false;
    const float* xp; float* out; const float* gate;
    __device__ __forceinline__ void operator()(const AccT& acc, const pg8::Unit& u, int wr, int wc, int fr, int fq) const {
        asm volatile("" : "+v"(fr), "+v"(fq));
        const int row0 = u.pm * 256 + wr * 64 + fr, col0 = u.pn * 256 + wc * 32 + 4 * fq;
        const float* gp = gate + (size_t)(u.pm >> 4) * 6144 + col0;
        f32x4 gv[2][2];
#pragma unroll
        for (int bj = 0; bj < 2; ++bj)
#pragma unroll
            for (int n = 0; n < 2; ++n) gv[bj][n] = *(const f32x4*)(gp + bj * 128 + n * 16);
#pragma unroll
        for (int ai = 0; ai < 2; ++ai) {
            f32x4 xv[4][2][2];
#pragma unroll
            for (int m = 0; m < 4; ++m) { const float* xr = xp + (size_t)(row0 + ai * 128 + m * 16) * DM + col0;
#pragma unroll
                for (int bj = 0; bj < 2; ++bj)
#pragma unroll
                    for (int n = 0; n < 2; ++n) xv[m][bj][n] = *(const f32x4*)(xr + bj * 128 + n * 16); }
#pragma unroll
            for (int m = 0; m < 4; ++m) { float* op = out + (size_t)(row0 + ai * 128 + m * 16) * DM + col0;
#pragma unroll
                for (int bj = 0; bj < 2; ++bj)
#pragma unroll
                    for (int n = 0; n < 2; ++n) *(f32x4*)(op + bj * 128 + n * 16) = xv[m][bj][n] + gv[bj][n] * acc[ai][bj][m][n]; }
        }
    }
};
template <bool IN32, bool OUT32> struct EpiResidB {
    static constexpr bool PERM = true, AFTER_DRAIN = false;
    const void* xin; void* xout; const float* gate;
    __device__ __forceinline__ void operator()(const AccT& acc, const pg8::Unit& u, int wr, int wc, int fr, int fq) const {
        asm volatile("" : "+v"(fr), "+v"(fq));
        const int row0 = u.pm * 256 + wr * 64 + fr, col0 = u.pn * 256 + wc * 32 + 8 * fq;
        const float* gp = gate + (size_t)(u.pm >> 4) * 6144 + col0;
        f32x4 gv[2][2];
#pragma unroll
        for (int bj = 0; bj < 2; ++bj) { gv[bj][0] = *(const f32x4*)(gp + bj * 128); gv[bj][1] = *(const f32x4*)(gp + bj * 128 + 4); }
#pragma unroll
        for (int ai = 0; ai < 2; ++ai) {
            f32x4 xa[4][2][2];
#pragma unroll
            for (int m = 0; m < 4; ++m) { const size_t ro = (size_t)(row0 + ai * 128 + m * 16) * DM + col0;
#pragma unroll
                for (int bj = 0; bj < 2; ++bj) {
                    if (IN32) { const float* xr = (const float*)xin + ro + bj * 128; xa[m][bj][0] = *(const f32x4*)xr; xa[m][bj][1] = *(const f32x4*)(xr + 4); }
                    else { const u32x4 w = *(const u32x4*)((const bf16_t*)xin + ro + bj * 128);
                        xa[m][bj][0] = (f32x4){bflo(w.x), bfhi(w.x), bflo(w.y), bfhi(w.y)}; xa[m][bj][1] = (f32x4){bflo(w.z), bfhi(w.z), bflo(w.w), bfhi(w.w)}; } } }
#pragma unroll
            for (int m = 0; m < 4; ++m) { const size_t ro = (size_t)(row0 + ai * 128 + m * 16) * DM + col0;
#pragma unroll
                for (int bj = 0; bj < 2; ++bj) { const f32x4 x0 = xa[m][bj][0] + gv[bj][0] * acc[ai][bj][m][0], x1 = xa[m][bj][1] + gv[bj][1] * acc[ai][bj][m][1];
                    if (OUT32) { float* op = (float*)xout + ro + bj * 128; *(f32x4*)op = x0; *(f32x4*)(op + 4) = x1; }
                    else { u32x4 w; w.x = cvt_pk_bf16(x0[0], x0[1]); w.y = cvt_pk_bf16(x0[2], x0[3]); w.z = cvt_pk_bf16(x1[0], x1[1]); w.w = cvt_pk_bf16(x1[2], x1[3]);
                        *(u32x4*)((bf16_t*)xout + ro + bj * 128) = w; } } }
        }
    }
};
template <int ACT> struct EpiBf16 {
    static constexpr bool PERM = true, AFTER_DRAIN = false;
    bf16_t* O; int ldc;
    __device__ __forceinline__ void operator()(const AccT& acc, const pg8::Unit& u, int wr, int wc, int fr, int fq) const {
        asm volatile("" : "+v"(fr), "+v"(fq));
        const int row0 = u.pm * 256 + wr * 64 + fr, col0 = u.pn * 256 + wc * 32 + 8 * fq;
#pragma unroll
        for (int ai = 0; ai < 2; ++ai)
#pragma unroll
            for (int m = 0; m < 4; ++m) { bf16_t* rowp = O + (size_t)(row0 + ai * 128 + m * 16) * ldc + col0;
#pragma unroll
                for (int bj = 0; bj < 2; ++bj) { f32x4 v0 = acc[ai][bj][m][0], v1 = acc[ai][bj][m][1];
                    if (ACT == 1) {
#pragma unroll
                        for (int j = 0; j < 4; ++j) { const float a = fmaxf(v0[j], 0.f), b = fmaxf(v1[j], 0.f); v0[j] = a * a; v1[j] = b * b; } }
                    if (ACT == 2) {
#pragma unroll
                        for (int j = 0; j < 4; ++j) { v0[j] = gelu_tanh(v0[j]); v1[j] = gelu_tanh(v1[j]); } }
                    u32x4 w; w.x = cvt_pk_bf16(v0[0], v0[1]); w.y = cvt_pk_bf16(v0[2], v0[3]); w.z = cvt_pk_bf16(v1[0], v1[1]); w.w = cvt_pk_bf16(v1[2], v1[3]);
                    *(u32x4*)(rowp + bj * 128) = w; } }
    }
};
struct EpiVT {
    static constexpr bool PERM = true, AFTER_DRAIN = false;
    bf16_t* VT; float* SSV;
    __device__ __forceinline__ void operator()(const AccT& acc, const pg8::Unit& u, int wr, int wc, int fr, int fq) const {
        asm volatile("" : "+v"(fr), "+v"(fq));
        const int row0 = u.pm * 256 + wr * 64 + fr, col0 = u.pn * 256 + wc * 32 + 8 * fq;
        float s[2][2][4];
#pragma unroll
        for (int bj = 0; bj < 2; ++bj)
#pragma unroll
            for (int n = 0; n < 2; ++n)
#pragma unroll
                for (int j = 0; j < 4; ++j) s[bj][n][j] = 0.f;
#pragma unroll
        for (int ai = 0; ai < 2; ++ai)
#pragma unroll
            for (int m = 0; m < 4; ++m) { bf16_t* rowp = VT + (size_t)(row0 + ai * 128 + m * 16) * VTP + col0;
#pragma unroll
                for (int bj = 0; bj < 2; ++bj) { f32x4 v0 = acc[ai][bj][m][0], v1 = acc[ai][bj][m][1];
#pragma unroll
                    for (int j = 0; j < 4; ++j) { v0[j] = gelu_tanh(v0[j]); v1[j] = gelu_tanh(v1[j]); s[bj][0][j] += v0[j] * v0[j]; s[bj][1][j] += v1[j] * v1[j]; }
                    u32x4 w; w.x = cvt_pk_bf16(v0[0], v0[1]); w.y = cvt_pk_bf16(v0[2], v0[3]); w.z = cvt_pk_bf16(v1[0], v1[1]); w.w = cvt_pk_bf16(v1[2], v1[3]);
                    *(u32x4*)(rowp + bj * 128) = w; } }
        float* sp = SSV + (size_t)(u.pm * 2 + wr) * VTP + col0;
#pragma unroll
        for (int bj = 0; bj < 2; ++bj)
#pragma unroll
            for (int n = 0; n < 2; ++n) { f32x4 t;
#pragma unroll
                for (int j = 0; j < 4; ++j) { float x = s[bj][n][j]; x += swz_xor<1>(x); x += swz_xor<2>(x); x += swz_xor<4>(x); x += swz_xor<8>(x); t[j] = x; }
                if (fr == 0) *(f32x4*)(sp + bj * 128 + n * 4) = t; }
    }
};
__device__ __forceinline__ void head_ss(const AccT& acc, LAS float* red, int wr, int wc, int fr, int fq) {
    LAS float* rw = red + (wr * 64 + fr) * 8 + wc;
#pragma unroll
    for (int ai = 0; ai < 2; ++ai)
#pragma unroll
        for (int m = 0; m < 4; ++m)
#pragma unroll
            for (int bj = 0; bj < 2; ++bj) { const f32x4 a = acc[ai][bj][m][0], b = acc[ai][bj][m][1];
                float s = (a[0] * a[0] + a[1] * a[1]) + (a[2] * a[2] + a[3] * a[3]) + (b[0] * b[0] + b[1] * b[1]) + (b[2] * b[2] + b[3] * b[3]);
                s += swz_xor<16>(s); s = sum_x32(s);
                if (fq == 0) rw[(ai * 128 + m * 16) * 8 + bj * 4] = s; }
    asm volatile("s_waitcnt lgkmcnt(0)" ::: "memory"); __builtin_amdgcn_s_barrier(); asm volatile("" ::: "memory");
}
__device__ __forceinline__ float head_rs(const LAS float* red, int rowl, int bj) {
    const f32x4 t = *(const LAS f32x4*)(red + rowl * 8 + bj * 4);
    return __builtin_amdgcn_rsqf(((t[0] + t[1]) + (t[2] + t[3])) * (1.f / 128.f) + EPS);
}
__device__ __forceinline__ void head_done() { asm volatile("s_waitcnt lgkmcnt(0)" ::: "memory"); __builtin_amdgcn_s_barrier(); asm volatile("" ::: "memory"); }
struct EpiKN {
    static constexpr bool PERM = true, AFTER_DRAIN = false;
    bf16_t* KN; float* RS; const float* g; LAS float* red; int pm_off;
    __device__ __forceinline__ void operator()(const AccT& acc, const pg8::Unit& u, int wr, int wc, int fr, int fq) const {
        asm volatile("" : "+v"(fr), "+v"(fq));
        head_ss(acc, red, wr, wc, fr, fq);
        const int pmg = u.pm + pm_off; const int row0 = pmg * 256 + wr * 64 + fr, d0 = wc * 32 + 8 * fq;
        const float* gl = g + d0; asm volatile("" : "+v"(gl)); const f32x4 g0 = *(const f32x4*)gl, g1 = *(const f32x4*)(gl + 4);
#pragma unroll
        for (int ai = 0; ai < 2; ++ai)
#pragma unroll
            for (int m = 0; m < 4; ++m) { const int r = row0 + ai * 128 + m * 16;
#pragma unroll
                for (int bj = 0; bj < 2; ++bj) { const float s = head_rs(red + (wr * 64 + fr) * 8, ai * 128 + m * 16, bj); const int h = 2 * u.pn + bj;
                    if (wc == 0 && fq == 0) RS[(size_t)r * 8 + h] = s;
                    if (pmg < MT / 256) { const f32x4 v0 = acc[ai][bj][m][0] * s * g0, v1 = acc[ai][bj][m][1] * s * g1;
                        u32x4 w; w.x = cvt_pk_bf16(v0[0], v0[1]); w.y = cvt_pk_bf16(v0[2], v0[3]); w.z = cvt_pk_bf16(v1[0], v1[1]); w.w = cvt_pk_bf16(v1[2], v1[3]);
                        *(u32x4*)(KN + (size_t)r * 1024 + h * 128 + d0) = w; } } }
        head_done();
    }
};
struct EpiQ {
    static constexpr bool PERM = true, AFTER_DRAIN = false;
    bf16_t* Q; const float* gqn; const float* gqr; LAS float* red;
    __device__ __forceinline__ void operator()(const AccT& acc, const pg8::Unit& u, int wr, int wc, int fr, int fq) const {
        asm volatile("" : "+v"(fr), "+v"(fq));
        const int row0 = u.pm * 256 + wr * 64 + fr;
        if (u.pn < 4) {
            head_ss(acc, red, wr, wc, fr, fq);
            const int d0 = wc * 32 + 8 * fq;
            const float* gl = gqn + d0; asm volatile("" : "+v"(gl)); const f32x4 g0 = *(const f32x4*)gl, g1 = *(const f32x4*)(gl + 4);
#pragma unroll
            for (int ai = 0; ai < 2; ++ai)
#pragma unroll
                for (int m = 0; m < 4; ++m) { const int r = row0 + ai * 128 + m * 16;
#pragma unroll
                    for (int bj = 0; bj < 2; ++bj) { const float s = head_rs(red + (wr * 64 + fr) * 8, ai * 128 + m * 16, bj); const int h = 2 * u.pn + bj;
                        const f32x4 v0 = acc[ai][bj][m][0] * s * g0, v1 = acc[ai][bj][m][1] * s * g1;
                        u32x4 w; w.x = cvt_pk_bf16(v0[0], v0[1]); w.y = cvt_pk_bf16(v0[2], v0[3]); w.z = cvt_pk_bf16(v1[0], v1[1]); w.w = cvt_pk_bf16(v1[2], v1[3]);
                        *(u32x4*)(Q + (size_t)r * 1536 + h * 192 + d0) = w; } }
            head_done();
        } else {
            const int h = (u.pn - 4) * 4 + wc, i0c = 8 * fq;
            float gqa[8], gqb[8]; { const float* gl = gqr + i0c; asm volatile("" : "+v"(gl));
#pragma unroll
                for (int t = 0; t < 8; ++t) { gqa[t] = gl[t]; gqb[t] = gl[32 + t]; } }
#pragma unroll
            for (int ai = 0; ai < 2; ++ai)
#pragma unroll
                for (int m = 0; m < 4; ++m) { const int r = row0 + ai * 128 + m * 16; int i0 = i0c; asm volatile("" : "+v"(i0));
                    float ss = 0.f;
#pragma unroll
                    for (int n = 0; n < 2; ++n)
#pragma unroll
                        for (int j = 0; j < 4; ++j) { const float a = acc[ai][0][m][n][j], b = acc[ai][1][m][n][j]; ss += a * a + b * b; }
                    ss += swz_xor<16>(ss); ss = sum_x32(ss);
                    const float s = __builtin_amdgcn_rsqf(ss * (1.f / 64.f) + EPS); const float pos = (float)row_pos(r);
                    unsigned w1[4], w2[4];
#pragma unroll
                    for (int tp = 0; tp < 4; ++tp) { float oa[2], ob[2];
#pragma unroll
                        for (int e = 0; e < 2; ++e) { const int t = 2 * tp + e; float sn, cs; sincos_rev(pos * rope_inv(i0 + t), sn, cs);
                            const float y1 = acc[ai][0][m][t >> 2][t & 3] * s * gqa[t], y2 = acc[ai][1][m][t >> 2][t & 3] * s * gqb[t];
                            oa[e] = y1 * cs - y2 * sn; ob[e] = y2 * cs + y1 * sn; }
                        w1[tp] = cvt_pk_bf16(oa[0], oa[1]); w2[tp] = cvt_pk_bf16(ob[0], ob[1]); }
                    bf16_t* qp = Q + (size_t)r * 1536 + h * 192 + 128 + i0;
                    *(u32x4*)qp = (u32x4){w1[0], w1[1], w1[2], w1[3]}; *(u32x4*)(qp + 32) = (u32x4){w2[0], w2[1], w2[2], w2[3]};
                    asm volatile("" ::: "memory"); }
        }
    }
};

struct Args { const float* in[28]; float* out; unsigned char* ws; int ph_lo, ph_hi; };
struct Frame {
    LAS unsigned char* lds;
    int G;
    const float* const* in; float* out; unsigned char* ws;
};
#define LOCAL_IDS() int tid_l_ = threadIdx.x; asm volatile("" : "+v"(tid_l_)); const int tid = tid_l_, lane = tid & 63, wave = __builtin_amdgcn_readfirstlane(tid >> 6); (void)tid; (void)lane; (void)wave
#define LDS_WAIT() asm volatile("s_waitcnt lgkmcnt(0)" ::: "memory")

__device__ __forceinline__ void transpose_block(const float* W, int K, int N, bf16_t* WT, int k0, int n0, int drow, LAS float* scr, int lane) {
#pragma unroll 8
    for (int i = 0; i < 32; ++i) { const int kk = 2 * i + (lane >> 5); scr[kk * 33 + (lane & 31)] = W[(size_t)(k0 + kk) * N + n0 + (lane & 31)]; }
    LDS_WAIT(); asm volatile("" ::: "memory");
    const int c = lane & 7;
#pragma unroll
    for (int j = 0; j < 4; ++j) { const int n = (lane >> 3) + 8 * j; const LAS float* s = scr + (8 * c) * 33 + n;
        u32x4 o; o.x = cvt_pk_bf16(s[0 * 33], s[1 * 33]); o.y = cvt_pk_bf16(s[2 * 33], s[3 * 33]); o.z = cvt_pk_bf16(s[4 * 33], s[5 * 33]); o.w = cvt_pk_bf16(s[6 * 33], s[7 * 33]);
        *(u32x4*)(WT + (size_t)(drow + n) * K + k0 + 8 * c) = o; }
    LDS_WAIT(); asm volatile("" ::: "memory");
}
__device__ __forceinline__ void transpose_item(const float* W, int K, int N, bf16_t* WT, int item, bool qperm, LAS float* scr, int lane) {
    const int nblk = N / 32, kb = item / nblk, nb = item % nblk, n0 = 32 * nb;
    int drow = n0;
    if (qperm) { const int h = n0 / 192, e = n0 % 192; drow = (e < 128) ? h * 128 + e : 1024 + (h >> 2) * 256 + 128 * ((e - 128) >> 5) + 32 * (h & 3); }
    transpose_block(W, K, N, WT, 64 * kb, n0, drow, scr, lane);
}
__device__ __forceinline__ void ada_item(Frame& F, int item) {
    LOCAL_IDS();
    const int layer = item / 96, col0 = (item % 96) * 64, w = wave;
    LAS float* slab = (LAS float*)F.lds + w * 2560;
    const float* W = F.in[6] + (size_t)layer * 1024 * 6144;
    float acc[40];
#pragma unroll
    for (int b = 0; b < 40; ++b) acc[b] = 0.f;
    for (int hh = 0; hh < 2; ++hh) {
        const int kbase = 128 * w + 64 * hh;
#pragma unroll 8
        for (int b = 0; b < 40; ++b) { const float c = (b < NB_P ? F.in[4] + b * DM : F.in[5] + (b - NB_P) * DM)[kbase + lane];
            slab[lane * 40 + b] = c * __builtin_amdgcn_rcpf(1.f + __expf(-c)); }
        LDS_WAIT(); asm volatile("" ::: "memory");
        for (int kk = 0; kk < 64; ++kk) { const float wv = W[(size_t)(kbase + kk) * 6144 + col0 + lane];
#pragma unroll
            for (int b4 = 0; b4 < 10; ++b4) { const f32x4 s = *(const LAS f32x4*)(slab + kk * 40 + 4 * b4);
                acc[4 * b4 + 0] += s[0] * wv; acc[4 * b4 + 1] += s[1] * wv; acc[4 * b4 + 2] += s[2] * wv; acc[4 * b4 + 3] += s[3] * wv; } }
        LDS_WAIT(); asm volatile("" ::: "memory");
    }
    __syncthreads();
    LAS float* red = (LAS float*)F.lds;
#pragma unroll
    for (int b = 0; b < 40; ++b) red[(w * 40 + b) * 64 + lane] = acc[b];
    __syncthreads();
    float* MODF = (float*)(F.ws + WS_MODF) + (size_t)layer * 40 * 6144;
    const float* bias = F.in[7] + (size_t)layer * 6144;
    for (int o = tid; o < 2560; o += 512) { const int b = o >> 6, l = o & 63; float s = bias[col0 + l];
#pragma unroll
        for (int ww = 0; ww < 8; ++ww) s += red[(ww * 40 + b) * 64 + l];
        MODF[(size_t)b * 6144 + col0 + l] = s; }
    __syncthreads();
}
__device__ __forceinline__ void cvt8(const float* src, bf16_t* dst) {
    const f32x4 a = *(const f32x4*)src, b = *(const f32x4*)(src + 4);
    u32x4 w; w.x = cvt_pk_bf16(a[0], a[1]); w.y = cvt_pk_bf16(a[2], a[3]); w.z = cvt_pk_bf16(b[0], b[1]); w.w = cvt_pk_bf16(b[2], b[3]);
    *(u32x4*)dst = w;
}
__device__ __forceinline__ void p0_phase(Frame& F) {
    LOCAL_IDS();
    for (int it = blockIdx.x; it < 192; it += F.G) ada_item(F, it);
    LAS float* scr = (LAS float*)(F.lds + wave * 8704);
    const int gw = blockIdx.x * 8 + wave, NGW = F.G * 8;
    unsigned char* ws = F.ws;
    constexpr int I_WIN = 16 * 22, I_WQ = 6 * 48, I_WUK = 4 * 32, I_WO = 16 * 32, I_W1 = 16 * 128, I_W2 = 64 * 32, I_CWIN = 16 * 64;
    constexpr int NITEMS = I_WIN + I_WQ + 2 * I_WUK + I_WO + 2 * I_W1 + 2 * I_W2 + I_CWIN + I_WO;
    for (int it = gw; it < NITEMS; it += NGW) {
        int r = it;
        if (r < I_WIN) { transpose_item(F.in[12], 1024, 704, (bf16_t*)(ws + WS_WIN), r, false, scr, lane); continue; } r -= I_WIN;
        if (r < I_WQ) { transpose_item(F.in[15], 384, 1536, (bf16_t*)(ws + WS_WQ), r, true, scr, lane); continue; } r -= I_WQ;
        if (r < I_WUK) { transpose_item(F.in[16], 256, 1024, (bf16_t*)(ws + WS_WUK), r, false, scr, lane); continue; } r -= I_WUK;
        if (r < I_WUK) { transpose_item(F.in[17], 256, 1024, (bf16_t*)(ws + WS_WUV), r, false, scr, lane); continue; } r -= I_WUK;
        if (r < I_WO) { transpose_item(F.in[22], 1024, 1024, (bf16_t*)(ws + WS_WO), r, false, scr, lane); continue; } r -= I_WO;
        if (r < 2 * I_W1) { const int l = r / I_W1; transpose_item(F.in[10] + (size_t)l * 1024 * 4096, 1024, 4096, (bf16_t*)(ws + WS_W1) + (size_t)l * 4096 * 1024, r % I_W1, false, scr, lane); continue; } r -= 2 * I_W1;
        if (r < 2 * I_W2) { const int l = r / I_W2; transpose_item(F.in[11] + (size_t)l * 1024 * 4096, 4096, 1024, (bf16_t*)(ws + WS_W2) + (size_t)l * 4096 * 1024, r % I_W2, false, scr, lane); continue; } r -= 2 * I_W2;
        if (r < I_CWIN) { transpose_item(F.in[23], 1024, 2048, (bf16_t*)(ws + WS_CWIN), r, false, scr, lane); continue; } r -= I_CWIN;
        transpose_item(F.in[27], 1024, 1024, (bf16_t*)(ws + WS_CWO), r, false, scr, lane);
    }
    const long gt = (long)blockIdx.x * 512 + tid, NT = (long)F.G * 512;
    { const float* src = F.in[2]; bf16_t* dst = (bf16_t*)(ws + WS_CKV) + (size_t)MT * 256;
      for (long i = gt; i < (long)NCACHE * 256 / 8; i += NT) cvt8(src + i * 8, dst + i * 8); }
    { const float* src = F.in[3]; bf16_t* dst = (bf16_t*)(ws + WS_KPE);
      for (long i = gt; i < (long)NCACHE * 64 / 8; i += NT) cvt8(src + i * 8, dst + i * 8); }
    { const float* src = F.in[16]; const float* gk = F.in[20]; bf16_t* dst = (bf16_t*)(ws + WS_WUKN);
      for (long i = gt; i < 256 * 1024 / 8; i += NT) { const int d = (int)(i * 8) & 127;
          const f32x4 a = *(const f32x4*)(src + i * 8) * *(const f32x4*)(gk + d), b = *(const f32x4*)(src + i * 8 + 4) * *(const f32x4*)(gk + d + 4);
          u32x4 w; w.x = cvt_pk_bf16(a[0], a[1]); w.y = cvt_pk_bf16(a[2], a[3]); w.z = cvt_pk_bf16(b[0], b[1]); w.w = cvt_pk_bf16(b[2], b[3]);
          *(u32x4*)(dst + i * 8) = w; } }
}

__device__ __forceinline__ void xb_load(const bf16_t* p, f32x4& v) { const u32x2 w = *(const u32x2*)p; v = (f32x4){bflo(w.x), bfhi(w.x), bflo(w.y), bfhi(w.y)}; }
__device__ __forceinline__ void tail_row(Frame& F, int row, int lane, const float* tgate, const float* tbase, f32x4 (&v)[4], bool to_out) {
    const float* P = (const float*)(F.ws + WS_PBUF) + (size_t)(row - MP) * DM;
    bf16_t* XB = (bf16_t*)(F.ws + WS_V);
    const float* gp = tgate + (size_t)row_seq(row) * 6144;
#pragma unroll
    for (int j = 0; j < 4; ++j) { const int c = 4 * lane + 256 * j; f32x4 s = *(const f32x4*)(P + c);
#pragma unroll
        for (int k = 1; k < KSPL; ++k) s += *(const f32x4*)(P + (size_t)k * MS * DM + c);
        f32x4 base; if (tbase) base = *(const f32x4*)(tbase + (size_t)(row - MP) * DM + c); else xb_load(XB + (size_t)row * DM + c, base);
        v[j] = base + *(const f32x4*)(gp + c) * s;
        if (to_out) *(f32x4*)(F.out + (size_t)row * DM + c) = v[j];
        else { u32x2 w; w.x = cvt_pk_bf16(v[j][0], v[j][1]); w.y = cvt_pk_bf16(v[j][2], v[j][3]); *(u32x2*)(XB + (size_t)row * DM + c) = w; } }
}
template <int SRC> __device__ __forceinline__ void modnorm_phase(Frame& F, int layer, int which, const float* tgate, const float* tbase) {
    LOCAL_IDS();
    const int gw = blockIdx.x * 8 + wave, NGW = F.G * 8;
    const float* g = (which ? F.in[9] : F.in[8]) + layer * DM;
    const float* MODF = (const float*)(F.ws + WS_MODF) + (size_t)layer * 40 * 6144;
    bf16_t* H = (bf16_t*)(F.ws + WS_H);
    for (int row = gw; row < MT; row += NGW) {
        const float* xr = SRC == 0 ? (row < MP ? F.in[0] + (size_t)row * DM : F.in[1] + (size_t)(row - MP) * DM) : F.out + (size_t)row * DM;
        const float* md = MODF + (size_t)row_seq(row) * 6144 + which * 3072;
        f32x4 v[4]; float ss = 0.f;
        if (tgate != nullptr && row >= MP) tail_row(F, row, lane, tgate, tbase, v, false);
        else {
#pragma unroll
            for (int j = 0; j < 4; ++j) { if (SRC == 0) v[j] = *(const f32x4*)(xr + 4 * lane + 256 * j); else xb_load((const bf16_t*)(F.ws + WS_V) + (size_t)row * DM + 4 * lane + 256 * j, v[j]); } }
#pragma unroll
        for (int j = 0; j < 4; ++j) ss += (v[j][0] * v[j][0] + v[j][1] * v[j][1]) + (v[j][2] * v[j][2] + v[j][3] * v[j][3]);
        const float rs = __builtin_amdgcn_rsqf(wave_sum(ss) * (1.f / DM) + EPS);
#pragma unroll
        for (int j = 0; j < 4; ++j) { const int c = 4 * lane + 256 * j;
            const f32x4 gg = *(const f32x4*)(g + c), sh = *(const f32x4*)(md + c), sc = *(const f32x4*)(md + 1024 + c);
            const f32x4 o = v[j] * rs * gg * (sc + 1.f) + sh;
            u32x2 w; w.x = cvt_pk_bf16(o[0], o[1]); w.y = cvt_pk_bf16(o[2], o[3]);
            *(u32x2*)(H + (size_t)row * DM + c) = w; }
    }
}
__device__ __forceinline__ void final_tail_phase(Frame& F, const float* tgate) {
    LOCAL_IDS();
    const int gw = blockIdx.x * 8 + wave, NGW = F.G * 8;
    for (int row = MP + gw; row < MT; row += NGW) { f32x4 v[4]; tail_row(F, row, lane, tgate, nullptr, v, true); }
}

__device__ __forceinline__ void latent_phase(Frame& F) {
    LOCAL_IDS();
    const int gw = blockIdx.x * 8 + wave, NGW = F.G * 8;
    const bf16_t* A0 = (const bf16_t*)(F.ws + WS_A0);
    bf16_t* CQ = (bf16_t*)(F.ws + WS_CQ); bf16_t* CKV = (bf16_t*)(F.ws + WS_CKV); bf16_t* KR = (bf16_t*)(F.ws + WS_KR);
    const float* gqa = F.in[13]; const float* gkva = F.in[14]; const float* gkr = F.in[21];
    const float inv = rope_inv(lane & 31);
    for (int row = gw; row < MT; row += NGW) {
        const bf16_t* a = A0 + (size_t)row * 768;
        f32x2 q[3]; float s1 = 0.f;
#pragma unroll
        for (int j = 0; j < 3; ++j) { const unsigned w = *(const unsigned*)(a + 2 * lane + 128 * j); q[j] = (f32x2){bflo(w), bfhi(w)}; s1 += q[j][0] * q[j][0] + q[j][1] * q[j][1]; }
        f32x4 kv; { const u32x2 w = *(const u32x2*)(a + 384 + 4 * lane); kv = (f32x4){bflo(w.x), bfhi(w.x), bflo(w.y), bfhi(w.y)}; }
        float s2 = (kv[0] * kv[0] + kv[1] * kv[1]) + (kv[2] * kv[2] + kv[3] * kv[3]);
        const float kr = bf2f(a[640 + lane]); float s3 = kr * kr;
        s1 = wave_sum(s1); s2 = wave_sum(s2); s3 = wave_sum(s3);
        const float r1 = __builtin_amdgcn_rsqf(s1 * (1.f / 384.f) + EPS), r2 = __builtin_amdgcn_rsqf(s2 * (1.f / 256.f) + EPS), r3 = __builtin_amdgcn_rsqf(s3 * (1.f / 64.f) + EPS);
#pragma unroll
        for (int j = 0; j < 3; ++j) { const int c = 2 * lane + 128 * j; const f32x2 gg = *(const f32x2*)(gqa + c);
            *(unsigned*)(CQ + (size_t)row * 384 + c) = cvt_pk_bf16(q[j][0] * r1 * gg[0], q[j][1] * r1 * gg[1]); }
        { const f32x4 gg = *(const f32x4*)(gkva + 4 * lane); const f32x4 o = kv * r2 * gg;
          float* op = row < MP ? F.out + OUT_CKVP + (size_t)row * 256 : F.out + OUT_CKVS + (size_t)(row - MP) * 256;
          *(f32x4*)(op + 4 * lane) = o;
          u32x2 w; w.x = cvt_pk_bf16(o[0], o[1]); w.y = cvt_pk_bf16(o[2], o[3]);
          *(u32x2*)(CKV + (size_t)row * 256 + 4 * lane) = w; }
        { const float y = kr * r3 * gkr[lane]; const auto yy = __builtin_amdgcn_permlane32_swap(__float_as_uint(y), __float_as_uint(y), false, false); const float yo = __uint_as_float(lane < 32 ? yy[1] : yy[0]);
          float sn, cs; sincos_rev((float)row_pos(row) * inv, sn, cs);
          const float o = lane < 32 ? y * cs - yo * sn : y * cs + yo * sn;
          float* op = row < MP ? F.out + OUT_KPEP + (size_t)row * 64 : F.out + OUT_KPES + (size_t)(row - MP) * 64;
          op[lane] = o; KR[(size_t)row * 64 + lane] = f2bf(o); }
    }
}

namespace att {
#define SBAR() __builtin_amdgcn_sched_barrier(0)
constexpr float THR = 8.f;
__device__ __forceinline__ int crow(int r, int hi) { return (r & 3) + 8 * (r >> 2) + 4 * hi; }
__device__ __forceinline__ void partialSM(f32x16& p0, f32x16& p1, float& m_reg, float& mn, float& alpha) {
    constexpr float C = SM_SCALE * 1.4426950408889634f;
    float pmax = p0[0];
#pragma unroll
    for (int r = 1; r < 16; ++r) pmax = fmaxf(pmax, p0[r]);
#pragma unroll
    for (int r = 0; r < 16; ++r) pmax = fmaxf(pmax, p1[r]);
    { auto rr = __builtin_amdgcn_permlane32_swap(__float_as_uint(pmax), __float_as_uint(pmax), false, false);
      pmax = fmaxf(__uint_as_float(rr[0]), __uint_as_float(rr[1])); }
    if (__builtin_expect(__all(pmax - m_reg <= THR / SM_SCALE), 1)) { mn = m_reg; alpha = 1.f; }
    else { mn = fmaxf(m_reg, pmax); alpha = __builtin_amdgcn_exp2f((m_reg - mn) * C); m_reg = mn; }
    const float mnC = -mn * C;
#pragma unroll
    for (int r = 0; r < 16; ++r) p0[r] = fmaf(p0[r], C, mnC);
#pragma unroll
    for (int r = 0; r < 16; ++r) p1[r] = fmaf(p1[r], C, mnC);
#pragma unroll
    for (int r = 0; r < 16; ++r) p0[r] = __builtin_amdgcn_exp2f(p0[r]);
}
__device__ __forceinline__ void finishSM(f32x16& p0, f32x16& p1, float alpha, float& l_reg, bf16x8& pa0, bf16x8& pa1, bf16x8& pa2, bf16x8& pa3) {
#pragma unroll
    for (int r = 0; r < 16; ++r) p1[r] = __builtin_amdgcn_exp2f(p1[r]);
    float ps = 0;
#pragma unroll
    for (int r = 0; r < 16; ++r) ps += p0[r];
#pragma unroll
    for (int r = 0; r < 16; ++r) ps += p1[r];
    { auto rr = __builtin_amdgcn_permlane32_swap(__float_as_uint(ps), __float_as_uint(ps), false, false);
      ps = __uint_as_float(rr[0]) + __uint_as_float(rr[1]); }
    l_reg = l_reg * alpha + ps;
#define PK4(P, BASE, OUT) do { unsigned a0 = cvt_pk_bf16(P[BASE + 0], P[BASE + 1]), a1 = cvt_pk_bf16(P[BASE + 2], P[BASE + 3]);   \
    unsigned b0 = cvt_pk_bf16(P[BASE + 4], P[BASE + 5]), b1 = cvt_pk_bf16(P[BASE + 6], P[BASE + 7]);                              \
    auto r0 = __builtin_amdgcn_permlane32_swap(a0, b0, false, false); auto r1 = __builtin_amdgcn_permlane32_swap(a1, b1, false, false); \
    u32x4 w = {r0[0], r1[0], r0[1], r1[1]}; OUT = *reinterpret_cast<bf16x8*>(&w); } while (0)
    PK4(p0, 0, pa0); PK4(p0, 8, pa1); PK4(p1, 0, pa2); PK4(p1, 8, pa3);
#undef PK4
}
__device__ __forceinline__ int v_st(int k, int c) { const int kk = (k & ~0xC) | ((k & 4) << 1) | ((k & 8) >> 1); return ((kk >> 3) * 4 + (c >> 5)) * 512 + ((kk & 7) * 32 + (c & 31)) * 2; }
__device__ __forceinline__ int v_rd_base(int lane) { return ((lane & 3) << 3) | (((lane >> 2) & 3) << 6) | (((lane >> 4) & 1) << 5) | (((lane >> 5) & 1) << 8); }
constexpr int v_rd_off(int d0, int ks, int half) { return d0 * 512 + ks * 4096 + half * 2048; }
template <int OFF> __device__ __forceinline__ s16x4 tr_read(int vb) {
    s16x4 r; asm volatile("ds_read_b64_tr_b16 %0, %1 offset:%2" : "=&v"(r) : "v"(vb), "i"(OFF) : "memory"); return r;
}
template <int D0> __device__ __forceinline__ void pv_one(f32x16& od, int vb, bf16x8 pa0, bf16x8 pa1, bf16x8 pa2, bf16x8 pa3) {
    const s16x4 l0 = tr_read<v_rd_off(D0, 0, 0)>(vb), h0 = tr_read<v_rd_off(D0, 0, 1)>(vb), l1 = tr_read<v_rd_off(D0, 1, 0)>(vb), h1 = tr_read<v_rd_off(D0, 1, 1)>(vb);
    const s16x4 l2 = tr_read<v_rd_off(D0, 2, 0)>(vb), h2 = tr_read<v_rd_off(D0, 2, 1)>(vb), l3 = tr_read<v_rd_off(D0, 3, 0)>(vb), h3 = tr_read<v_rd_off(D0, 3, 1)>(vb);
    asm volatile("s_waitcnt lgkmcnt(0)" ::: "memory"); SBAR();
#define PK(L, H) (bf16x8){L[0], L[1], L[2], L[3], H[0], H[1], H[2], H[3]}
    od = __builtin_amdgcn_mfma_f32_32x32x16_bf16(pa0, PK(l0, h0), od, 0, 0, 0);
    od = __builtin_amdgcn_mfma_f32_32x32x16_bf16(pa1, PK(l1, h1), od, 0, 0, 0);
    od = __builtin_amdgcn_mfma_f32_32x32x16_bf16(pa2, PK(l2, h2), od, 0, 0, 0);
    od = __builtin_amdgcn_mfma_f32_32x32x16_bf16(pa3, PK(l3, h3), od, 0, 0, 0);
#undef PK
}
__device__ __forceinline__ void pv_d0(f32x16* o, int vb, bf16x8 pa0, bf16x8 pa1, bf16x8 pa2, bf16x8 pa3) {
    pv_one<0>(o[0], vb, pa0, pa1, pa2, pa3); pv_one<1>(o[1], vb, pa0, pa1, pa2, pa3); pv_one<2>(o[2], vb, pa0, pa1, pa2, pa3); pv_one<3>(o[3], vb, pa0, pa1, pa2, pa3);
}

constexpr int P_SHM_V = 64 * 128 * 2, P_SHM_K = 64 * 192 * 2;
#define KSWZ192(row, colB) ((row) * 384 + ((colB) ^ (((row) & 7) << 4)))
__device__ __forceinline__ void qkt192(f32x16& p0, f32x16& p1, const LAS char* Ks, const int (&ka)[4], const bf16x8* qr, const LAS char* QRl, int hi, bool vis) {
    if (vis) {
        p0 = f32x16{}; p1 = f32x16{};
#pragma unroll
        for (int d0 = 0; d0 < 12; ++d0) {
            const bf16x8 b0 = *reinterpret_cast<const LAS bf16x8*>(Ks + ka[d0 & 3] + (d0 >> 2) * 128);
            const bf16x8 b1 = *reinterpret_cast<const LAS bf16x8*>(Ks + ka[d0 & 3] + (d0 >> 2) * 128 + 32 * 384);
            const bf16x8 qf = d0 < 8 ? qr[d0 < 8 ? d0 : 0] : *reinterpret_cast<const LAS bf16x8*>(QRl + ((d0 - 8) * 16 + hi * 8) * 2);
            p0 = __builtin_amdgcn_mfma_f32_32x32x16_bf16(b0, qf, p0, 0, 0, 0);
            p1 = __builtin_amdgcn_mfma_f32_32x32x16_bf16(b1, qf, p1, 0, 0, 0); }
    } else {
#pragma unroll
        for (int r = 0; r < 16; ++r) { p0[r] = -1e30f; p1[r] = -1e30f; }
    }
}
__device__ __forceinline__ void prompt_unit(int b, int h, int qb, const bf16_t* __restrict__ Q, const bf16_t* __restrict__ KN, const bf16_t* __restrict__ KR,
                                            const bf16_t* __restrict__ V, bf16_t* __restrict__ O, LAS char* lds) {
    int tid_l_ = threadIdx.x; asm volatile("" : "+v"(tid_l_));
    const int tid = tid_l_, wid = tid >> 6, lane = tid & 63, r32 = lane & 31, hi = lane >> 5;
    LAS char* V_lds = lds; LAS char* K_lds = lds + 2 * P_SHM_V;
    LAS float* wsc = (LAS float*)(lds + 2 * P_SHM_V + 2 * P_SHM_K) + wid * 64; LAS float* li_l = wsc; LAS float* al_l = wsc + 32;
    float m_reg = -1e30f, l_reg = 0; f32x16 o[4] = {}; bf16x8 qr[8];
    LAS char* QRl = lds + 2 * P_SHM_V + 2 * P_SHM_K + 2048 + wid * 4608 + r32 * 144;
    const size_t rowbase = (size_t)b * SEQ;
    const bf16_t* Qw = Q + (rowbase + qb * 256 + wid * 32 + r32) * 1536 + h * 192 + hi * 8;
#pragma unroll
    for (int d0 = 0; d0 < 8; ++d0) qr[d0] = *reinterpret_cast<const bf16x8*>(Qw + d0 * 16);
#pragma unroll
    for (int d0 = 8; d0 < 12; ++d0) *reinterpret_cast<LAS bf16x8*>(QRl + ((d0 - 8) * 16 + hi * 8) * 2) = *reinterpret_cast<const bf16x8*>(Qw + d0 * 16);
    int ka[4];
#pragma unroll
    for (int k = 0; k < 4; ++k) ka[k] = r32 * 384 + ((k * 32 + hi * 16) ^ ((r32 & 7) << 4));
    const int cw = 4 * qb + (wid >> 1);
    const int sr = tid >> 4, sc = (tid & 15) * 8, vst0 = v_st(sr, sc), vst1 = v_st(32 + sr, sc), krr = tid >> 3, krc = (tid & 7) * 8;
    const int vb0 = (int)(uintptr_t)V_lds + v_rd_base(lane);
    const bf16_t* Vh = V + rowbase * 1024 + h * 128; const bf16_t* Kh = KN + rowbase * 1024 + h * 128; const bf16_t* Rh = KR + rowbase * 64;
    struct { bf16x8 vs0, vs1, ks0, ks1, kr; } sr_[1];
#define SLOAD(i, k0) do { sr_[i].vs0 = *reinterpret_cast<const bf16x8*>(&Vh[(size_t)((k0) + sr) * 1024 + sc]); sr_[i].vs1 = *reinterpret_cast<const bf16x8*>(&Vh[(size_t)((k0) + 32 + sr) * 1024 + sc]); \
    sr_[i].ks0 = *reinterpret_cast<const bf16x8*>(&Kh[(size_t)((k0) + sr) * 1024 + sc]); sr_[i].ks1 = *reinterpret_cast<const bf16x8*>(&Kh[(size_t)((k0) + 32 + sr) * 1024 + sc]); \
    sr_[i].kr = *reinterpret_cast<const bf16x8*>(&Rh[(size_t)((k0) + krr) * 64 + krc]); } while (0)
#define SWRITE(bb, i) do { *(LAS bf16x8*)(V_lds + (bb) * P_SHM_V + vst0) = sr_[i].vs0; *(LAS bf16x8*)(V_lds + (bb) * P_SHM_V + vst1) = sr_[i].vs1; const int kc = sc * 2; \
    *(LAS bf16x8*)(K_lds + (bb) * P_SHM_K + KSWZ192(sr, kc)) = sr_[i].ks0; *(LAS bf16x8*)(K_lds + (bb) * P_SHM_K + KSWZ192(32 + sr, kc)) = sr_[i].ks1; \
    *(LAS bf16x8*)(K_lds + (bb) * P_SHM_K + KSWZ192(krr, 256 + krc * 2)) = sr_[i].kr; } while (0)
#define SWAIT() asm volatile("s_waitcnt vmcnt(0)" ::: "memory")
#define RESC(a) do { if (__any((a) < 1.f)) { if (hi == 0) al_l[r32] = (a); asm volatile("s_waitcnt lgkmcnt(0)" ::: "memory"); \
    _Pragma("unroll") for (int d = 0; d < 4; ++d) _Pragma("unroll") for (int r = 0; r < 16; ++r) o[d][r] *= al_l[crow(r, hi)]; } } while (0)
    f32x16 pA0, pA1, pB0, pB1; float mnA, mnB, alA, alB; bf16x8 pa0, pa1, pa2, pa3; const int NT = 4 * qb + 4;
    constexpr int SE = 0, SO = 0;
    SLOAD(SE, 0); asm volatile("s_waitcnt vmcnt(0)" ::: "memory"); SWRITE(0, SE); __syncthreads();
    qkt192(pA0, pA1, K_lds, ka, qr, QRl, hi, true); partialSM(pA0, pA1, m_reg, mnA, alA);
    SLOAD(SO, 64);
    SWAIT(); SWRITE(1, SO); __syncthreads();
    for (int j = 1; j + 1 < NT; j += 2) {
        SBAR(); qkt192(pB0, pB1, K_lds + P_SHM_K, ka, qr, QRl, hi, j <= cw);
        finishSM(pA0, pA1, alA, l_reg, pa0, pa1, pa2, pa3); SBAR();
        SLOAD(SO, (j + 1) * 64); SBAR();
        if (j - 1 <= cw) pv_d0(o, vb0, pa0, pa1, pa2, pa3);
        partialSM(pB0, pB1, m_reg, mnB, alB);
        __syncthreads(); SWAIT(); SWRITE(0, SE);
        RESC(alB); __syncthreads();
        SBAR(); qkt192(pA0, pA1, K_lds, ka, qr, QRl, hi, j + 1 <= cw);
        finishSM(pB0, pB1, alB, l_reg, pa0, pa1, pa2, pa3); SBAR();
        SLOAD(SE, (j + 2) * 64); SBAR();
        if (j <= cw) pv_d0(o, vb0 + P_SHM_V, pa0, pa1, pa2, pa3);
        partialSM(pA0, pA1, m_reg, mnA, alA);
        __syncthreads(); SWAIT(); SWRITE(1, SO);
        RESC(alA); __syncthreads();
    }
    SBAR(); qkt192(pB0, pB1, K_lds + P_SHM_K, ka, qr, QRl, hi, NT - 1 <= cw);
    finishSM(pA0, pA1, alA, l_reg, pa0, pa1, pa2, pa3); SBAR();
    if (NT - 2 <= cw) pv_d0(o, vb0, pa0, pa1, pa2, pa3);
    partialSM(pB0, pB1, m_reg, mnB, alB);
    __syncthreads(); RESC(alB);
    finishSM(pB0, pB1, alB, l_reg, pa0, pa1, pa2, pa3); SBAR();
    if (NT - 1 <= cw) pv_d0(o, vb0 + P_SHM_V, pa0, pa1, pa2, pa3);
    if (hi == 0) li_l[r32] = l_reg; asm volatile("s_waitcnt lgkmcnt(0)" ::: "memory");
    float rli[16];
#pragma unroll
    for (int r = 0; r < 16; ++r) rli[r] = __builtin_amdgcn_rcpf(li_l[crow(r, hi)]);
    bf16_t* Ow = O + (rowbase + qb * 256 + wid * 32) * 1024 + h * 128;
#pragma unroll
    for (int r = 0; r < 16; ++r) { const int orow = crow(r, hi);
#pragma unroll
        for (int d0 = 0; d0 < 4; ++d0) Ow[(size_t)orow * 1024 + d0 * 32 + r32] = f2bf(o[d0][r] * rli[r]); }
    __syncthreads();
#undef SLOAD
#undef SWRITE
#undef SWAIT
#undef RESC
}

constexpr int S_QP = 264;
constexpr int S_OFF_Q = 0, S_OFF_K = 8 * 16 * S_QP * 2  , S_OFF_V = S_OFF_K + 64 * 640  , S_OFF_RS = S_OFF_V + 32768, S_OFF_SC = S_OFF_RS + 2048  , S_END = S_OFF_SC + 2048;
static_assert(S_END <= LDS_MISC, "sample LDS map");
#define KSWZ320(row, colB) ((row) * 640 + ((colB) ^ (((row) & 7) << 4)))
__device__ __forceinline__ void sample_unit(int sb, int sp, const bf16_t* __restrict__ Q, const bf16_t* __restrict__ WUKN, const bf16_t* __restrict__ CKV, const bf16_t* __restrict__ KPE,
                                            const bf16_t* __restrict__ KR, const float* __restrict__ RS, float* __restrict__ PART, float* __restrict__ ML, LAS char* lds) {
    int tid_l_ = threadIdx.x; asm volatile("" : "+v"(tid_l_));
    const int tid = tid_l_, h = tid >> 6, lane = tid & 63, r32 = lane & 31, hi = lane >> 5, q16 = r32 & 15;
    LAS char* Q_lds = lds + S_OFF_Q + h * (16 * S_QP * 2); LAS char* K_lds = lds + S_OFF_K; LAS char* V_lds = lds + S_OFF_V;
    LAS float* rs_lds = (LAS float*)(lds + S_OFF_RS); LAS float* al_l = (LAS float*)(lds + S_OFF_SC) + h * 64;
    const size_t qrow = (size_t)MP + sb * 16 + q16;
    {
        bf16x8 qa[8];
#pragma unroll
        for (int ks = 0; ks < 8; ++ks) qa[ks] = *reinterpret_cast<const bf16x8*>(Q + qrow * 1536 + h * 192 + ks * 16 + hi * 8);
        LAS char* qw = Q_lds + ((4 * hi) * S_QP + r32) * 2;
        const bf16_t* wp = WUKN + (size_t)r32 * 1024 + h * 128 + hi * 8;
#pragma unroll 1
        for (int nb = 0; nb < 8; ++nb) {
            f32x16 acc = {};
#pragma unroll
            for (int ks = 0; ks < 8; ++ks) { const bf16x8 wb = *reinterpret_cast<const bf16x8*>(wp + ks * 16);
                acc = __builtin_amdgcn_mfma_f32_32x32x16_bf16(qa[ks], wb, acc, 0, 0, 0); }
#pragma unroll
            for (int r = 0; r < 8; ++r) *(LAS bf16_t*)(qw + (((r & 3) + 8 * (r >> 2)) * S_QP) * 2) = f2bf(acc[r]);
            qw += 64; wp += 32 * 1024;
        }
    }
    __syncthreads();
    const int hp = h & 3, vh = h >> 2, hl = 2 * hp + (r32 >> 4);
    bf16x8 qrp[4];
#pragma unroll
    for (int d0 = 0; d0 < 4; ++d0) qrp[d0] = *reinterpret_cast<const bf16x8*>(Q + qrow * 1536 + hl * 192 + 128 + d0 * 16 + hi * 8);
    float m_reg = -1e30f, l_reg = 0; f32x16 o[4] = {};
    const int vb0 = (int)(uintptr_t)V_lds + vh * 16384 + v_rd_base(lane);
    const int ntile = (sp == NSPLIT - 1) ? 17 : 16;
    const int krr = tid >> 3, krc = (tid & 7) * 8;
    const int skey = tid >> 5, cc = (tid & 31) * 8;
    LAS char* kst = K_lds + skey * 640 + ((cc * 2) ^ ((skey & 7) << 4));
    LAS char* vst = V_lds + (cc >> 7) * 16384 + v_st(skey, cc & 127);
    LAS char* krst = K_lds + krr * 640 + ((512 + krc * 2) ^ ((krr & 7) << 4));
    int ka[4];
#pragma unroll
    for (int k = 0; k < 4; ++k) ka[k] = r32 * 640 + ((k * 32 + hi * 16) ^ ((r32 & 7) << 4));
    const LAS char* qfp = lds + S_OFF_Q + hl * (16 * S_QP * 2) + (q16 * S_QP + hi * 8) * 2;
    const LAS float* rsp = rs_lds + (4 * hi) * 8 + hl;
    bf16x8 c[4], kr; float rsv;
#define S_LOAD(T) do { const bool nw_ = ((T) == 16); \
        const size_t crow0 = nw_ ? (size_t)MP + sb * 16 : (size_t)MT + (size_t)sb * PAST + sp * 1024 + (T) * 64; \
        const bf16_t* rsrc = nw_ ? KR + ((size_t)MP + sb * 16) * 64 : KPE + ((size_t)sb * PAST + sp * 1024 + (T) * 64) * 64; \
        _Pragma("unroll") for (int i = 0; i < 4; ++i) { const int key = skey + 16 * i; \
            c[i] = (!nw_ || key < 16) ? *reinterpret_cast<const bf16x8*>(CKV + (crow0 + key) * 256 + cc) : bf16x8{}; } \
        kr = (!nw_ || krr < 16) ? *reinterpret_cast<const bf16x8*>(rsrc + (size_t)krr * 64 + krc) : bf16x8{}; \
        rsv = (!nw_ || krr < 16) ? RS[(crow0 + krr) * 8 + (tid & 7)] : 0.f; } while (0)
    S_LOAD(0);
#pragma unroll 1
    for (int t = 0; t < ntile; ++t) {
        const bool isnew = (t == 16);
        __syncthreads();
#pragma unroll
        for (int i = 0; i < 4; ++i) { *(LAS bf16x8*)(kst + i * 16 * 640) = c[i];
            *(LAS bf16x8*)(vst + i * 4096) = c[i]; }
        *(LAS bf16x8*)krst = kr;
        rs_lds[krr * 8 + (tid & 7)] = rsv;
        __syncthreads();
        if (t + 1 < ntile) S_LOAD(t + 1);
        SBAR();
        f32x16 p0 = {}, p1 = {};
#pragma unroll
        for (int d0 = 0; d0 < 16; ++d0) { if ((d0 & 3) == 0) SBAR();
            const bf16x8 b0 = *reinterpret_cast<const LAS bf16x8*>(K_lds + ka[d0 & 3] + (d0 >> 2) * 128);
            const bf16x8 b1 = *reinterpret_cast<const LAS bf16x8*>(K_lds + ka[d0 & 3] + (d0 >> 2) * 128 + 32 * 640);
            const bf16x8 qf = *reinterpret_cast<const LAS bf16x8*>(qfp + d0 * 32);
            p0 = __builtin_amdgcn_mfma_f32_32x32x16_bf16(b0, qf, p0, 0, 0, 0);
            p1 = __builtin_amdgcn_mfma_f32_32x32x16_bf16(b1, qf, p1, 0, 0, 0); }
        SBAR();
#pragma unroll
        for (int r = 0; r < 16; ++r) { p0[r] *= rsp[((r & 3) + 8 * (r >> 2)) * 8]; p1[r] *= rsp[(32 + (r & 3) + 8 * (r >> 2)) * 8]; }
#pragma unroll
        for (int d0 = 0; d0 < 4; ++d0) {
            const bf16x8 b0 = *reinterpret_cast<const LAS bf16x8*>(K_lds + ka[d0] + 512);
            const bf16x8 b1 = *reinterpret_cast<const LAS bf16x8*>(K_lds + ka[d0] + 512 + 32 * 640);
            p0 = __builtin_amdgcn_mfma_f32_32x32x16_bf16(b0, qrp[d0], p0, 0, 0, 0);
            p1 = __builtin_amdgcn_mfma_f32_32x32x16_bf16(b1, qrp[d0], p1, 0, 0, 0); }
        if (isnew) {
#pragma unroll
            for (int r = 0; r < 16; ++r) { if (r >= 8) p0[r] = -1e30f; p1[r] = -1e30f; }
        }
        float mn, al; bf16x8 pa0, pa1, pa2, pa3;
        partialSM(p0, p1, m_reg, mn, al);
        finishSM(p0, p1, al, l_reg, pa0, pa1, pa2, pa3);
        if (__any(al < 1.f)) { if (hi == 0) al_l[r32] = al; asm volatile("s_waitcnt lgkmcnt(0)" ::: "memory");
#pragma unroll
            for (int d = 0; d < 4; ++d)
#pragma unroll
                for (int r = 0; r < 16; ++r) o[d][r] *= al_l[crow(r, hi)]; }
        pv_d0(o, vb0, pa0, pa1, pa2, pa3);
    }
    const size_t ubase = ((size_t)sb * NSPLIT + sp) * 8;
    if (vh == 0 && lane < 32) { const size_t pb = (ubase + hl) * 16 + q16; ML[pb * 2] = m_reg; ML[pb * 2 + 1] = l_reg; }
#pragma unroll
    for (int r = 0; r < 16; ++r) { const int row = crow(r, hi); const size_t pb = (ubase + 2 * hp + (row >> 4)) * 16 + (row & 15);
#pragma unroll
        for (int d = 0; d < 4; ++d) PART[pb * 256 + vh * 128 + d * 32 + r32] = o[d][r]; }
    __syncthreads();
#undef S_LOAD
}
}

__device__ __forceinline__ void attention_phase(Frame& F, unsigned* ctr, bool ctr_is_second = false) {
    LOCAL_IDS();
    volatile LAS unsigned* misc = (volatile LAS unsigned*)(F.lds + LDS_MISC);
    const bf16_t* Q = (const bf16_t*)(F.ws + WS_A0); const bf16_t* KN = (const bf16_t*)(F.ws + WS_KN); const bf16_t* KR = (const bf16_t*)(F.ws + WS_KR);
    const bf16_t* V = (const bf16_t*)(F.ws + WS_V); bf16_t* O = (bf16_t*)(F.ws + WS_H);
    constexpr int NSU = NB_S * NSPLIT, NPU = NB_P * NH * 16;
    for (;;) {
        __syncthreads();
        if (tid == 0) misc[0] = atomicAdd(ctr, 1u);
        __syncthreads();
        const int unit = (int)misc[0];
#ifdef REP_SAMPLE_ONLY
        if (unit >= (ctr_is_second ? NSU : NSU + NPU)) break;
#else
        if (unit >= NSU + NPU) break;
#endif
        if (unit < NSU) {
#ifndef NO_SAMPLE
            att::sample_unit(unit >> 2, unit & 3, Q, (const bf16_t*)(F.ws + WS_WUKN), (const bf16_t*)(F.ws + WS_CKV), (const bf16_t*)(F.ws + WS_KPE), KR,
                             (const float*)(F.ws + WS_RS), (float*)(F.ws + WS_PART), (float*)(F.ws + WS_ML), (LAS char*)F.lds);
#endif
        } else {
#ifndef NO_PROMPT
#ifdef ORDER_BH
            const int pu = unit - NSU, qb = 15 - (pu & 15), bh = pu >> 4;
#else
            const int pu = unit - NSU, qb = 15 - pu / 64, bh = pu % 64;
#endif
            att::prompt_unit(bh >> 3, bh & 7, qb, Q, KN, KR, V, O, (LAS char*)F.lds);
#endif
        }
    }
}

__device__ __forceinline__ void combine_phase(Frame& F) {
    LOCAL_IDS();
    const int gw = blockIdx.x * 8 + wave, NGW = F.G * 8;
    LAS float* ol = (LAS float*)(F.lds + wave * 16384);
    const float* PART = (const float*)(F.ws + WS_PART); const float* ML = (const float*)(F.ws + WS_ML); const float* wuv = F.in[17];
    bf16_t* O = (bf16_t*)(F.ws + WS_H);
    constexpr float C = SM_SCALE * 1.4426950408889634f;
    for (int item = gw; item < NB_S * NH; item += NGW) {
        const int sb = item >> 3, h = item & 7;
        for (int q = 0; q < 16; ++q) {
            float m[NSPLIT], l[NSPLIT], mx = -1e30f;
#pragma unroll
            for (int s = 0; s < NSPLIT; ++s) { const size_t pb = ((((size_t)sb * NSPLIT + s) * 8 + h) * 16 + q); m[s] = ML[pb * 2]; l[s] = ML[pb * 2 + 1]; mx = fmaxf(mx, m[s]); }
            float L = 0.f; f32x4 acc = {0.f, 0.f, 0.f, 0.f};
#pragma unroll
            for (int s = 0; s < NSPLIT; ++s) { const size_t pb = ((((size_t)sb * NSPLIT + s) * 8 + h) * 16 + q); const float f = __builtin_amdgcn_exp2f((m[s] - mx) * C);
                L += f * l[s]; acc += *(const f32x4*)(PART + pb * 256 + 4 * lane) * f; }
#ifdef E1_TEST
            *(LAS f32x4*)(ol + q * 256 + 4 * lane) = (f32x4){0.001f * (q + lane), 0.002f, 0.003f * sb, 0.004f * h};
#else
            *(LAS f32x4*)(ol + q * 256 + 4 * lane) = acc * (1.f / L);
#endif
        }
        LDS_WAIT(); asm volatile("" ::: "memory");
        float a0[16], a1[16];
#pragma unroll
        for (int q = 0; q < 16; ++q) { a0[q] = 0.f; a1[q] = 0.f; }
        for (int l4 = 0; l4 < 64; ++l4) {
            float w0[4], w1[4];
#pragma unroll
            for (int t = 0; t < 4; ++t) { w0[t] = wuv[(size_t)(4 * l4 + t) * 1024 + h * 128 + lane]; w1[t] = wuv[(size_t)(4 * l4 + t) * 1024 + h * 128 + 64 + lane]; }
#pragma unroll
            for (int q = 0; q < 16; ++q) { const f32x4 x = *(const LAS f32x4*)(ol + q * 256 + 4 * l4);
                a0[q] += x[0] * w0[0] + x[1] * w0[1] + x[2] * w0[2] + x[3] * w0[3]; a1[q] += x[0] * w1[0] + x[1] * w1[1] + x[2] * w1[2] + x[3] * w1[3]; }
        }
#pragma unroll
        for (int q = 0; q < 16; ++q) { bf16_t* op = O + ((size_t)MP + sb * 16 + q) * 1024 + h * 128; op[lane] = f2bf(a0[q]); op[64 + lane] = f2bf(a1[q]); }
        LDS_WAIT(); asm volatile("" ::: "memory");
    }
}

__device__ __forceinline__ void sgu_phase(Frame& F) {
    LOCAL_IDS();
    const int wid = wave, r32 = lane & 31, hi = lane >> 5;
    LAS float* rsv_l = (LAS float*)F.lds;
    const bf16_t* VT = (const bf16_t*)(F.ws + WS_VT); const bf16_t* U = (const bf16_t*)(F.ws + WS_U); bf16_t* Gt = (bf16_t*)(F.ws + WS_G);
    const float* SSV = (const float*)(F.ws + WS_SSV); const float* ws_ = F.in[25]; const float* bs = F.in[26]; const float* gv = F.in[24];
    const int mb = wid & 3, nb0 = (wid >> 2) * 2;
    for (int unit = blockIdx.x; unit < 288 * 8; unit += F.G) {
        const int ch = unit >> 3, g = unit & 7; const bool smp = ch >= 256;
        const int tok0 = smp ? MP + (ch - 256) * 16 : ch * 128, ntok = smp ? 16 : 128;
        const bool active = !smp || mb == 0;
        const int ksteps = smp ? 1 : (mb < 2 ? 4 : 8);
        float ssp[8];
        if (tid < 128) {
#pragma unroll
            for (int p = 0; p < 8; ++p) ssp[p] = (tid < ntok) ? SSV[(size_t)p * VTP + tok0 + tid] : 0.f; }
        bf16x8 b0[8], b1[8]; bf16_t uv0[16], uv1[16];
        const int c0 = g * 128 + nb0 * 32 + r32;
        const float* wrow = ws_ + (size_t)g * 16384 + (size_t)(32 * mb + r32) * 128 + hi * 8;
        if (active) {
            const bf16_t* v0p = VT + (size_t)c0 * VTP + tok0 + hi * 8; const bf16_t* v1p = v0p + (size_t)32 * VTP;
#pragma unroll
            for (int ks = 0; ks < 8; ++ks) if (ks < ksteps) {
                b0[ks] = *reinterpret_cast<const bf16x8*>(v0p + ks * 16); b1[ks] = *reinterpret_cast<const bf16x8*>(v1p + ks * 16); }
        }
        if (active) {
#pragma unroll
            for (int r = 0; r < 16; ++r) { const int i = 32 * mb + att::crow(r, hi);
                if (i < ntok) { const size_t tok = (size_t)tok0 + i; uv0[r] = U[tok * 1024 + c0]; uv1[r] = U[tok * 1024 + c0 + 32]; } }
        }
        if (tid < 128) { float s = ((ssp[0] + ssp[1]) + (ssp[2] + ssp[3])) + ((ssp[4] + ssp[5]) + (ssp[6] + ssp[7]));
            rsv_l[tid] = (tid < ntok) ? __builtin_amdgcn_rsqf(s * (1.f / 1024.f) + EPS) : 0.f; }
        __syncthreads();
        if (active) {
            f32x16 acc0 = {}, acc1 = {};
#pragma unroll
            for (int ks = 0; ks < 8; ++ks) if (ks < ksteps) { const int j0 = ks * 16 + hi * 8;
                const f32x4 ra = *(const LAS f32x4*)(rsv_l + j0), rb = *(const LAS f32x4*)(rsv_l + j0 + 4);
                const f32x4 xa = *(const f32x4*)(wrow + ks * 16) * ra, xb = *(const f32x4*)(wrow + ks * 16 + 4) * rb;
                u32x4 aw; aw.x = cvt_pk_bf16(xa[0], xa[1]); aw.y = cvt_pk_bf16(xa[2], xa[3]); aw.z = cvt_pk_bf16(xb[0], xb[1]); aw.w = cvt_pk_bf16(xb[2], xb[3]);
                const bf16x8 af = *reinterpret_cast<bf16x8*>(&aw);
                acc0 = __builtin_amdgcn_mfma_f32_32x32x16_bf16(af, b0[ks], acc0, 0, 0, 0);
                acc1 = __builtin_amdgcn_mfma_f32_32x32x16_bf16(af, b1[ks], acc1, 0, 0, 0); }
            const float g0 = gv[c0], g1 = gv[c0 + 32];
#pragma unroll
            for (int r = 0; r < 16; ++r) { const int i = 32 * mb + att::crow(r, hi);
                if (i < ntok) { const size_t tok = (size_t)tok0 + i; const float bias = bs[g * 128 + i];
                    Gt[tok * 1024 + c0] = f2bf(bf2f(uv0[r]) * (acc0[r] * g0 + bias));
                    Gt[tok * 1024 + c0 + 32] = f2bf(bf2f(uv1[r]) * (acc1[r] * g1 + bias)); } }
        }
        if (smp) {
            for (int idx = tid; idx < 2048; idx += 512) { const int t = idx >> 7, c = g * 128 + (idx & 127);
                F.out[OUT_VS + (size_t)((ch - 256) * 16 + t) * 1024 + c] = bf2f(VT[(size_t)c * VTP + tok0 + t]) * rsv_l[t] * gv[c]; }
        }
        __syncthreads();
    }
}

#define XB_TMO      128
#define XB_XCNT(j)  (256  + 64 * (j))
#define XB_XSUB(j)  (1280 + 64 * (j))
#define XB_XGEN(j)  (2304 + 64 * (j))
#define XB_TOP      3328
#define XB_TOPGEN   3392
#define XCD_BAR_WORDS 3456
#define XB_SPIN_CAP (1u << 18)

__device__ __forceinline__ unsigned xb_ld(unsigned* p)              { return __hip_atomic_load(p, __ATOMIC_RELAXED, __HIP_MEMORY_SCOPE_AGENT); }
__device__ __forceinline__ unsigned xb_add(unsigned* p, unsigned v) { return __hip_atomic_fetch_add(p, v, __ATOMIC_RELAXED, __HIP_MEMORY_SCOPE_AGENT); }
__device__ __forceinline__ unsigned xb_xcc_id() { return (unsigned)__builtin_amdgcn_s_getreg((3 << 11) | 20) & 0xFu; }
#define XB_SPIN(cond, bar) do { unsigned _sp = 0; while (cond) { __builtin_amdgcn_s_sleep(1); \
    if ((++_sp & 255u) == 0u) { if (xb_ld(&(bar)[XB_TMO])) break; if (_sp > XB_SPIN_CAP) { atomicAdd(&(bar)[XB_TMO], 1u); break; } } } } while (0)

struct XcdBarrier {
    unsigned* bar; unsigned x;
    volatile LAS unsigned* st;
};

__device__ __forceinline__ XcdBarrier xcd_barrier_post(unsigned* bar, volatile LAS unsigned* st) {
    XcdBarrier b; b.bar = bar; b.x = xb_xcc_id(); b.st = st;
    if (threadIdx.x == 0) (void)xb_add(&bar[XB_XCNT(b.x)], 1u);
    return b;
}
__device__ __forceinline__ void xcd_barrier_complete(unsigned* bar, unsigned x, unsigned& nloc, unsigned& nx) {
    const unsigned G = gridDim.x * gridDim.y * gridDim.z;
    unsigned sum, cnt, mine, sp = 0u;
    for (;;) {
        sum = 0u; cnt = 0u; mine = 0u;
#pragma unroll
        for (unsigned j = 0; j < 16; ++j) { const unsigned c = xb_ld(&bar[XB_XCNT(j)]); sum += c; cnt += (c > 0u) ? 1u : 0u; mine = (j == x) ? c : mine; }
        if (sum == G) break;
        __builtin_amdgcn_s_sleep(1);
        if ((++sp & 255u) == 0u) { if (xb_ld(&bar[XB_TMO])) break; if (sp > XB_SPIN_CAP) { atomicAdd(&bar[XB_TMO], 1u); break; } }
    }
    nloc = mine > 0u ? mine : 1u; nx = cnt > 0u ? cnt : 1u;
}

__device__ __forceinline__ void xcd_barrier(const XcdBarrier& b) {
    asm volatile("s_waitcnt vmcnt(0)" ::: "memory");
    __syncthreads();
    if (threadIdx.x == 0) {
        unsigned* bar = b.bar;
        __builtin_amdgcn_s_waitcnt(0);
        unsigned nloc = b.st[0], nx = b.st[1];
        if (nloc == 0u) { xcd_barrier_complete(bar, b.x, nloc, nx); b.st[0] = nloc; b.st[1] = nx; }
        const unsigned old = xb_add(&bar[XB_XSUB(b.x)], 1u);
        const unsigned gen = old / nloc;
        if (old + 1u == (gen + 1u) * nloc) {
            __builtin_amdgcn_fence(__ATOMIC_RELEASE, "agent");
            asm volatile("s_waitcnt vmcnt(0)" ::: "memory");
            const unsigned og = xb_add(&bar[XB_TOP], 1u);
            const unsigned tg = og / nx;
            if (og + 1u == (tg + 1u) * nx) xb_add(&bar[XB_TOPGEN], 1u);
            else XB_SPIN(xb_ld(&bar[XB_TOPGEN]) == tg, bar);
            __builtin_amdgcn_fence(__ATOMIC_ACQUIRE, "agent");
            xb_add(&bar[XB_XGEN(b.x)], 1u);
            asm volatile("s_waitcnt vmcnt(0)" ::: "memory");
        } else {
            XB_SPIN(xb_ld(&bar[XB_XGEN(b.x)]) == gen, bar);
            __builtin_amdgcn_fence(__ATOMIC_ACQUIRE, "agent");
            asm volatile("s_waitcnt vmcnt(0)" ::: "memory");
        }
    }
    __syncthreads();
}

typedef EpiResidB<true, false> RB_TF; typedef EpiResidB<false, false> RB_FF; typedef EpiResidB<false, true> RB_FT;
constexpr int N_PHASES = 19;
__global__ void __launch_bounds__(512, 2) fwd_megakernel(Args args) {
    extern __shared__ __attribute__((aligned(16))) unsigned char lds_raw[];
    cg::grid_group grid = cg::this_grid();
    Frame F;
    F.lds = (LAS unsigned char*)lds_raw;
    F.G = gridDim.x;
    F.in = args.in; F.out = args.out; F.ws = args.ws;
    unsigned char* ws = args.ws;
    const int lo = args.ph_lo, hi = args.ph_hi;
    { volatile LAS unsigned* st = (volatile LAS unsigned*)(F.lds + LDS_MISC + 16); if (threadIdx.x < 2) st[threadIdx.x] = 0u; __syncthreads(); }
    XcdBarrier xbar = xcd_barrier_post((unsigned*)(ws + WS_CTL + 4096), (volatile LAS unsigned*)(F.lds + LDS_MISC + 16));
    LAS float* red = (LAS float*)(F.lds + LDS_RED);
    const float* MODF = (const float*)(ws + WS_MODF);
#ifndef PHASE_MASK
#define PHASE_MASK 0xFFFFFFFFu
#endif
#define PH(k) ((((PHASE_MASK) >> (k)) & 1u) && lo <= (k) && (k) < hi)
#ifndef REPEAT_MASK
#define REPEAT_MASK 0u
#endif
#define REP(k) for (int rep_ = 0; rep_ < 1 + (int)(((REPEAT_MASK) >> (k)) & 1u); ++rep_)
#define SEAM(k) do { if (PH(k) && PH((k) + 1)) { if ((k) == 0) { \
        asm volatile("s_waitcnt vmcnt(0) lgkmcnt(0)" ::: "memory"); __syncthreads(); \
        if (threadIdx.x == 0) { __builtin_amdgcn_fence(__ATOMIC_RELEASE, "agent"); asm volatile("s_waitcnt vmcnt(0)" ::: "memory"); } \
        grid.sync(); \
        if (threadIdx.x == 0) { __builtin_amdgcn_fence(__ATOMIC_ACQUIRE, "agent"); asm volatile("s_waitcnt vmcnt(0)" ::: "memory"); } \
        __syncthreads(); } else xcd_barrier(xbar); } } while (0)
#define GEMM(EPI, A_, B_, M_, N_, K_, E_) do { int k_ = (K_); asm volatile("" : "+s"(k_)); pg8::Gemm g_{(const bf16_t*)(A_), (const bf16_t*)(B_), (M_), (N_), k_, k_}; pg8::StaticOrder S_; S_.init((M_), (N_), F.G, (int)((blockIdx.x + gemm_rot_) % F.G)); S_.rev = gemm_rev_; \
        pg8::gemm_phase<EPI, pg8::StaticOrder, true, true>(F.lds, g_, S_, (E_)); } while (0)

#define GEMM_TAIL(A_, B_, KFULL_) do { int k_ = (KFULL_) / KSPL; asm volatile("" : "+s"(k_)); pg8::Gemm g_{(const bf16_t*)(A_), (const bf16_t*)(B_), MS, 1024, k_, (KFULL_)}; pg8::TailOrder S_; S_.init(MS, 1024, KSPL, F.G, (int)blockIdx.x); \
        EpiPart E_{(float*)(ws + WS_PBUF)}; pg8::gemm_phase<EpiPart, pg8::TailOrder, true, true>(F.lds, g_, S_, E_); } while (0)
    int gemm_rev_ = 0;
    int gemm_rot_ = 0;
    if (PH(0)) REP(0) p0_phase(F);
    SEAM(0);
    if (PH(1)) REP(1) modnorm_phase<0>(F, 0, 0, nullptr, nullptr);
    SEAM(1);
    if (PH(2)) REP(2) { EpiBf16<0> E{(bf16_t*)(ws + WS_A0), 768}; GEMM(EpiBf16<0>, ws + WS_H, ws + WS_WIN, MT, 768, 1024, E);
        if (blockIdx.x >= 134) { EpiKN E2{(bf16_t*)(ws + WS_KN), (float*)(ws + WS_RS), F.in[20], red, MKN / 256 - 92}; int k_ = 256; asm volatile("" : "+s"(k_));
            pg8::Gemm g_{(const bf16_t*)(ws + WS_CKV) + (size_t)(MKN / 256 - 92) * 256 * 256, (const bf16_t*)(ws + WS_WUK), 92 * 256, 1024, k_, k_}; pg8::StaticOrder S_; S_.init(92 * 256, 1024, 122, (int)blockIdx.x - 134);
            pg8::gemm_phase<EpiKN, pg8::StaticOrder, true, true>(F.lds, g_, S_, E2); } }
    SEAM(2);
    if (PH(3)) REP(3) latent_phase(F);
    SEAM(3);
    if (PH(4)) REP(4) {
#if !defined(P4_ONLY) || P4_ONLY == 1
        { EpiKN E{(bf16_t*)(ws + WS_KN), (float*)(ws + WS_RS), F.in[20], red, 0}; GEMM(EpiKN, ws + WS_CKV, ws + WS_WUK, MKN - 92 * 256, 1024, 256, E); }
#endif
#if !defined(P4_ONLY) || P4_ONLY == 2
        gemm_rot_ = 96;
        { EpiQ E{(bf16_t*)(ws + WS_A0), F.in[18], F.in[19], red}; GEMM(EpiQ, ws + WS_CQ, ws + WS_WQ, MT, 1536, 384, E); }
#endif
#if !defined(P4_ONLY) || P4_ONLY == 3
        gemm_rot_ = 56;
        { EpiBf16<0> E{(bf16_t*)(ws + WS_V), 1024}; GEMM(EpiBf16<0>, ws + WS_CKV, ws + WS_WUV, MT, 1024, 256, E); }
        gemm_rot_ = 0;
#endif
    }
    SEAM(4);
    if (PH(5)) REP(5) attention_phase(F, (unsigned*)(ws + WS_CTL) + rep_, rep_ != 0);
    SEAM(5);
    if (PH(6)) REP(6) combine_phase(F);
    SEAM(6);
    if (PH(7)) REP(7) { EpiResidB<true, false> E{F.in[0], ws + WS_V, MODF + 2048}; GEMM(RB_TF, ws + WS_H, ws + WS_WO, MP, 1024, 1024, E); GEMM_TAIL(ws + WS_H + (size_t)MP * 1024 * 2, ws + WS_WO, 1024); }
    SEAM(7);
    if (PH(8)) REP(8) modnorm_phase<1>(F, 0, 1, MODF + 2048, F.in[1]);
    SEAM(8);
    if (PH(9)) REP(9) { EpiBf16<1> E{(bf16_t*)(ws + WS_HF), 4096}; GEMM(EpiBf16<1>, ws + WS_H, ws + WS_W1, MT, 4096, 1024, E); }
    SEAM(9);
    if (PH(10)) REP(10) { gemm_rev_ = 1; EpiResidB<false, false> E{ws + WS_V, ws + WS_V, MODF + 5120}; GEMM(RB_FF, ws + WS_HF, ws + WS_W2, MP, 1024, 4096, E); gemm_rev_ = 0; GEMM_TAIL(ws + WS_HF + (size_t)MP * 4096 * 2, ws + WS_W2, 4096); }
#ifdef DUP_W2
    if (PH(10)) { EpiBf16<0> E{(bf16_t*)(ws + WS_H), 1024}; GEMM(EpiBf16<0>, ws + WS_HF, ws + WS_W2, MP, 1024, 4096, E); }
#endif
#ifdef EXTRA_SYNCS
    for (int es_ = 0; es_ < EXTRA_SYNCS; ++es_) SEAM(10);
#endif
    SEAM(10);
    if (PH(11)) REP(11) modnorm_phase<1>(F, 1, 0, MODF + 5120, nullptr);
    SEAM(11);
    if (PH(12)) REP(12) {
        { EpiBf16<2> E{(bf16_t*)(ws + WS_U), 1024}; GEMM(EpiBf16<2>, ws + WS_H, ws + WS_CWIN, MT, 1024, 1024, E); }
        gemm_rot_ = 128;
        { EpiVT E{(bf16_t*)(ws + WS_VT), (float*)(ws + WS_SSV)}; GEMM(EpiVT, ws + WS_CWIN + (size_t)1024 * 1024 * 2, ws + WS_H, 1024, MT, 1024, E); }
        gemm_rot_ = 0;
    }
    SEAM(12);
    if (PH(13)) REP(13) sgu_phase(F);
    SEAM(13);
    if (PH(14)) REP(14) { EpiResidB<false, false> E{ws + WS_V, ws + WS_V, MODF + 40 * 6144 + 2048}; GEMM(RB_FF, ws + WS_G, ws + WS_CWO, MP, 1024, 1024, E); GEMM_TAIL(ws + WS_G + (size_t)MP * 1024 * 2, ws + WS_CWO, 1024); }
    SEAM(14);
    if (PH(15)) REP(15) modnorm_phase<1>(F, 1, 1, MODF + 40 * 6144 + 2048, nullptr);
    SEAM(15);
    if (PH(16)) REP(16) { EpiBf16<1> E{(bf16_t*)(ws + WS_HF), 4096}; GEMM(EpiBf16<1>, ws + WS_H, ws + WS_W1 + (size_t)4096 * 1024 * 2, MT, 4096, 1024, E); }
    SEAM(16);
    if (PH(17)) REP(17) { gemm_rev_ = 1; EpiResidB<false, true> E{ws + WS_V, F.out, MODF + 40 * 6144 + 5120}; GEMM(RB_FT, ws + WS_HF, ws + WS_W2 + (size_t)4096 * 1024 * 2, MP, 1024, 4096, E); gemm_rev_ = 0; GEMM_TAIL(ws + WS_HF + (size_t)MP * 4096 * 2, ws + WS_W2 + (size_t)4096 * 1024 * 2, 4096); }
    SEAM(17);
    if (PH(18)) REP(18) final_tail_phase(F, MODF + 40 * 6144 + 5120);
#undef PH
#undef SEAM
#undef GEMM
#undef GEMM_TAIL
}

#ifndef MK_N_LAUNCHES
#define MK_N_LAUNCHES 1
#endif
extern "C" void kernel_launch(void* const* d_in, const int* in_sizes, int n_in, void* d_out, int out_size, void* d_ws, size_t ws_size, hipStream_t stream) {
    static int grid = 0;
    if (grid == 0) {
        if (n_in != 28 || (size_t)out_size != OUT_END || ws_size < WS_END) { fprintf(stderr, "kernel_launch: unexpected shapes: n_in %d out %d ws %zu\n", n_in, out_size, ws_size); grid = -1; return; }
        int dev = 0, cus = 0, per_cu = 0;
        hipGetDevice(&dev); hipDeviceGetAttribute(&cus, hipDeviceAttributeMultiprocessorCount, dev);
        if (hipFuncSetAttribute((const void*)fwd_megakernel, hipFuncAttributeMaxDynamicSharedMemorySize, LDS_BYTES) != hipSuccess) { fprintf(stderr, "kernel_launch: hipFuncSetAttribute failed\n"); grid = -1; return; }
        if (hipOccupancyMaxActiveBlocksPerMultiprocessor(&per_cu, (const void*)fwd_megakernel, 512, LDS_BYTES) != hipSuccess || per_cu < 1) { fprintf(stderr, "kernel_launch: occupancy query says %d\n", per_cu); per_cu = 1; }
        (void)hipGetLastError();
        grid = cus;
        fprintf(stderr, "kernel_launch: grid %d (per_cu %d)\n", grid, per_cu);
    }
    if (grid < 0) return;
    (void)hipMemsetAsync((char*)d_ws + WS_CTL, 0, CTL_BYTES, stream);
    Args a{};
    for (int i = 0; i < 28; ++i) a.in[i] = (const float*)d_in[i];
    a.out = (float*)d_out; a.ws = (unsigned char*)d_ws;
#if MK_N_LAUNCHES == 1
#ifndef PH_HI_TEST
#define PH_HI_TEST N_PHASES
#endif
    a.ph_lo = 0; a.ph_hi = PH_HI_TEST;
    void* params[] = {&a};
    hipError_t e = hipLaunchCooperativeKernel((const void*)fwd_megakernel, dim3(grid), dim3(512), params, LDS_BYTES, stream);
    if (e != hipSuccess) fprintf(stderr, "kernel_launch: cooperative launch failed: %s (grid %d)\n", hipGetErrorString(e), grid);
#else
    for (int p = 0; p < N_PHASES; ++p) { a.ph_lo = p; a.ph_hi = p + 1; hipLaunchKernelGGL(fwd_megakernel, dim3(grid), dim3(512), LDS_BYTES, stream, a); }
#endif
}
```
